# Optimizing an MI355X kernel written in HIP

```python
import jax, jax.numpy as jnp
from jax import lax
import numpy as np

D_MODEL = 2048
BATCH = 4
SEQ = 2048
DEPTH = 2

N_CONV_LAYERS = DEPTH // 2
N_ATTN_LAYERS = DEPTH - N_CONV_LAYERS
CONV_WIDTH = 3
N_HEADS = 16
HEAD_DIM = D_MODEL // N_HEADS
MOBA_BLOCK = 256
MOBA_TOPK = 3
Q_CHUNK = 16
N_GROUPS = 4
EXPERTS_PER_GROUP = 8
N_EXPERTS = N_GROUPS * EXPERTS_PER_GROUP
EXPERT_TOPK = 2
D_EXPERT = D_MODEL // 4
MOE_ROWS = 128
NORM_EPS = 1e-6
ALIBI_MAX_BIAS = 8.0

kernel_name = 'yoco_shortconv_moba_hier_moe'


def rms_norm(x, g):
    xf = x.astype(jnp.float32)
    y = xf * lax.rsqrt(jnp.mean(xf * xf, axis=-1, keepdims=True) + NORM_EPS)
    return (y * g.astype(jnp.float32)).astype(x.dtype)


def alibi_slopes(n_heads):
    return jnp.exp2(-ALIBI_MAX_BIAS * jnp.arange(1, n_heads + 1, dtype=jnp.float32) / n_heads)


def short_conv_mixer(h, w_in, w_conv, w_out):
    D = h.shape[-1]
    b_gate, c_gate, xh = jnp.split(h @ w_in, 3, axis=-1)
    u = c_gate * xh
    u = lax.conv_general_dilated(u, w_conv[:, None, :].astype(u.dtype), (1,), [(CONV_WIDTH - 1, 0)],
                                 dimension_numbers=('NWC', 'WIO', 'NWC'), feature_group_count=D)
    return (b_gate * u) @ w_out


def shared_kv(h, kv_norm, w_kv, k_norm):
    Bsz, S, D = h.shape
    k, v = jnp.split(rms_norm(h, kv_norm) @ w_kv, 2, axis=-1)
    k = rms_norm(k.reshape(Bsz, S, N_HEADS, HEAD_DIM), k_norm).transpose(0, 2, 1, 3)
    v = v.reshape(Bsz, S, N_HEADS, HEAD_DIM).transpose(0, 2, 1, 3)
    n_blocks = -(-S // MOBA_BLOCK)
    pad = n_blocks * MOBA_BLOCK - S
    k = jnp.pad(k, ((0, 0), (0, 0), (0, pad), (0, 0)))
    v = jnp.pad(v, ((0, 0), (0, 0), (0, pad), (0, 0)))
    k_mean = k.astype(jnp.float32).reshape(Bsz, N_HEADS, n_blocks, MOBA_BLOCK, HEAD_DIM).mean(axis=3)
    return k, v, k_mean


def moba_attention(q, k, v, k_mean):
    Bsz, H, S, hd = q.shape
    nb = k_mean.shape[2]
    n_sel = min(MOBA_TOPK, nb)
    kb = k.reshape(Bsz * H, nb, MOBA_BLOCK, hd)
    vb = v.reshape(Bsz * H, nb, MOBA_BLOCK, hd)
    slopes = alibi_slopes(H)
    scale = hd ** -0.5
    blk_pos = jnp.arange(MOBA_BLOCK)
    gather = jax.vmap(lambda a, ix: a[ix])

    def chunk(c):
        t0 = c * Q_CHUNK
        i = t0 // MOBA_BLOCK
        t = t0 + jnp.arange(Q_CHUNK)
        qf = lax.dynamic_slice_in_dim(q, t0, Q_CHUNK, axis=2).astype(jnp.float32)
        gate = jnp.einsum('bhqd,bhnd->bhqn', qf, k_mean)
        gate = jnp.where(jnp.arange(nb) < i, gate, -jnp.inf)
        _, sel = lax.top_k(gate, n_sel)
        sel_ok = sel < i
        sel_flat = sel.reshape(Bsz * H, Q_CHUNK * n_sel)
        kg = gather(kb, sel_flat).reshape(Bsz, H, Q_CHUNK, n_sel, MOBA_BLOCK, hd).astype(jnp.float32)
        vg = gather(vb, sel_flat).reshape(Bsz, H, Q_CHUNK, n_sel, MOBA_BLOCK, hd).astype(jnp.float32)
        s_sel = jnp.einsum('bhqd,bhqnkd->bhqnk', qf, kg) * scale
        dist_sel = (t[:, None, None] - (sel[..., None] * MOBA_BLOCK + blk_pos)).astype(jnp.float32)
        s_sel = jnp.where(sel_ok[..., None], s_sel - slopes[:, None, None, None] * dist_sel, -jnp.inf)
        k_own = lax.dynamic_slice_in_dim(k, i * MOBA_BLOCK, MOBA_BLOCK, axis=2).astype(jnp.float32)
        v_own = lax.dynamic_slice_in_dim(v, i * MOBA_BLOCK, MOBA_BLOCK, axis=2).astype(jnp.float32)
        s_own = jnp.einsum('bhqd,bhkd->bhqk', qf, k_own) * scale
        dist_own = t[:, None] - (i * MOBA_BLOCK + blk_pos)
        s_own = jnp.where(dist_own >= 0, s_own - slopes[:, None, None] * dist_own.astype(jnp.float32), -jnp.inf)
        p = jax.nn.softmax(jnp.concatenate(
            [s_sel.reshape(Bsz, H, Q_CHUNK, n_sel * MOBA_BLOCK), s_own], axis=-1), axis=-1)
        p_sel = p[..., :n_sel * MOBA_BLOCK].reshape(Bsz, H, Q_CHUNK, n_sel, MOBA_BLOCK)
        p_own = p[..., n_sel * MOBA_BLOCK:]
        o = (jnp.einsum('bhqnk,bhqnkd->bhqd', p_sel, vg)
             + jnp.einsum('bhqk,bhkd->bhqd', p_own, v_own))
        return o.astype(q.dtype)

    out = lax.map(chunk, jnp.arange(S // Q_CHUNK))
    return out.transpose(1, 0, 3, 2, 4).reshape(Bsz, S, H * hd)


def hier_moe(h, w_rg, w_re, w_gate, w_up, w_down):
    N, D = h.shape
    hf = h.astype(jnp.float32)
    g_logits = hf @ w_rg.astype(jnp.float32)
    g_prob = jax.nn.softmax(g_logits, axis=-1)
    g_sel = jnp.argmax(g_logits, axis=-1)
    g_w = jnp.take_along_axis(g_prob, g_sel[:, None], axis=-1)
    e_logits = (hf @ w_re.astype(jnp.float32)).reshape(N, N_GROUPS, EXPERTS_PER_GROUP)
    e_logits = jnp.take_along_axis(e_logits, g_sel[:, None, None], axis=1)[:, 0]
    e_top, e_idx = lax.top_k(e_logits, EXPERT_TOPK)
    e_w = jax.nn.softmax(e_top, axis=-1) * g_w
    expert = g_sel[:, None] * EXPERTS_PER_GROUP + e_idx

    M = N * EXPERT_TOPK
    flat_e = expert.reshape(M)
    flat_tok = jnp.repeat(jnp.arange(N), EXPERT_TOPK)
    flat_w = e_w.reshape(M)
    order = jnp.argsort(flat_e)
    se = flat_e[order]
    counts = jnp.bincount(flat_e, length=N_EXPERTS)
    starts = jnp.cumsum(counts) - counts
    padded = (counts + MOE_ROWS - 1) // MOE_ROWS * MOE_ROWS
    pends = jnp.cumsum(padded)
    dest = (pends - padded)[se] + (jnp.arange(M) - starts[se])
    n_blocks = -(-(M + N_EXPERTS * (MOE_ROWS - 1)) // MOE_ROWS)
    cap = n_blocks * MOE_ROWS
    row_tok = jnp.full((cap,), N, dtype=jnp.int32).at[dest].set(flat_tok[order].astype(jnp.int32))
    row_w = jnp.zeros((cap,), jnp.float32).at[dest].set(flat_w[order])
    blk_e = jnp.minimum(jnp.searchsorted(pends, jnp.arange(n_blocks) * MOE_ROWS, side='right'), N_EXPERTS - 1)
    h_pad = jnp.concatenate([h, jnp.zeros((1, D), h.dtype)], axis=0)

    def expert_block(args):
        tok, e = args
        xb = h_pad[tok]
        return (jax.nn.silu(xb @ w_gate[e]) * (xb @ w_up[e])) @ w_down[e]

    y = lax.map(expert_block, (row_tok.reshape(n_blocks, MOE_ROWS), blk_e)).reshape(cap, D)
    y = y.astype(jnp.float32) * row_w[:, None]
    return jax.ops.segment_sum(y, row_tok, num_segments=N + 1)[:N].astype(h.dtype)


def setup_inputs(seed: int = 0) -> dict:
    key = jax.random.key(seed)
    ks = jax.random.split(key, 17)
    D = D_MODEL

    def nrm(k, shape, fan_in):
        return jax.random.normal(k, shape, jnp.float32) * fan_in ** -0.5

    def gain(k, shape):
        return 1.0 + 0.02 * jax.random.normal(k, shape, jnp.float32)

    return {
        'x': jax.random.normal(ks[0], (BATCH, SEQ, D), jnp.float32),
        'mix_norm': gain(ks[1], (DEPTH, D)),
        'ffn_norm': gain(ks[2], (DEPTH, D)),
        'conv_w_in': nrm(ks[3], (N_CONV_LAYERS, D, 3 * D), D),
        'conv_w': nrm(ks[4], (N_CONV_LAYERS, CONV_WIDTH, D), CONV_WIDTH),
        'conv_w_out': nrm(ks[5], (N_CONV_LAYERS, D, D), D),
        'kv_norm': gain(ks[6], (D,)),
        'w_kv': nrm(ks[7], (D, 2 * D), D),
        'k_norm': gain(ks[8], (HEAD_DIM,)),
        'w_q': nrm(ks[9], (N_ATTN_LAYERS, D, D), D),
        'q_norm': gain(ks[10], (N_ATTN_LAYERS, HEAD_DIM)),
        'w_o': nrm(ks[11], (N_ATTN_LAYERS, D, D), D),
        'router_group': nrm(ks[12], (DEPTH, D, N_GROUPS), D),
        'router_expert': nrm(ks[13], (DEPTH, D, N_EXPERTS), D),
        'w_gate': nrm(ks[14], (DEPTH, N_EXPERTS, D, D_EXPERT), D),
        'w_up': nrm(ks[15], (DEPTH, N_EXPERTS, D, D_EXPERT), D),
        'w_down': nrm(ks[16], (DEPTH, N_EXPERTS, D_EXPERT, D), D_EXPERT),
    }


def reference(x, mix_norm, ffn_norm, conv_w_in, conv_w, conv_w_out, kv_norm, w_kv, k_norm,
              w_q, q_norm, w_o, router_group, router_expert, w_gate, w_up, w_down):
    Bsz, S, D = x.shape
    h = x
    k_sh = v_sh = k_mean = None
    for l in range(DEPTH):
        if l < N_CONV_LAYERS:
            h = h + short_conv_mixer(rms_norm(h, mix_norm[l]), conv_w_in[l], conv_w[l], conv_w_out[l])
        else:
            j = l - N_CONV_LAYERS
            if j == 0:
                k_sh, v_sh, k_mean = shared_kv(h, kv_norm, w_kv, k_norm)
            q = rms_norm((rms_norm(h, mix_norm[l]) @ w_q[j]).reshape(Bsz, S, N_HEADS, HEAD_DIM), q_norm[j])
            attn = moba_attention(q.transpose(0, 2, 1, 3), k_sh, v_sh, k_mean)
            h = h + attn @ w_o[j]
        ffn = hier_moe(rms_norm(h, ffn_norm[l]).reshape(Bsz * S, D), router_group[l], router_expert[l],
                       w_gate[l], w_up[l], w_down[l])
        h = h + ffn.reshape(Bsz, S, D)
    return h
```

```cpp
#include <hip/hip_runtime.h>
#include <cstdint>
#include <cstddef>
#include <cstdio>

constexpr int NTOK = 8192, DM = 2048, SEQ = 2048, NBATCH = 4, NH = 16, HD = 128, NBLK = 8, BLK = 256;
constexpr int NE = 32, DE = 512, NG = 4, EPG = 8;
constexpr float EPS = 1e-6f;
constexpr int LDP = DM + 128;

typedef unsigned short bf16_t;
typedef float f32x4 __attribute__((ext_vector_type(4)));

constexpr size_t MB = 1024 * 1024;
constexpr size_t WS_CTL = 0;
constexpr size_t WS_CNT = 64 * 1024;
constexpr size_t WS_A1 = 1 * MB;
constexpr size_t WS_A2 = WS_A1 + 36 * MB;
constexpr size_t WS_BCX = WS_A2 + 36 * MB;
constexpr size_t WS_Z = WS_BCX + 96 * MB;
constexpr size_t WS_ACT = WS_Z + 36 * MB;
constexpr size_t WS_Y = WS_ACT + 16 * MB;
constexpr size_t WS_KMEAN = WS_Y + 64 * MB;
constexpr size_t WS_LIST = WS_KMEAN + 1 * MB;
constexpr size_t WS_TOKW = WS_LIST + 2 * MB;
constexpr size_t WS_TOKE = WS_TOKW + 1 * MB;
constexpr size_t WS_T = WS_TOKE + 1 * MB;
constexpr size_t WS_WT = WS_T;
constexpr size_t WS_HB = WS_T + 96 * MB;
constexpr size_t WS_TOKR = WS_TOKW + 512 * 1024;
constexpr size_t WS_WR = WS_T + 192 * MB;
constexpr size_t WS_END = WS_WR + 1 * MB;

__device__ __forceinline__ unsigned pk2(float lo, float hi) {
    typedef float f2 __attribute__((ext_vector_type(2)));
    typedef __bf16 b2 __attribute__((ext_vector_type(2)));
    f2 v = {lo, hi}; b2 b = __builtin_convertvector(v, b2); return __builtin_bit_cast(unsigned, b);
}
__device__ __forceinline__ float bflo(unsigned u) { return __uint_as_float(u << 16); }
__device__ __forceinline__ float bfhi(unsigned u) { return __uint_as_float(u & 0xffff0000u); }
__device__ __forceinline__ float bf2f(bf16_t b) { return __uint_as_float((unsigned)b << 16); }
__device__ __forceinline__ float wave_sum(float v) {
#pragma unroll
    for (int o = 1; o < 64; o <<= 1) v += __shfl_xor(v, o);
    return v;
}
__device__ __forceinline__ float wave_max(float v) {
#pragma unroll
    for (int o = 1; o < 64; o <<= 1) v = fmaxf(v, __shfl_xor(v, o));
    return v;
}

__device__ __forceinline__ size_t stg_off(int row, int k) {
    const int r = row & 255;
    return ((size_t)((row >> 8) * 64 + (k >> 5)) * 8192) + (size_t)((r * 64 + (((((k & 31) >> 3)) ^ ((0 - (r >> 2)) & 3)) << 4)) >> 1) + (k & 7);
}
__device__ __forceinline__ void norm_rows(const float* __restrict__ src, const float* g1, bf16_t* o1, const float* g2, bf16_t* o2,
                                          int gwave, int nwaves, int lane) {
    for (int row = gwave; row < NTOK; row += nwaves) {
        const f32x4* p = (const f32x4*)(src + (size_t)row * DM);
        f32x4 v[8]; float ss = 0.f;
#pragma unroll
        for (int i = 0; i < 8; ++i) { v[i] = p[lane + 64 * i]; ss += v[i][0] * v[i][0] + v[i][1] * v[i][1] + v[i][2] * v[i][2] + v[i][3] * v[i][3]; }
        ss = wave_sum(ss);
        const float r = rsqrtf(ss * (1.0f / DM) + EPS);
#pragma unroll
        for (int i = 0; i < 8; ++i) {
            const int c = 4 * (lane + 64 * i);
            const f32x4 g = *(const f32x4*)(g1 + c);
            uint2 o; o.x = pk2(v[i][0] * r * g[0], v[i][1] * r * g[1]); o.y = pk2(v[i][2] * r * g[2], v[i][3] * r * g[3]);
            *(uint2*)(o1 + stg_off(row, c)) = o;
            if (g2) {
                const f32x4 h = *(const f32x4*)(g2 + c);
                uint2 q; q.x = pk2(v[i][0] * r * h[0], v[i][1] * r * h[1]); q.y = pk2(v[i][2] * r * h[2], v[i][3] * r * h[3]);
                *(uint2*)(o2 + stg_off(row, c)) = q;
            }
        }
    }
}

__device__ __forceinline__ void combine_rows(float* H, const bf16_t* __restrict__ Y, const float* g1, bf16_t* o1, const float* g2, bf16_t* o2,
                                             int gwave, int nwaves, int lane) {
    for (int row = gwave; row < NTOK; row += nwaves) {
        f32x4* p = (f32x4*)(H + (size_t)row * DM);
        const uint2* y0 = (const uint2*)(Y + (size_t)(2 * row) * DM);
        const uint2* y1 = (const uint2*)(Y + (size_t)(2 * row + 1) * DM);
        f32x4 v[8]; float ss = 0.f;
#pragma unroll
        for (int i = 0; i < 8; ++i) {
            v[i] = p[lane + 64 * i];
            const uint2 a = y0[lane + 64 * i], b = y1[lane + 64 * i];
            v[i][0] += bflo(a.x) + bflo(b.x); v[i][1] += bfhi(a.x) + bfhi(b.x);
            v[i][2] += bflo(a.y) + bflo(b.y); v[i][3] += bfhi(a.y) + bfhi(b.y);
            p[lane + 64 * i] = v[i];
            ss += v[i][0] * v[i][0] + v[i][1] * v[i][1] + v[i][2] * v[i][2] + v[i][3] * v[i][3];
        }
        if (g1) {
            ss = wave_sum(ss);
            const float r = rsqrtf(ss * (1.0f / DM) + EPS);
#pragma unroll
            for (int i = 0; i < 8; ++i) {
                const int c = 4 * (lane + 64 * i);
                const f32x4 g = *(const f32x4*)(g1 + c);
                uint2 o; o.x = pk2(v[i][0] * r * g[0], v[i][1] * r * g[1]); o.y = pk2(v[i][2] * r * g[2], v[i][3] * r * g[3]);
                *(uint2*)(o1 + stg_off(row, c)) = o;
                const f32x4 h = *(const f32x4*)(g2 + c);
                uint2 q; q.x = pk2(v[i][0] * r * h[0], v[i][1] * r * h[1]); q.y = pk2(v[i][2] * r * h[2], v[i][3] * r * h[3]);
                *(uint2*)(o2 + stg_off(row, c)) = q;
            }
        }
    }
}

__device__ __forceinline__ void combine_rows2(const bf16_t* __restrict__ HBin, const bf16_t* __restrict__ Y, const float* g1, bf16_t* o1, const float* g2, bf16_t* o2,
                                              bf16_t* HBout, float* OUT, int gwave, int nwaves, int lane) {
    for (int row = gwave; row < NTOK; row += nwaves) {
        const uint2* hp = (const uint2*)(HBin + (size_t)row * DM);
        const uint2* y0 = (const uint2*)(Y + (size_t)(2 * row) * DM);
        const uint2* y1 = (const uint2*)(Y + (size_t)(2 * row + 1) * DM);
        f32x4 v[8]; float ss = 0.f;
#pragma unroll
        for (int i = 0; i < 8; ++i) {
            const uint2 h = hp[lane + 64 * i], a = y0[lane + 64 * i], b = y1[lane + 64 * i];
            v[i][0] = bflo(h.x) + (bflo(a.x) + bflo(b.x)); v[i][1] = bfhi(h.x) + (bfhi(a.x) + bfhi(b.x));
            v[i][2] = bflo(h.y) + (bflo(a.y) + bflo(b.y)); v[i][3] = bfhi(h.y) + (bfhi(a.y) + bfhi(b.y));
            if (HBout) { uint2 o; o.x = pk2(v[i][0], v[i][1]); o.y = pk2(v[i][2], v[i][3]); *(uint2*)(HBout + (size_t)row * DM + 4 * (lane + 64 * i)) = o; }
            if (OUT) *(f32x4*)(OUT + (size_t)row * DM + 4 * (lane + 64 * i)) = v[i];
            ss += v[i][0] * v[i][0] + v[i][1] * v[i][1] + v[i][2] * v[i][2] + v[i][3] * v[i][3];
        }
        if (g1) {
            ss = wave_sum(ss);
            const float r = rsqrtf(ss * (1.0f / DM) + EPS);
#pragma unroll
            for (int i = 0; i < 8; ++i) {
                const int c = 4 * (lane + 64 * i);
                const f32x4 g = *(const f32x4*)(g1 + c);
                uint2 o; o.x = pk2(v[i][0] * r * g[0], v[i][1] * r * g[1]); o.y = pk2(v[i][2] * r * g[2], v[i][3] * r * g[3]);
                *(uint2*)(o1 + stg_off(row, c)) = o;
                const f32x4 h = *(const f32x4*)(g2 + c);
                uint2 q; q.x = pk2(v[i][0] * r * h[0], v[i][1] * r * h[1]); q.y = pk2(v[i][2] * r * h[2], v[i][3] * r * h[3]);
                *(uint2*)(o2 + stg_off(row, c)) = q;
            }
        }
    }
}

__device__ __forceinline__ void conv_phase(const bf16_t* __restrict__ Bb, const bf16_t* __restrict__ U, const float* __restrict__ cw, bf16_t* Z, int gthread, int nthreads) {
    for (int item = gthread; item < (NTOK / 16) * (DM / 8); item += nthreads) {
        const int co = item & 255, trun = item >> 8;
        const int t0 = trun * 16, s0 = t0 & (SEQ - 1);
        const int c0 = co * 8;
        float w0[8], w1[8], w2[8];
#pragma unroll
        for (int e = 0; e < 8; ++e) { w0[e] = cw[c0 + e]; w1[e] = cw[DM + c0 + e]; w2[e] = cw[2 * DM + c0 + e]; }
        float um2[8], um1[8];
#pragma unroll
        for (int e = 0; e < 8; ++e) { um2[e] = 0.f; um1[e] = 0.f; }
        if (s0 >= 2) {
            const uint4 a = *(const uint4*)(U + (size_t)(t0 - 2) * DM + c0), b = *(const uint4*)(U + (size_t)(t0 - 1) * DM + c0);
            const unsigned av[4] = {a.x, a.y, a.z, a.w}, bv[4] = {b.x, b.y, b.z, b.w};
#pragma unroll
            for (int e = 0; e < 4; ++e) { um2[2 * e] = bflo(av[e]); um2[2 * e + 1] = bfhi(av[e]); um1[2 * e] = bflo(bv[e]); um1[2 * e + 1] = bfhi(bv[e]); }
        }
        for (int t = t0; t < t0 + 16; ++t) {
            const uint4 bg = *(const uint4*)(Bb + (size_t)t * DM + c0), uu = *(const uint4*)(U + (size_t)t * DM + c0);
            const unsigned bgv[4] = {bg.x, bg.y, bg.z, bg.w}, uv[4] = {uu.x, uu.y, uu.z, uu.w};
            unsigned ov[4];
#pragma unroll
            for (int e = 0; e < 4; ++e) {
                const float ua = bflo(uv[e]), ub = bfhi(uv[e]);
                const float ca = w0[2 * e] * um2[2 * e] + w1[2 * e] * um1[2 * e] + w2[2 * e] * ua;
                const float cb = w0[2 * e + 1] * um2[2 * e + 1] + w1[2 * e + 1] * um1[2 * e + 1] + w2[2 * e + 1] * ub;
                ov[e] = pk2(bflo(bgv[e]) * ca, bfhi(bgv[e]) * cb);
                um2[2 * e] = um1[2 * e]; um2[2 * e + 1] = um1[2 * e + 1]; um1[2 * e] = ua; um1[2 * e + 1] = ub;
            }
            *(uint4*)(Z + stg_off(t, c0)) = make_uint4(ov[0], ov[1], ov[2], ov[3]);
        }
    }
}

__global__ void __launch_bounds__(512) k_prep(const float* x, const float* g, bf16_t* a1, int* cnt) {
    const int gt = blockIdx.x * 512 + threadIdx.x;
    if (gt < 2 * NE) cnt[gt] = 0;
    norm_rows(x, g, a1, nullptr, nullptr, gt >> 6, (gridDim.x * 512) >> 6, threadIdx.x & 63);
}
__global__ void __launch_bounds__(512) k_conv(const bf16_t* BCX, const float* cw, bf16_t* Z) {
    conv_phase(BCX, BCX + (size_t)NTOK * DM, cw, Z, blockIdx.x * 512 + threadIdx.x, gridDim.x * 512);
}
__global__ void __launch_bounds__(512) k_combine(float* H, const bf16_t* Y, const float* g1, bf16_t* o1, const float* g2, bf16_t* o2) {
    const int gt = blockIdx.x * 512 + threadIdx.x;
    combine_rows(H, Y, g1, o1, g2, o2, gt >> 6, (gridDim.x * 512) >> 6, threadIdx.x & 63);
}

__global__ void __launch_bounds__(512) naive_gemm(const bf16_t* __restrict__ A, const float* __restrict__ W, float* T, int N, int ldt, int coff) {
    __shared__ float sA[4 * DM];
    const int tid = threadIdx.x, n = blockIdx.x * 512 + tid;
    for (int half = 0; half < 2; ++half) {
    const int m0 = blockIdx.y * 8 + half * 4;
    __syncthreads();
    for (int i = tid; i < 4 * DM; i += 512) sA[i] = bf2f(A[(size_t)(m0 + (i >> 11)) * DM + (i & 2047)]);
    __syncthreads();
    float acc[4];
#pragma unroll
    for (int r = 0; r < 4; ++r) acc[r] = 0.f;
    for (int k = 0; k < DM; k += 4) {
        const float w0 = W[(size_t)k * N + n], w1 = W[(size_t)(k + 1) * N + n], w2 = W[(size_t)(k + 2) * N + n], w3 = W[(size_t)(k + 3) * N + n];
#pragma unroll
        for (int r = 0; r < 4; ++r) { const f32x4 a = *(const f32x4*)&sA[r * DM + k]; acc[r] += a[0] * w0 + a[1] * w1 + a[2] * w2 + a[3] * w3; }
    }
#pragma unroll
    for (int r = 0; r < 4; ++r) T[(size_t)(m0 + r) * ldt + coff + n] = acc[r];
    }
}
__global__ void naive_epi_bf16(const float* T, bf16_t* O, size_t n) { size_t i = (size_t)blockIdx.x * blockDim.x + threadIdx.x; if (i < n) O[i] = (bf16_t)(pk2(T[i], 0.f) & 0xffff); }
__global__ void naive_epi_resid(const float* R, const float* T, float* H, size_t n) { size_t i = (size_t)blockIdx.x * blockDim.x + threadIdx.x; if (i < n) H[i] = R[i] + T[i]; }
__global__ void __launch_bounds__(256) naive_epi_kvq(const float* T, const float* kn, const float* qn, bf16_t* Kb, bf16_t* Vb, bf16_t* Qb) {
    const int gw = (blockIdx.x * 256 + threadIdx.x) >> 6, lane = threadIdx.x & 63;
    if (gw >= NTOK * 48) return;
    const int tok = gw / 48, rem = gw % 48, which = rem / 16, h = rem % 16;
    const float* src = T + (size_t)tok * 6144 + which * 2048 + h * 128 + 2 * lane;
    float v0 = src[0], v1 = src[1];
    if (which != 1) {
        const float ss = wave_sum(v0 * v0 + v1 * v1);
        const float r = rsqrtf(ss * (1.0f / HD) + EPS);
        const float* g = (which == 0) ? kn : qn;
        v0 = v0 * r * g[2 * lane]; v1 = v1 * r * g[2 * lane + 1];
    }
    const int b = tok / SEQ, s = tok % SEQ;
    bf16_t* dst = (which == 0 ? Kb : (which == 1 ? Vb : Qb)) + ((size_t)(b * NH + h) * SEQ + s) * HD + 2 * lane;
    *(unsigned*)dst = pk2(v0, v1);
}
__global__ void naive_kmean(const bf16_t* Kb, float* KM) {
    const int i = blockIdx.x * blockDim.x + threadIdx.x;
    if (i >= NBATCH * NH * NBLK * HD) return;
    const int d = i & 127, blk = (i >> 7) & 7, bh = i >> 10;
    float s = 0.f;
    for (int r = 0; r < BLK; ++r) s += bf2f(Kb[((size_t)bh * SEQ + blk * BLK + r) * HD + d]);
    KM[i] = s * (1.0f / BLK);
}

__global__ void __launch_bounds__(256) naive_router(const float* __restrict__ H, const float* g, const float* __restrict__ wrg, const float* __restrict__ wre,
                                                    bf16_t* AF, int* cnt, int* list, float* tokw, int* toke) {
    const int tok = (blockIdx.x * 256 + threadIdx.x) >> 6, lane = threadIdx.x & 63;
    if (tok >= NTOK) return;
    const f32x4* p = (const f32x4*)(H + (size_t)tok * DM);
    f32x4 v[8]; float ss = 0.f;
#pragma unroll
    for (int i = 0; i < 8; ++i) { v[i] = p[lane + 64 * i]; ss += v[i][0] * v[i][0] + v[i][1] * v[i][1] + v[i][2] * v[i][2] + v[i][3] * v[i][3]; }
    ss = wave_sum(ss);
    const float r = rsqrtf(ss * (1.0f / DM) + EPS);
    float acc[36];
#pragma unroll
    for (int c = 0; c < 36; ++c) acc[c] = 0.f;
#pragma unroll
    for (int i = 0; i < 8; ++i) {
        const int c0 = 4 * (lane + 64 * i);
        const f32x4 gg = *(const f32x4*)(g + c0);
        f32x4 y; y[0] = v[i][0] * r * gg[0]; y[1] = v[i][1] * r * gg[1]; y[2] = v[i][2] * r * gg[2]; y[3] = v[i][3] * r * gg[3];
        uint2 o; o.x = pk2(y[0], y[1]); o.y = pk2(y[2], y[3]);
        *(uint2*)(AF + (size_t)tok * DM + c0) = o;
#pragma unroll
        for (int e = 0; e < 4; ++e) {
            const int k = c0 + e;
            const f32x4 wg = *(const f32x4*)(wrg + (size_t)k * 4);
#pragma unroll
            for (int c = 0; c < 4; ++c) acc[c] += y[e] * wg[c];
#pragma unroll
            for (int q = 0; q < 8; ++q) {
                const f32x4 w = *(const f32x4*)(wre + (size_t)k * 32 + 4 * q);
#pragma unroll
                for (int c = 0; c < 4; ++c) acc[4 + 4 * q + c] += y[e] * w[c];
            }
        }
    }
#pragma unroll
    for (int c = 0; c < 36; ++c) acc[c] = wave_sum(acc[c]);
    if (lane == 0) {
        int gs = 0; float gm = acc[0];
#pragma unroll
        for (int c = 1; c < 4; ++c) if (acc[c] > gm) { gm = acc[c]; gs = c; }
        float den = 0.f;
#pragma unroll
        for (int c = 0; c < 4; ++c) den += __expf(acc[c] - gm);
        const float gw = 1.0f / den;
        float el[8];
#pragma unroll
        for (int c = 0; c < 8; ++c) {
            float x = 0.f;
#pragma unroll
            for (int gg = 0; gg < 4; ++gg) x = (gs == gg) ? acc[4 + gg * 8 + c] : x;
            el[c] = x;
        }
        int i0 = 0; float t0 = el[0];
#pragma unroll
        for (int c = 1; c < 8; ++c) if (el[c] > t0) { t0 = el[c]; i0 = c; }
        int i1 = -1; float t1 = -INFINITY;
#pragma unroll
        for (int c = 0; c < 8; ++c) if (c != i0 && el[c] > t1) { t1 = el[c]; i1 = c; }
        const float e1 = __expf(t1 - t0);
        const float w0 = gw / (1.0f + e1), w1 = gw * e1 / (1.0f + e1);
        const int ex0 = gs * 8 + i0, ex1 = gs * 8 + i1;
        tokw[tok * 2] = w0; tokw[tok * 2 + 1] = w1; toke[tok * 2] = ex0; toke[tok * 2 + 1] = ex1;
    }
}

__global__ void __launch_bounds__(512) naive_build_lists(const int* toke, int* cnt, int* list) {
    __shared__ int part[512];
    const int e = blockIdx.x, tid = threadIdx.x;
    int c = 0;
    for (int i = 0; i < 32; ++i) c += (toke[tid * 32 + i] == e);
    part[tid] = c;
    __syncthreads();
    int off = 0;
    for (int j = 0; j < tid; ++j) off += part[j];
    for (int i = 0; i < 32; ++i) if (toke[tid * 32 + i] == e) list[e * NTOK + off++] = tid * 32 + i;
    if (tid == 511) cnt[e] = off;
}
__global__ void __launch_bounds__(512) naive_moe_a(const bf16_t* __restrict__ AF, const float* __restrict__ Wg, const float* __restrict__ Wu,
                                                   const int* cnt, const int* list, bf16_t* ACT) {
    __shared__ float sA[4 * DM];
    __shared__ int srs[8];
    const int e = blockIdx.y, c0 = blockIdx.x * 4, n = cnt[e], tid = threadIdx.x;
    if (c0 >= n) return;
    if (tid < 4) srs[tid] = (c0 + tid < n) ? list[e * NTOK + c0 + tid] : -1;
    __syncthreads();
    for (int i = tid; i < 4 * DM; i += 512) { const int sr = srs[i >> 11]; sA[i] = sr >= 0 ? bf2f(AF[(size_t)(sr >> 1) * DM + (i & 2047)]) : 0.f; }
    __syncthreads();
    float ag[4], au[4];
#pragma unroll
    for (int r = 0; r < 4; ++r) { ag[r] = 0.f; au[r] = 0.f; }
    const float* wg = Wg + (size_t)e * DM * DE + tid; const float* wu = Wu + (size_t)e * DM * DE + tid;
    for (int k = 0; k < DM; k += 4) {
        float g4[4], u4[4];
#pragma unroll
        for (int q = 0; q < 4; ++q) { g4[q] = wg[(size_t)(k + q) * DE]; u4[q] = wu[(size_t)(k + q) * DE]; }
#pragma unroll
        for (int r = 0; r < 4; ++r) { const f32x4 a = *(const f32x4*)&sA[r * DM + k];
            ag[r] += a[0] * g4[0] + a[1] * g4[1] + a[2] * g4[2] + a[3] * g4[3];
            au[r] += a[0] * u4[0] + a[1] * u4[1] + a[2] * u4[2] + a[3] * u4[3]; }
    }
#pragma unroll
    for (int r = 0; r < 4; ++r) { const int sr = srs[r]; if (sr >= 0) { const float gv = ag[r]; const float a = gv / (1.0f + __expf(-gv)) * au[r];
        ACT[(size_t)sr * DE + tid] = (bf16_t)(pk2(a, 0.f) & 0xffff); } }
}
__global__ void __launch_bounds__(512) naive_moe_b(const bf16_t* __restrict__ ACT, const float* __restrict__ Wd, const int* cnt, const int* list,
                                                   const float* tokw, bf16_t* Y) {
    __shared__ float sA[8 * DE];
    __shared__ int srs[8];
    const int e = blockIdx.y, c0 = blockIdx.x * 8, n = cnt[e], tid = threadIdx.x;
    if (c0 >= n) return;
    if (tid < 8) srs[tid] = (c0 + tid < n) ? list[e * NTOK + c0 + tid] : -1;
    __syncthreads();
    for (int i = tid; i < 8 * DE; i += 512) { const int sr = srs[i >> 9]; sA[i] = sr >= 0 ? bf2f(ACT[(size_t)sr * DE + (i & 511)]) : 0.f; }
    __syncthreads();
    float acc[8][4];
#pragma unroll
    for (int r = 0; r < 8; ++r)
#pragma unroll
        for (int q = 0; q < 4; ++q) acc[r][q] = 0.f;
    const float* wd = Wd + (size_t)e * DE * DM + tid;
    for (int k = 0; k < DE; ++k) {
        float w[4];
#pragma unroll
        for (int q = 0; q < 4; ++q) w[q] = wd[(size_t)k * DM + 512 * q];
#pragma unroll
        for (int r = 0; r < 8; ++r) { const float a = sA[r * DE + k];
#pragma unroll
            for (int q = 0; q < 4; ++q) acc[r][q] += a * w[q]; }
    }
#pragma unroll
    for (int r = 0; r < 8; ++r) { const int sr = srs[r]; if (sr >= 0) { const float w = tokw[sr];
#pragma unroll
        for (int q = 0; q < 4; ++q) Y[(size_t)sr * DM + tid + 512 * q] = (bf16_t)(pk2(acc[r][q] * w, 0.f) & 0xffff); } }
}

__global__ void __launch_bounds__(256) naive_attn(const bf16_t* __restrict__ Qb, const bf16_t* __restrict__ Kb, const bf16_t* __restrict__ Vb,
                                                  const float* __restrict__ KM, bf16_t* ATT) {
    const int gw = (blockIdx.x * 256 + threadIdx.x) >> 6, lane = threadIdx.x & 63;
    if (gw >= NBATCH * NH * SEQ) return;
    const int s = gw % SEQ, bh = gw / SEQ, h = bh % NH, b = bh / NH;
    const int i = s / BLK;
    const unsigned qq = *(const unsigned*)(Qb + ((size_t)bh * SEQ + s) * HD + 2 * lane);
    const float q0 = bflo(qq), q1 = bfhi(qq);
    float gate[8];
#pragma unroll
    for (int n = 0; n < 8; ++n) {
        const float* km = KM + ((size_t)bh * NBLK + n) * HD + 2 * lane;
        gate[n] = wave_sum(q0 * km[0] + q1 * km[1]);
    }
    unsigned sel = 0;
#pragma unroll
    for (int n = 0; n < 8; ++n) {
        int rank = 0;
#pragma unroll
        for (int m = 0; m < 8; ++m) if (m < i && m != n && (gate[m] > gate[n] || (gate[m] == gate[n] && m < n))) ++rank;
        if (n < i && rank < 3) sel |= 1u << n;
    }
    const float slope = exp2f(-8.0f * (float)(h + 1) / (float)NH);
    const float scale = 0.08838834764831845f;
    float m = -INFINITY, l = 0.f, o0 = 0.f, o1 = 0.f;
    for (int jj = 0; jj <= i; ++jj) {
        const int j = (jj == 0) ? i : jj - 1;
        if (j != i && !((sel >> j) & 1)) continue;
        for (int c = 0; c < 4; ++c) {
            const int kbase = j * BLK + c * 64;
            if (j == i && kbase > s) break;
            const int kk = kbase + lane;
            const bf16_t* krow = Kb + ((size_t)bh * SEQ + kk) * HD;
            float dot = 0.f;
            for (int d2 = 0; d2 < 64; ++d2) {
                const float qa = __shfl(q0, d2), qb = __shfl(q1, d2);
                const unsigned kv = *(const unsigned*)(krow + 2 * d2);
                dot += qa * bflo(kv) + qb * bfhi(kv);
            }
            const bool valid = (j < i) || (kk <= s);
            const float sc = valid ? dot * scale - slope * (float)(s - kk) : -INFINITY;
            const float mx = wave_max(sc);
            const float mn = fmaxf(m, mx);
            const float p = valid ? __expf(sc - mn) : 0.f;
            const float alpha = __expf(m - mn);
            l = l * alpha + wave_sum(p);
            o0 *= alpha; o1 *= alpha; m = mn;
            for (int t = 0; t < 64; ++t) {
                const float pt = __shfl(p, t);
                const unsigned vv = *(const unsigned*)(Vb + ((size_t)bh * SEQ + kbase + t) * HD + 2 * lane);
                o0 += pt * bflo(vv); o1 += pt * bfhi(vv);
            }
        }
    }
    const float inv = 1.0f / l;
    *(unsigned*)(ATT + ((size_t)(b * SEQ + s)) * DM + h * HD + 2 * lane) = pk2(o0 * inv, o1 * inv);
}


#define LAS __attribute__((address_space(3)))
typedef short bf16x8 __attribute__((ext_vector_type(8)));
typedef unsigned u32x4 __attribute__((ext_vector_type(4)));
constexpr int LDS_GEMM = 131072;
constexpr int LDS_MISC = LDS_GEMM;
constexpr int LDS_BYTES = LDS_GEMM + 8192;

__device__ __forceinline__ int lds_off(int row, int chunk) { return row * 128 + ((chunk ^ (((row >> 1) & 7) ^ ((row >> 4) & 1))) << 4); }

struct GemmCtx { int tid, lane, wid, wr, wc, fr, fq; };
__device__ __forceinline__ GemmCtx make_ctx() {
    GemmCtx c; int t = threadIdx.x; asm volatile("" : "+v"(t));
    c.tid = t; c.lane = c.tid & 63; c.wid = __builtin_amdgcn_readfirstlane(c.tid >> 6);
    c.wr = c.wid >> 1; c.wc = c.wid & 1; c.fr = c.lane & 15; c.fq = c.lane >> 4; return c;
}

__device__ __forceinline__ int a_chunk_off(int tid) { const int r = tid >> 3; return (((tid & 7) ^ (((r >> 1) & 7) ^ ((r >> 4) & 1))) << 3); }
template <int ABL = 0> __device__ __forceinline__ void gemm_tile_f32w(LAS unsigned char* lds, const GemmCtx& c, const bf16_t* Abase, const unsigned (&aoff)[4], const float* Bbase, unsigned boff0,
                                               int brow0, int bkg, int ldw, int nk, f32x4 (&acc)[4][8]) {
#pragma unroll
    for (int mi = 0; mi < 4; ++mi)
#pragma unroll
        for (int ni = 0; ni < 8; ++ni) acc[mi][ni] = (f32x4){0.f, 0.f, 0.f, 0.f};
    LAS unsigned char* bw0 = lds + 65536 + lds_off(brow0, bkg);
    LAS unsigned char* bw2 = lds + 65536 + lds_off(brow0 + 2, bkg);
    typedef const __attribute__((address_space(1))) f32x4* gf4p;
    const __attribute__((address_space(1))) char* Bg = (const __attribute__((address_space(1))) char*)Bbase;
    const __attribute__((address_space(1))) char* Ag = (const __attribute__((address_space(1))) char*)Abase;
    const int x0 = c.fq ^ (c.fr >> 1);
    int foff[2][2];
#pragma unroll
    for (int par = 0; par < 2; ++par)
#pragma unroll
        for (int k32 = 0; k32 < 2; ++k32) foff[par][k32] = c.fr * 128 + ((x0 ^ (k32 * 4 + par)) << 4);
    const int abase = (c.wr * 64) * 128, bbase = 65536 + (c.wc * 128) * 128;
    LAS unsigned char* adst = lds + c.tid * 16;
    const unsigned ldw4 = (unsigned)ldw * 4u;

    f32x4 rb[8];
    auto gload = [&](int kt, int buf) {
#pragma unroll
        for (int i = 0; i < 4; ++i)
            if (ABL != 3) __builtin_amdgcn_global_load_lds((const __attribute__((address_space(1))) unsigned*)(Ag + (size_t)((aoff[i] + (unsigned)kt * 64u) * 2u)), (LAS unsigned*)(adst + buf * 32768 + i * 8192), 16, 0, 0);
        const unsigned vo = boff0 * 4u;
#pragma unroll
        for (int j = 0; j < 8; ++j) { if (ABL != 2) rb[j] = *(gf4p)((Bg + (size_t)((unsigned)(kt * 64 + j) * ldw4)) + (size_t)vo); else rb[j] = (f32x4){1.f, 2.f, 3.f, (float)kt}; }
    };
    auto lstore = [&](int buf) {
#pragma unroll
        for (int i = 0; i < 4; ++i) {
            u32x4 w; w[0] = pk2(rb[0][i], rb[1][i]); w[1] = pk2(rb[2][i], rb[3][i]); w[2] = pk2(rb[4][i], rb[5][i]); w[3] = pk2(rb[6][i], rb[7][i]);
            *(LAS u32x4*)((i < 2 ? bw0 : bw2) + buf * 32768 + (i & 1) * 128) = w;
        }
    };
    gload(0, 0); lstore(0);
    asm volatile("s_waitcnt vmcnt(0)" ::: "memory");
    __syncthreads();
    for (int kt = 0; kt < nk; ++kt) {
        const int cur = kt & 1;
        if (kt + 1 < nk) gload(kt + 1, cur ^ 1);
#pragma unroll
        for (int k32 = 0; k32 < 2; ++k32) {
            bf16x8 af[4];
#pragma unroll
            for (int mi = 0; mi < 4; ++mi) af[mi] = *(const LAS bf16x8*)(lds + cur * 32768 + abase + mi * 2048 + foff[mi & 1][k32]);
#pragma unroll
            for (int ni = 0; ni < 8; ++ni) {
                const bf16x8 bfr = *(const LAS bf16x8*)(lds + cur * 32768 + bbase + ni * 2048 + foff[ni & 1][k32]);
#pragma unroll
                for (int mi = 0; mi < 4; ++mi) { if (ABL != 1) acc[mi][ni] = __builtin_amdgcn_mfma_f32_16x16x32_bf16(bfr, af[mi], acc[mi][ni], 0, 0, 0); else { acc[mi][ni][0] += __builtin_bit_cast(float, (int)bfr[0]) ; acc[mi][ni][1] += __builtin_bit_cast(float, (int)af[mi][0]); } }
            }
        }
        if (kt + 1 < nk) lstore(cur ^ 1);
        asm volatile("s_waitcnt vmcnt(0)" ::: "memory");
        __syncthreads();
    }
}

__device__ __forceinline__ void gemm_tile_bf16(LAS unsigned char* lds, const GemmCtx& c, const bf16_t* Abase, unsigned aoff0, unsigned aoff1, const bf16_t* Bbase, unsigned boff0, unsigned boff1,
                                               int nk, f32x4 (&acc)[4][8], unsigned bstage = 32u, unsigned astage = 32u,
                                               bool pre = false, bool nxt = false, const bf16_t* An = nullptr, unsigned na0 = 0u, unsigned nb0 = 0u) {
#pragma unroll
    for (int mi = 0; mi < 4; ++mi)
#pragma unroll
        for (int ni = 0; ni < 8; ++ni) acc[mi][ni] = (f32x4){0.f, 0.f, 0.f, 0.f};
    typedef const __attribute__((address_space(1))) unsigned* gu32p;
    const __attribute__((address_space(1))) char* Ag = (const __attribute__((address_space(1))) char*)Abase;
    const __attribute__((address_space(1))) char* Bg = (const __attribute__((address_space(1))) char*)Bbase;
    LAS unsigned char* dst = lds + c.tid * 16;
    const int fo = c.fr * 64 + ((c.fq ^ ((0 - (c.fr >> 2)) & 3)) << 4);
    LAS unsigned char* fa = lds + c.wr * 4096 + fo;
    LAS unsigned char* fb = lds + 16384 + c.wc * 8192 + fo;
    auto issue = [&](int kt) {
        const int st = (kt & 3) * 32768;
        const unsigned ko = (unsigned)kt * astage, kb = (unsigned)kt * bstage;
        __builtin_amdgcn_global_load_lds((gu32p)(Ag + (size_t)((aoff0 + ko) * 2u)), (LAS unsigned*)(dst + st), 16, 0, 0);
        __builtin_amdgcn_global_load_lds((gu32p)(Ag + (size_t)((aoff1 + ko) * 2u)), (LAS unsigned*)(dst + st + 8192), 16, 0, 0);
        __builtin_amdgcn_global_load_lds((gu32p)(Bg + (size_t)((boff0 + kb) * 2u)), (LAS unsigned*)(dst + st + 16384), 16, 0, 0);
        __builtin_amdgcn_global_load_lds((gu32p)(Bg + (size_t)((boff1 + kb) * 2u)), (LAS unsigned*)(dst + st + 16384 + 8192), 16, 0, 0);
    };
#define RING_BAR() do { __builtin_amdgcn_sched_barrier(0); __builtin_amdgcn_s_barrier(); __builtin_amdgcn_sched_barrier(0); asm volatile("" ::: "memory"); } while (0)
    const bool g1 = c.wid >= 4;
    if (!pre) { issue(0); issue(1); issue(2); }
    asm volatile("s_waitcnt vmcnt(8)" ::: "memory");
    RING_BAR();
    if (g1) RING_BAR();
    for (int s = 0; s < nk; ++s) {
        const int st = (s & 3) * 32768;
        bf16x8 af[4], bfv[8];
#pragma unroll
        for (int mi = 0; mi < 4; ++mi) af[mi] = *(const LAS bf16x8*)(fa + st + mi * 1024);
#pragma unroll
        for (int ni = 0; ni < 8; ++ni) bfv[ni] = *(const LAS bf16x8*)(fb + st + ni * 1024);
        __builtin_amdgcn_sched_barrier(0);
        if (s + 3 < nk) issue(s + 3);
        if (g1) {
            if (s <= nk - 4) asm volatile("s_waitcnt vmcnt(8)" ::: "memory");
            else if (s == nk - 3) asm volatile("s_waitcnt vmcnt(4)" ::: "memory");
            else if (s == nk - 2) asm volatile("s_waitcnt vmcnt(0)" ::: "memory");
        }
        __builtin_amdgcn_s_waitcnt(0xC07F);
        RING_BAR();
#pragma unroll
        for (int ni = 0; ni < 8; ++ni)
#pragma unroll
            for (int mi = 0; mi < 4; ++mi) acc[mi][ni] = __builtin_amdgcn_mfma_f32_16x16x32_bf16(bfv[ni], af[mi], acc[mi][ni], 0, 0, 0);
        if (!g1) {
            if (s <= nk - 4) asm volatile("s_waitcnt vmcnt(8)" ::: "memory");
            else if (s == nk - 3) asm volatile("s_waitcnt vmcnt(4)" ::: "memory");
            else if (s == nk - 2) asm volatile("s_waitcnt vmcnt(0)" ::: "memory");
        }
        RING_BAR();
    }
    if (!g1) RING_BAR();
    if (nxt) {
        const __attribute__((address_space(1))) char* Ang = (const __attribute__((address_space(1))) char*)An;
#pragma unroll
        for (int kt = 0; kt < 3; ++kt) {
            const int st = kt * 32768;
            const unsigned ko = (unsigned)kt * astage, kb = (unsigned)kt * bstage;
            __builtin_amdgcn_global_load_lds((gu32p)(Ang + (size_t)((na0 + ko) * 2u)), (LAS unsigned*)(dst + st), 16, 0, 0);
            __builtin_amdgcn_global_load_lds((gu32p)(Ang + (size_t)((na0 + 4096u + ko) * 2u)), (LAS unsigned*)(dst + st + 8192), 16, 0, 0);
            __builtin_amdgcn_global_load_lds((gu32p)(Bg + (size_t)((nb0 + kb) * 2u)), (LAS unsigned*)(dst + st + 16384), 16, 0, 0);
            __builtin_amdgcn_global_load_lds((gu32p)(Bg + (size_t)((nb0 + 4096u + kb) * 2u)), (LAS unsigned*)(dst + st + 16384 + 8192), 16, 0, 0);
        }
    }
#undef RING_BAR
}
__device__ __forceinline__ unsigned ring_off(int tid, int row0, int ld) {
    return (unsigned)((row0 + (tid >> 2)) * ld + ((((tid & 3) ^ ((0 - (tid >> 4)) & 3))) << 3));
}

template <bool CONVIN = false> __device__ __forceinline__ void convert_wt(LAS unsigned char* lds, const GemmCtx& c, const float* __restrict__ W, int N, bf16_t* WT) {
    LAS float* tile = (LAS float*)lds;
    const int ntn = N / 64, ntiles = (DM / 64) * ntn;
    for (int t = blockIdx.x; t < ntiles; t += gridDim.x) {
        const int kt = t / ntn, nt = t % ntn;
        __syncthreads();
#pragma unroll
        for (int i = 0; i < 2; ++i) {
            const int idx = i * 512 + c.tid, kr = idx >> 4, c4 = (idx & 15) * 4;
            const f32x4 v = *(const f32x4*)(W + (size_t)(kt * 64 + kr) * N + nt * 64 + c4);
            tile[kr * 65 + c4] = v[0]; tile[kr * 65 + c4 + 1] = v[1]; tile[kr * 65 + c4 + 2] = v[2]; tile[kr * 65 + c4 + 3] = v[3];
        }
        __syncthreads();
        {
            const int n = c.tid >> 3, k8 = (c.tid & 7) * 8;
            u32x4 o;
#pragma unroll
            for (int q = 0; q < 4; ++q) o[q] = pk2(tile[(k8 + 2 * q) * 65 + n], tile[(k8 + 2 * q + 1) * 65 + n]);
            {
                int nrow = nt * 64 + n;
                if (CONVIN && nrow >= 2048) {
                    const int which = (nrow - 2048) >> 11, ch = (nrow - 2048) & 2047, hd = ch & 127;
                    nrow = 2048 + (ch >> 7) * 256 + (hd >> 6) * 128 + (2 * ((hd >> 4) & 3) + which) * 16 + (hd & 15);
                }
                const int pn = nrow >> 8, r = nrow & 255, kk = kt * 64 + k8, j = kk >> 5, lc = (kk & 31) >> 3;
                *(u32x4*)(WT + ((size_t)(pn * 64 + j) * 8192) + (r * 64 + ((lc ^ ((0 - (r >> 2)) & 3)) << 4)) / 2) = o;
            }
        }
    }
}

struct MegaArgs {
    const float* x; const float* mix_norm; const float* ffn_norm; const float* conv_w_in; const float* conv_w; const float* conv_w_out;
    const float* kv_norm; const float* w_kv; const float* k_norm; const float* w_q; const float* q_norm; const float* w_o;
    const float* router_group; const float* router_expert; const float* w_gate; const float* w_up; const float* w_down;
    float* H; unsigned char* ws; int ph_lo, ph_hi;
};
enum { PH_PREP = 0, PH_GEMM1 = 1, PH_CONV = 2, PH_GEMM2 = 3, PH_ROUTER0 = 4, PH_MOEA0 = 5, PH_MOEB0 = 6, PH_COMBINE0 = 7, PH_GEMM3 = 8, PH_ATTN = 9, PH_GEMM4 = 10,
       PH_ROUTER1 = 11, PH_MOEA1 = 12, PH_MOEB1 = 13, PH_COMBINE1 = 14, PH_END = 15 };

__device__ __forceinline__ int vblock(LAS unsigned char* lds) {
    volatile LAS unsigned* bst = (volatile LAS unsigned*)(lds + LDS_MISC + 8160);
    const unsigned v = bst[2], ok = bst[3];
    const int b = blockIdx.x;
    return __builtin_amdgcn_readfirstlane((ok && v < 256u) ? (int)v : ((b & 7) * 32 + (b >> 3)));
}
__device__ __forceinline__ bool dense_tile(LAS unsigned char* lds, int it, int ntn, int& pm, int& pn) {
    const int b = blockIdx.x, G = gridDim.x;
    const int t = it * G + b;
    if (G != 256) { if (t >= 32 * ntn) return false; pm = t % 32; pn = t / 32; return true; }
    const int r = it; if (r * 8 >= ntn) return false;
    const int vb = vblock(lds); const int x = vb >> 5, j = vb & 31; pm = 4 * x + (j & 3); pn = 8 * r + (j >> 2); return true;
}

template <bool RBF> __device__ __forceinline__ void phase_gemm_resid(LAS unsigned char* lds, const GemmCtx& c, const bf16_t* A, const bf16_t* WT, const void* R, bf16_t* HB) {
    int pm, pn; bool have = dense_tile(lds, 0, DM / 256, pm, pn), pre = false;
    for (int it = 0; have; ++it) {
        int npm = 0, npn = 0; const bool hn = dense_tile(lds, it + 1, DM / 256, npm, npn);
        f32x4 acc[4][8];
        gemm_tile_bf16(lds, c, A, (unsigned)(pm * 64 * 8192 + c.tid * 8), (unsigned)(pm * 64 * 8192 + 4096 + c.tid * 8), WT, (unsigned)(pn * 64 * 8192 + c.tid * 8), (unsigned)(pn * 64 * 8192 + 4096 + c.tid * 8), DM / 32, acc, 8192u, 8192u,
                       pre, hn, A, (unsigned)(npm * 64 * 8192 + c.tid * 8), (unsigned)(npn * 64 * 8192 + c.tid * 8));
#pragma unroll
        for (int mi = 0; mi < 4; ++mi) {
            const size_t row = (size_t)pm * 256 + c.wr * 64 + mi * 16 + c.fr;
#pragma unroll
            for (int ni = 0; ni < 8; ++ni) {
                const size_t idx = row * DM + pn * 256 + c.wc * 128 + ni * 16 + c.fq * 4;
                f32x4 r;
                if (RBF) { const uint2 h = *(const uint2*)((const bf16_t*)R + idx); r[0] = bflo(h.x); r[1] = bfhi(h.x); r[2] = bflo(h.y); r[3] = bfhi(h.y); }
                else r = *(const f32x4*)((const float*)R + idx);
                r = r + acc[mi][ni];
                uint2 o; o.x = pk2(r[0], r[1]); o.y = pk2(r[2], r[3]);
                *(uint2*)(HB + idx) = o;
            }
        }
        pm = npm; pn = npn; have = hn; pre = hn;
    }
}

__device__ __forceinline__ void phase_gemm1(LAS unsigned char* lds, const GemmCtx& c, const bf16_t* A, const bf16_t* WT, bf16_t* O) {
    int pm, pn; bool have = dense_tile(lds, 0, 6144 / 256, pm, pn), pre = false;
    for (int it = 0; have; ++it) {
        int npm = 0, npn = 0; const bool hn = dense_tile(lds, it + 1, 6144 / 256, npm, npn);
        f32x4 acc[4][8];
        const int lpm = pm, lpn = pn;
        gemm_tile_bf16(lds, c, A, (unsigned)(lpm * 64 * 8192 + c.tid * 8), (unsigned)(lpm * 64 * 8192 + 4096 + c.tid * 8), WT, (unsigned)(lpn * 64 * 8192 + c.tid * 8), (unsigned)(lpn * 64 * 8192 + 4096 + c.tid * 8), DM / 32, acc, 8192u, 8192u,
                       pre, hn, A, (unsigned)(npm * 64 * 8192 + c.tid * 8), (unsigned)(npn * 64 * 8192 + c.tid * 8));
#pragma unroll
        for (int mi = 0; mi < 4; ++mi) {
            const size_t row = (size_t)pm * 256 + c.wr * 64 + mi * 16 + c.fr;
            if (pn < 8) {
#pragma unroll
                for (int ni = 0; ni < 8; ++ni) {
                    uint2 o; o.x = pk2(acc[mi][ni][0], acc[mi][ni][1]); o.y = pk2(acc[mi][ni][2], acc[mi][ni][3]);
                    *(uint2*)(O + row * DM + pn * 256 + c.wc * 128 + ni * 16 + c.fq * 4) = o;
                }
            } else {
                bf16_t* U = O + (size_t)NTOK * DM;
#pragma unroll
                for (int p = 0; p < 4; ++p) {
                    uint2 o; o.x = pk2(acc[mi][2 * p][0] * acc[mi][2 * p + 1][0], acc[mi][2 * p][1] * acc[mi][2 * p + 1][1]);
                    o.y = pk2(acc[mi][2 * p][2] * acc[mi][2 * p + 1][2], acc[mi][2 * p][3] * acc[mi][2 * p + 1][3]);
                    *(uint2*)(U + row * DM + (pn - 8) * 128 + c.wc * 64 + p * 16 + c.fq * 4) = o;
                }
            }
        }
        pm = npm; pn = npn; have = hn; pre = hn;
    }
}

__device__ __forceinline__ void phase_gemm3(LAS unsigned char* lds, const GemmCtx& c, const bf16_t* AKV, const bf16_t* AQ, const bf16_t* WT,
                                            const float* kn, const float* qn, bf16_t* Kb, bf16_t* Vb, bf16_t* Qb, float* KM) {
    int pm, pn; bool have = dense_tile(lds, 0, 24, pm, pn), pre = false;
    for (int it = 0; have; ++it) {
        int npm = 0, npn = 0; const bool hn = dense_tile(lds, it + 1, 24, npm, npn);
        const bool isq = pn >= 16;
        const bf16_t* A = isq ? AQ : AKV;
        f32x4 acc[4][8];
        gemm_tile_bf16(lds, c, A, (unsigned)(pm * 64 * 8192 + c.tid * 8), (unsigned)(pm * 64 * 8192 + 4096 + c.tid * 8), WT, (unsigned)(pn * 64 * 8192 + c.tid * 8), (unsigned)(pn * 64 * 8192 + 4096 + c.tid * 8), DM / 32, acc, 8192u, 8192u,
                       pre, hn, (npn >= 16) ? AQ : AKV, (unsigned)(npm * 64 * 8192 + c.tid * 8), (unsigned)(npn * 64 * 8192 + c.tid * 8));
        const int which = pn >> 3;
        const int head = (pn & 7) * 2 + c.wc;
        bf16_t* dst = which == 0 ? Kb : (which == 1 ? Vb : Qb);
        const float* gn = which == 0 ? kn : qn;
        float colsum[8][4];
#pragma unroll
        for (int ni = 0; ni < 8; ++ni)
#pragma unroll
            for (int e = 0; e < 4; ++e) colsum[ni][e] = 0.f;
#pragma unroll
        for (int mi = 0; mi < 4; ++mi) {
            const int tok = pm * 256 + c.wr * 64 + mi * 16 + c.fr;
            const int b = tok >> 11, sq = tok & 2047;
            float r = 1.f;
            if (which != 1) {
                float ss = 0.f;
#pragma unroll
                for (int ni = 0; ni < 8; ++ni)
#pragma unroll
                    for (int e = 0; e < 4; ++e) ss += acc[mi][ni][e] * acc[mi][ni][e];
                ss += __shfl_xor(ss, 16); ss += __shfl_xor(ss, 32);
                r = rsqrtf(ss * (1.0f / HD) + EPS);
            }
            bf16_t* orow = dst + ((size_t)(b * NH + head) * SEQ + sq) * HD + c.fq * 4;
#pragma unroll
            for (int ni = 0; ni < 8; ++ni) {
                f32x4 v = acc[mi][ni];
                if (which != 1) { const f32x4 g = *(const f32x4*)(gn + ni * 16 + c.fq * 4); v[0] = v[0] * r * g[0]; v[1] = v[1] * r * g[1]; v[2] = v[2] * r * g[2]; v[3] = v[3] * r * g[3]; }
                if (which == 0) {
#pragma unroll
                    for (int e = 0; e < 4; ++e) colsum[ni][e] += v[e];
                }
                uint2 o; o.x = pk2(v[0], v[1]); o.y = pk2(v[2], v[3]);
                *(uint2*)(orow + ni * 16) = o;
            }
        }
        if (which == 0) {
            LAS float* red = (LAS float*)(lds + LDS_MISC);
#pragma unroll
            for (int ni = 0; ni < 8; ++ni)
#pragma unroll
                for (int e = 0; e < 4; ++e) {
                    float v = colsum[ni][e];
                    v += __shfl_xor(v, 1); v += __shfl_xor(v, 2); v += __shfl_xor(v, 4); v += __shfl_xor(v, 8);
                    if (c.fr == 0) red[(c.wr * 2 + c.wc) * 128 + ni * 16 + c.fq * 4 + e] = v;
                }
            __syncthreads();
            if (c.tid < 256) {
                const int wc2 = c.tid >> 7, d = c.tid & 127;
                const float sum = ((red[(0 * 2 + wc2) * 128 + d] + red[(1 * 2 + wc2) * 128 + d]) + red[(2 * 2 + wc2) * 128 + d]) + red[(3 * 2 + wc2) * 128 + d];
                const int hd2 = (pn & 7) * 2 + wc2, b = pm >> 3, blk = pm & 7;
                KM[((size_t)(b * NH + hd2) * NBLK + blk) * HD + d] = sum * (1.0f / BLK);
            }
            __syncthreads();
        }
        pm = npm; pn = npn; have = hn; pre = hn;
    }
}

template <int OFF> __device__ __forceinline__ unsigned long long karg64() {
    unsigned long long v; auto k = __builtin_amdgcn_kernarg_segment_ptr();
    asm volatile("s_load_dwordx2 %0, %1, %2\n\ts_waitcnt lgkmcnt(0)" : "=s"(v) : "s"(k), "i"(OFF) : "memory");
    return v;
}
#define ARG(field) ((decltype(MegaArgs::field))karg64<offsetof(MegaArgs, field)>())
#define WSP(T, off) ((T*)((unsigned char*)ARG(ws) + (off)))

__device__ __forceinline__ void moe_counts(LAS int* misc, const GemmCtx& c, const int* toke) {
    if (c.tid < 32) misc[c.tid] = 0;
    __syncthreads();
    typedef int i32x4 __attribute__((ext_vector_type(4)));
    const i32x4* tp = (const i32x4*)(toke + c.tid * 32);
#pragma unroll
    for (int i = 0; i < 8; ++i) {
        const i32x4 v = tp[i];
        atomicAdd((int*)&misc[v[0]], 1); atomicAdd((int*)&misc[v[1]], 1); atomicAdd((int*)&misc[v[2]], 1); atomicAdd((int*)&misc[v[3]], 1);
    }
    __syncthreads();
    if (c.tid == 0) { int acc = 0; for (int e = 0; e < NE; ++e) { misc[32 + e] = acc; acc += (misc[e] + 255) >> 8; } misc[32 + NE] = acc; }
    __syncthreads();
}
__device__ __forceinline__ void moe_rowlist(LAS int* misc, const GemmCtx& c, const int* toke, int e, int mt) {
    __syncthreads();
    typedef int i32x4 __attribute__((ext_vector_type(4)));
    int tb = c.tid * 32; asm volatile("" : "+v"(tb));
    const i32x4* tp = (const i32x4*)(toke + tb);
    i32x4 ent[8];
#pragma unroll
    for (int i = 0; i < 8; ++i) ent[i] = tp[i];
    int cntm = 0;
#pragma unroll
    for (int i = 0; i < 8; ++i) cntm += (ent[i][0] == e) + (ent[i][1] == e) + (ent[i][2] == e) + (ent[i][3] == e);
    int incl = cntm;
#pragma unroll
    for (int o = 1; o < 64; o <<= 1) { const int t = __shfl_up(incl, o); if (c.lane >= o) incl += t; }
    if (c.lane == 63) misc[128 + c.wid] = incl;
    if (c.tid < 256) misc[1024 + c.tid] = -1;
    __syncthreads();
    int base = 0;
#pragma unroll
    for (int w = 0; w < 8; ++w) base += (w < c.wid) ? misc[128 + w] : 0;
    int pos = base + incl - cntm - mt * 256;
    if (cntm > 0 && pos < 256 && pos + cntm > 0) {
#pragma unroll
        for (int i = 0; i < 8; ++i)
#pragma unroll
            for (int q = 0; q < 4; ++q) if (ent[i][q] == e) { if (pos >= 0 && pos < 256) misc[1024 + pos] = tb + 4 * i + q; ++pos; }
    }
    __syncthreads();
}
__device__ __forceinline__ bool moe_tile(LAS int* misc, int it, int ntn, int& e, int& mt, int& nt) {
    const int b = blockIdx.x, G = gridDim.x;
    const int t = (G == 256) ? it * 256 + (b & 7) * 32 + (b >> 3) : it * G + b;
    const int total = misc[32 + NE] * ntn;
    if (t >= total) return false;
    const int g = t / ntn; nt = t % ntn;
    int ee = 0;
#pragma unroll
    for (int q = 1; q < NE; ++q) ee += (misc[32 + q] <= g);
    e = ee; mt = g - misc[32 + ee]; return true;
}

__device__ __forceinline__ unsigned xb_ld(unsigned* p);
__device__ __forceinline__ unsigned xb_add(unsigned* p, unsigned v);
#define MOE_CNT_WORD(layer, g) (3584 + (layer) * 128 + (g))
__device__ __forceinline__ bool moe_item(LAS int* misc, int g_total, int it, int& isb, int& g, int& nt) {
    const int b = blockIdx.x, G = gridDim.x;
    const int TA = g_total * 4, TB = g_total * 8;
    if (G != 256 || TA > 512 || TA < 256) {
        const int t = it * G + b;
        if (t >= TA + TB) return false;
        if (t < TA) { isb = 0; g = t >> 2; nt = t & 3; } else { isb = 1; g = (t - TA) >> 3; nt = (t - TA) & 7; }
        return true;
    }
    const int vb = vblock((LAS unsigned char*)misc - LDS_MISC);
    const int nA2 = TA - 256, nl = 256 - nA2;
    const bool heavy = vb < nA2;
    if (it == 0) { isb = 0; g = vb >> 2; nt = vb & 3; return true; }
    int slot = it - 1;
    if (heavy) { if (slot == 0) { const int t = 256 + vb; isb = 0; g = t >> 2; nt = t & 3; return true; } slot -= 1; }
    int i;
    if (heavy) i = 2 * nl + slot * 256 + nl + vb;
    else i = (slot < 2) ? slot * nl + (vb - nA2) : 2 * nl + (slot - 2) * 256 + (vb - nA2);
    if (i >= TB) return false;
    isb = 1; g = i >> 3; nt = i & 7; return true;
}
__device__ __forceinline__ void moe_g2emt(LAS int* misc, int g, int& e, int& mt) {
    int ee = 0;
#pragma unroll
    for (int q = 1; q < NE; ++q) ee += (misc[32 + q] <= g);
    e = __builtin_amdgcn_readfirstlane(ee); mt = __builtin_amdgcn_readfirstlane(g - misc[32 + ee]);
}
__device__ __forceinline__ void phase_moe(LAS unsigned char* lds, const GemmCtx& c, int layer) {
    LAS int* misc = (LAS int*)(lds + LDS_MISC);
    moe_counts(misc, c, WSP(int, WS_TOKE) + layer * 2 * NTOK);
    const int g_total = __builtin_amdgcn_readfirstlane(misc[32 + NE]);
    const int total_it = (g_total * 12 + gridDim.x - 1) / gridDim.x + 3;
    for (int it = 0; it < total_it; ++it) {
        int isb, g, nt; if (!moe_item(misc, g_total, it, isb, g, nt)) continue;
        isb = __builtin_amdgcn_readfirstlane(isb); g = __builtin_amdgcn_readfirstlane(g); nt = __builtin_amdgcn_readfirstlane(nt);
        int e, mt; moe_g2emt(misc, g, e, mt);
        moe_rowlist(misc, c, WSP(int, WS_TOKE) + layer * 2 * NTOK, e, mt);
        f32x4 acc[4][8];
        if (!isb) {
            {
                unsigned ao[4];
#pragma unroll
                for (int i = 0; i < 4; ++i) { const int sr = misc[1024 + (c.tid >> 3) + 64 * i]; ao[i] = (unsigned)((sr < 0 ? 0 : (sr >> 1)) * DM + a_chunk_off(c.tid)); }
                const int mat = c.wid & 1, bkg = (c.wid >> 1) * 2 + (c.lane >> 5), cgm = c.lane & 31;
                const int brow0 = (cgm >> 4) * 128 + (2 * ((cgm >> 2) & 3) + mat) * 16 + (cgm & 3) * 4;
                const float* Wb = (mat ? ARG(w_up) : ARG(w_gate)) + (size_t)(layer * NE + e) * DM * DE + nt * 128;
                gemm_tile_f32w(lds, c, WSP(bf16_t, WS_A1), ao, Wb, (unsigned)((bkg * 8) * DE + 4 * cgm), brow0, bkg, DE, DM / 64, acc);
            }
            bf16_t* ACT = WSP(bf16_t, WS_ACT);
            const float* tokr = WSP(float, WS_TOKR) + layer * NTOK;
#pragma unroll
            for (int mi = 0; mi < 4; ++mi) {
                const int sr = misc[1024 + c.wr * 64 + mi * 16 + c.fr];
                if (sr >= 0) {
                    const float rs = tokr[sr >> 1];
                    bf16_t* orow = ACT + (size_t)sr * DE + nt * 128 + c.wc * 64 + c.fq * 4;
#pragma unroll
                    for (int p = 0; p < 4; ++p) {
                        float a[4];
#pragma unroll
                        for (int q = 0; q < 4; ++q) { const float gv = acc[mi][2 * p][q] * rs; a[q] = gv / (1.0f + __expf(-gv)) * (acc[mi][2 * p + 1][q] * rs); }
                        uint2 o; o.x = pk2(a[0], a[1]); o.y = pk2(a[2], a[3]);
                        *(uint2*)(orow + p * 16) = o;
                    }
                }
            }
            asm volatile("s_waitcnt vmcnt(0)" ::: "memory");
            __syncthreads();
            if (c.tid == 0) {
                __builtin_amdgcn_fence(__ATOMIC_RELEASE, "agent");
                asm volatile("s_waitcnt vmcnt(0)" ::: "memory");
                (void)xb_add((unsigned*)ARG(ws) + MOE_CNT_WORD(layer, g), 1u);
            }
        } else {
            if (c.tid == 0) {
                unsigned* cw = (unsigned*)ARG(ws) + MOE_CNT_WORD(layer, g);
                unsigned sp = 0;
                while (xb_ld(cw) < 4u) { __builtin_amdgcn_s_sleep(2); if (++sp > (1u << 22)) break; }
                __builtin_amdgcn_fence(__ATOMIC_ACQUIRE, "agent");
                asm volatile("s_waitcnt vmcnt(0)" ::: "memory");
            }
            __syncthreads();
            {
                unsigned ao[4];
#pragma unroll
                for (int i = 0; i < 4; ++i) { const int sr = misc[1024 + (c.tid >> 3) + 64 * i]; ao[i] = (unsigned)((sr < 0 ? 0 : sr) * DE + a_chunk_off(c.tid)); }
                const float* Wb = ARG(w_down) + (size_t)(layer * NE + e) * DE * DM + nt * 256;
                gemm_tile_f32w(lds, c, WSP(bf16_t, WS_ACT), ao, Wb, (unsigned)((c.wid * 8) * DM + 4 * c.lane), 4 * c.lane, c.wid, DM, DE / 64, acc);
            }
            bf16_t* Y = WSP(bf16_t, WS_Y);
            const float* tokw = WSP(float, WS_TOKW) + layer * 2 * NTOK;
#pragma unroll
            for (int mi = 0; mi < 4; ++mi) {
                const int sr = misc[1024 + c.wr * 64 + mi * 16 + c.fr];
                if (sr >= 0) {
                    const float w = tokw[sr];
                    bf16_t* orow = Y + (size_t)sr * DM + nt * 256 + c.wc * 128 + c.fq * 4;
#pragma unroll
                    for (int ni = 0; ni < 8; ++ni) {
                        uint2 o; o.x = pk2(acc[mi][ni][0] * w, acc[mi][ni][1] * w); o.y = pk2(acc[mi][ni][2] * w, acc[mi][ni][3] * w);
                        *(uint2*)(orow + ni * 16) = o;
                    }
                }
            }
        }
    }
}

typedef float f32x16 __attribute__((ext_vector_type(16)));
__device__ __forceinline__ void phase_router(LAS unsigned char* lds, const GemmCtx& c, const bf16_t* __restrict__ HB, const float* __restrict__ g,
                                             const float* __restrict__ wrg, const float* __restrict__ wre, bf16_t* AF, int* toke, float* tokw, float* tokr) {
    LAS float* RR = (LAS float*)lds;
    LAS float* YCH = RR + 64;
    LAS float* WRE = YCH + 32 * 260;
    LAS float* WRG = WRE + 256 * 32;
    LAS float* PLOG = WRG + 256 * 4;
    LAS float* PG = PLOG + 8 * 32 * 32;
    for (int tg = blockIdx.x; tg < NTOK / 32; tg += gridDim.x) {
        const int tok0 = tg * 32;
        __syncthreads();
        f32x16 accl;
#pragma unroll
        for (int i = 0; i < 16; ++i) accl[i] = 0.f;
        float accg[4] = {0.f, 0.f, 0.f, 0.f};
        const int ltok = c.tid >> 4, lq = c.tid & 15;
        float ss = 0.f;
        uint2 hbr[1][4]; f32x4 ggr[1][4], wer[1][4], wgr[1];
        auto ldchunk = [&](int kc, int sl) {
#pragma unroll
            for (int j = 0; j < 4; ++j) {
                const int k = kc * 256 + lq * 4 + 64 * j;
                hbr[sl][j] = *(const uint2*)(HB + (size_t)(tok0 + ltok) * DM + k);
                ggr[sl][j] = *(const f32x4*)(g + k);
                wer[sl][j] = *(const f32x4*)(wre + (size_t)kc * 256 * 32 + (c.tid + 512 * j) * 4);
            }
            if (c.tid < 256) wgr[sl] = *(const f32x4*)(wrg + (size_t)kc * 256 * 4 + c.tid * 4);
        };
        ldchunk(0, 0);
        auto chunk = [&](int kc, const int sl) {
#pragma unroll
            for (int j = 0; j < 4; ++j) {
                const int kl = lq * 4 + 64 * j, k = kc * 256 + kl;
                const uint2 hb = hbr[sl][j];
                const f32x4 h = (f32x4){bflo(hb.x), bfhi(hb.x), bflo(hb.y), bfhi(hb.y)};
                ss += h[0] * h[0] + h[1] * h[1] + h[2] * h[2] + h[3] * h[3];
                const f32x4 gg = ggr[sl][j];
                f32x4 y; y[0] = h[0] * gg[0]; y[1] = h[1] * gg[1]; y[2] = h[2] * gg[2]; y[3] = h[3] * gg[3];
                uint2 o; o.x = pk2(y[0], y[1]); o.y = pk2(y[2], y[3]);
                *(uint2*)(AF + (size_t)(tok0 + ltok) * DM + k) = o;
                *(LAS f32x4*)(YCH + ltok * 260 + kl) = y;
            }
#pragma unroll
            for (int j = 0; j < 4; ++j) *(LAS f32x4*)(WRE + (c.tid + 512 * j) * 4) = wer[sl][j];
            if (c.tid < 256) *(LAS f32x4*)(WRG + c.tid * 4) = wgr[sl];
            __syncthreads();
            if (kc + 1 < 8) ldchunk(kc + 1, 0);
#pragma unroll
            for (int s2 = 0; s2 < 16; ++s2) {
                const int kk = 32 * c.wid + 2 * s2 + (c.lane >> 5);
                const float av = YCH[(c.lane & 31) * 260 + kk];
                const float bv = WRE[kk * 32 + (c.lane & 31)];
                accl = __builtin_amdgcn_mfma_f32_32x32x2f32(av, bv, accl, 0, 0, 0);
            }
            {
                const int t2 = c.tid & 31, ks = c.tid >> 5;
#pragma unroll
                for (int kk = 0; kk < 16; ++kk) {
                    const float yv = YCH[t2 * 260 + ks * 16 + kk];
                    const f32x4 wv = *(const LAS f32x4*)(WRG + (ks * 16 + kk) * 4);
                    accg[0] += yv * wv[0]; accg[1] += yv * wv[1]; accg[2] += yv * wv[2]; accg[3] += yv * wv[3];
                }
            }
            __syncthreads();
        };
#pragma unroll 1
        for (int kc = 0; kc < 8; ++kc) chunk(kc, 0);
        ss += __shfl_xor(ss, 1); ss += __shfl_xor(ss, 2); ss += __shfl_xor(ss, 4); ss += __shfl_xor(ss, 8);
        if (lq == 0) { const float r = rsqrtf(ss * (1.0f / DM) + EPS); RR[ltok] = r; tokr[tok0 + ltok] = r; }
#pragma unroll
        for (int r = 0; r < 16; ++r) PLOG[(c.wid * 32 + ((r & 3) + 8 * (r >> 2) + 4 * (c.lane >> 5))) * 32 + (c.lane & 31)] = accl[r];
        {
            const int t2 = c.tid & 31, ks = c.tid >> 5;
            *(LAS f32x4*)(PG + (ks * 32 + t2) * 4) = (f32x4){accg[0], accg[1], accg[2], accg[3]};
        }
        __syncthreads();
        if (c.tid < 32) {
            const int t2 = c.tid;
            const float rr = RR[t2];
            float gl[4] = {0.f, 0.f, 0.f, 0.f};
#pragma unroll
            for (int ks = 0; ks < 16; ++ks) { const f32x4 v = *(const LAS f32x4*)(PG + (ks * 32 + t2) * 4); gl[0] += v[0]; gl[1] += v[1]; gl[2] += v[2]; gl[3] += v[3]; }
#pragma unroll
            for (int q = 0; q < 4; ++q) gl[q] *= rr;
            int gs = 0; float gm = gl[0];
#pragma unroll
            for (int q = 1; q < 4; ++q) if (gl[q] > gm) { gm = gl[q]; gs = q; }
            float den = 0.f;
#pragma unroll
            for (int q = 0; q < 4; ++q) den += __expf(gl[q] - gm);
            const float gw = 1.0f / den;
            float el[8];
#pragma unroll
            for (int q = 0; q < 8; ++q) {
                float v = 0.f;
#pragma unroll
                for (int w = 0; w < 8; ++w) v += PLOG[(w * 32 + t2) * 32 + gs * 8 + q];
                el[q] = v * rr;
            }
            int i0 = 0; float t0 = el[0];
#pragma unroll
            for (int q = 1; q < 8; ++q) if (el[q] > t0) { t0 = el[q]; i0 = q; }
            int i1 = -1; float t1 = -INFINITY;
#pragma unroll
            for (int q = 0; q < 8; ++q) if (q != i0 && el[q] > t1) { t1 = el[q]; i1 = q; }
            const float e1 = __expf(t1 - t0);
            const int tok = tok0 + t2;
            tokw[tok * 2] = gw / (1.0f + e1); tokw[tok * 2 + 1] = gw * e1 / (1.0f + e1);
            toke[tok * 2] = gs * 8 + i0; toke[tok * 2 + 1] = gs * 8 + i1;
        }
    }
}

__device__ __forceinline__ void convert_router(const GemmCtx& c, const float* __restrict__ rg, const float* __restrict__ re, bf16_t* WR) {
    const int nthreads = gridDim.x * 512;
    for (int idx = blockIdx.x * 512 + c.tid; idx < 2 * 48 * (DM / 8); idx += nthreads) {
        const int k8 = (idx % (DM / 8)) * 8, n = (idx / (DM / 8)) % 48, layer = idx / (48 * (DM / 8));
        u32x4 hi, lo;
#pragma unroll
        for (int q = 0; q < 4; ++q) {
            float w[2];
#pragma unroll
            for (int u = 0; u < 2; ++u) {
                const int k = k8 + 2 * q + u;
                w[u] = n < 32 ? re[((size_t)layer * DM + k) * NE + n] : (n < 36 ? rg[((size_t)layer * DM + k) * NG + (n - 32)] : 0.f);
            }
            const unsigned h2 = pk2(w[0], w[1]);
            hi[q] = h2; lo[q] = pk2(w[0] - bflo(h2), w[1] - bfhi(h2));
        }
        *(u32x4*)(WR + ((size_t)(layer * 2 + 0) * 48 + n) * DM + k8) = hi;
        *(u32x4*)(WR + ((size_t)(layer * 2 + 1) * 48 + n) * DM + k8) = lo;
    }
}
__device__ __forceinline__ void phase_router2(LAS unsigned char* lds, const GemmCtx& c, const bf16_t* __restrict__ HB, const float* __restrict__ g, const bf16_t* __restrict__ WR,
                                              bf16_t* AF, int* toke, float* tokw, float* tokr) {
    LAS float* PL = (LAS float*)lds;
    LAS float* SS = PL + 8 * 32 * 48;
    for (int tg = blockIdx.x; tg < NTOK / 32; tg += gridDim.x) {
        const int tok0 = tg * 32;
        __syncthreads();
        f32x4 acc[2][3];
#pragma unroll
        for (int mb = 0; mb < 2; ++mb)
#pragma unroll
            for (int nb = 0; nb < 3; ++nb) acc[mb][nb] = (f32x4){0.f, 0.f, 0.f, 0.f};
        float ssp[2] = {0.f, 0.f};
        const int kw = c.wid * 256 + 8 * c.fq;
#pragma unroll 2
        for (int st = 0; st < 8; ++st) {
            const int k0 = kw + 32 * st;
            const f32x4 g0 = *(const f32x4*)(g + k0), g1 = *(const f32x4*)(g + k0 + 4);
            bf16x8 af[2];
#pragma unroll
            for (int mb = 0; mb < 2; ++mb) {
                const size_t idx = (size_t)(tok0 + 16 * mb + c.fr) * DM + k0;
                const u32x4 hb = *(const u32x4*)(HB + idx);
                float h[8];
#pragma unroll
                for (int q = 0; q < 4; ++q) { h[2 * q] = bflo(hb[q]); h[2 * q + 1] = bfhi(hb[q]); }
#pragma unroll
                for (int q = 0; q < 8; ++q) ssp[mb] += h[q] * h[q];
                u32x4 o;
                o[0] = pk2(h[0] * g0[0], h[1] * g0[1]); o[1] = pk2(h[2] * g0[2], h[3] * g0[3]);
                o[2] = pk2(h[4] * g1[0], h[5] * g1[1]); o[3] = pk2(h[6] * g1[2], h[7] * g1[3]);
                *(u32x4*)(AF + idx) = o;
                af[mb] = __builtin_bit_cast(bf16x8, o);
            }
#pragma unroll
            for (int nb = 0; nb < 3; ++nb) {
                const bf16x8 wh = *(const bf16x8*)(WR + (size_t)(nb * 16 + c.fr) * DM + k0);
                const bf16x8 wl = *(const bf16x8*)(WR + (size_t)(48 + nb * 16 + c.fr) * DM + k0);
#pragma unroll
                for (int mb = 0; mb < 2; ++mb) {
                    acc[mb][nb] = __builtin_amdgcn_mfma_f32_16x16x32_bf16(wh, af[mb], acc[mb][nb], 0, 0, 0);
                    acc[mb][nb] = __builtin_amdgcn_mfma_f32_16x16x32_bf16(wl, af[mb], acc[mb][nb], 0, 0, 0);
                }
            }
        }
#pragma unroll
        for (int mb = 0; mb < 2; ++mb)
#pragma unroll
            for (int nb = 0; nb < 3; ++nb) *(LAS f32x4*)(PL + ((c.wid * 32 + 16 * mb + c.fr) * 48 + 16 * nb + 4 * c.fq)) = acc[mb][nb];
#pragma unroll
        for (int mb = 0; mb < 2; ++mb) {
            float v = ssp[mb];
            v += __shfl_xor(v, 16); v += __shfl_xor(v, 32);
            if (c.fq == 0) SS[c.wid * 32 + 16 * mb + c.fr] = v;
        }
        __syncthreads();
        if (c.tid < 32) {
            const int t2 = c.tid;
            float ss = 0.f;
#pragma unroll
            for (int w = 0; w < 8; ++w) ss += SS[w * 32 + t2];
            const float rr = rsqrtf(ss * (1.0f / DM) + EPS);
            tokr[tok0 + t2] = rr;
            float gl[4] = {0.f, 0.f, 0.f, 0.f};
#pragma unroll
            for (int w = 0; w < 8; ++w) { const f32x4 v = *(const LAS f32x4*)(PL + (w * 32 + t2) * 48 + 32); gl[0] += v[0]; gl[1] += v[1]; gl[2] += v[2]; gl[3] += v[3]; }
#pragma unroll
            for (int q = 0; q < 4; ++q) gl[q] *= rr;
            int gs = 0; float gm = gl[0];
#pragma unroll
            for (int q = 1; q < 4; ++q) if (gl[q] > gm) { gm = gl[q]; gs = q; }
            float den = 0.f;
#pragma unroll
            for (int q = 0; q < 4; ++q) den += __expf(gl[q] - gm);
            const float gw = 1.0f / den;
            float el[8];
#pragma unroll
            for (int q = 0; q < 8; ++q) {
                float v = 0.f;
#pragma unroll
                for (int w = 0; w < 8; ++w) v += PL[(w * 32 + t2) * 48 + gs * 8 + q];
                el[q] = v * rr;
            }
            int i0 = 0; float t0 = el[0];
#pragma unroll
            for (int q = 1; q < 8; ++q) if (el[q] > t0) { t0 = el[q]; i0 = q; }
            int i1 = -1; float t1 = -INFINITY;
#pragma unroll
            for (int q = 0; q < 8; ++q) if (q != i0 && el[q] > t1) { t1 = el[q]; i1 = q; }
            const float e1 = __expf(t1 - t0);
            const int tok = tok0 + t2;
            tokw[tok * 2] = gw / (1.0f + e1); tokw[tok * 2 + 1] = gw * e1 / (1.0f + e1);
            toke[tok * 2] = gs * 8 + i0; toke[tok * 2 + 1] = gs * 8 + i1;
        }
    }
}

typedef short v4i16_t __attribute__((ext_vector_type(4)));
__device__ __forceinline__ float bfs2f(short v) { return __uint_as_float(((unsigned)(unsigned short)v) << 16); }
__device__ __forceinline__ void attn_unit(LAS unsigned char* lds, const GemmCtx& c, int bh, int qb, const bf16_t* __restrict__ Qb, const bf16_t* __restrict__ Kb,
                                          const bf16_t* __restrict__ Vb, const float* __restrict__ KM, bf16_t* ATT) {
    const int lane = c.lane, w = c.wid, r32 = lane & 31, hh = lane >> 5;
    const int head = bh & 15, b = bh >> 4;
    const float LOG2E = 1.4426950408889634f;
    const float slope2 = exp2f(-8.0f * (float)(head + 1) / (float)NH) * LOG2E;
    const float cs = 0.08838834764831845f * LOG2E;
    const int qrow = qb * 256 + w * 32 + r32;
    bf16x8 qf[8];
    {
        const bf16_t* qp = Qb + ((size_t)bh * SEQ + qrow) * HD + 8 * hh;
#pragma unroll
        for (int ds = 0; ds < 8; ++ds) qf[ds] = *(const bf16x8*)(qp + 16 * ds);
    }
    unsigned sel = 0;
    if (qb > 0) {
        float gate[7];
#pragma unroll
        for (int n = 0; n < 7; ++n) {
            float part = 0.f;
            if (n < qb) {
                const float* km = KM + ((size_t)bh * NBLK + n) * HD + 8 * hh;
#pragma unroll
                for (int ds = 0; ds < 8; ++ds) {
                    const f32x4 k0 = *(const f32x4*)(km + 16 * ds), k1 = *(const f32x4*)(km + 16 * ds + 4);
                    part += bfs2f(qf[ds][0]) * k0[0] + bfs2f(qf[ds][1]) * k0[1] + bfs2f(qf[ds][2]) * k0[2] + bfs2f(qf[ds][3]) * k0[3]
                          + bfs2f(qf[ds][4]) * k1[0] + bfs2f(qf[ds][5]) * k1[1] + bfs2f(qf[ds][6]) * k1[2] + bfs2f(qf[ds][7]) * k1[3];
                }
                part += __shfl_xor(part, 32);
                asm volatile("" : "+v"(part) :: "memory");
            }
            gate[n] = part;
        }
#pragma unroll
        for (int n = 0; n < 7; ++n) {
            int rank = 0;
#pragma unroll
            for (int m2 = 0; m2 < 7; ++m2) if (m2 != n && m2 < qb && (gate[m2] > gate[n] || (gate[m2] == gate[n] && m2 < n))) ++rank;
            if (n < qb && rank < 3) sel |= 1u << n;
        }
    }
    const float hb = slope2 * (float)(4 * hh);
    f32x16 o[4];
#pragma unroll
    for (int db = 0; db < 4; ++db)
#pragma unroll
        for (int r = 0; r < 16; ++r) o[db][r] = 0.f;
    float m = -INFINITY, l = 0.f;
    const int kq = r32 & 15;
    int koff[2];
    koff[0] = r32 * 256; koff[1] = (r32 + 32) * 256;
    const int vq = (lane & 15) >> 2, vp = lane & 3, dhalf = (lane >> 4) & 1;
    int voff[4];
#pragma unroll
    for (int db = 0; db < 4; ++db) voff[db] = 16384 + (4 * hh + vq) * 256 + (((((db ^ vq) << 2) | (dhalf * 2 + (vp >> 1))) << 4)) + (vp & 1) * 8;
    const bf16_t* kbase_g = Kb + (size_t)bh * SEQ * HD;
    const bf16_t* vbase_g = Vb + (size_t)bh * SEQ * HD;
    int ksrc[2], vsrc[2];
#pragma unroll
    for (int i = 0; i < 2; ++i) {
        const int pos = i * 512 + c.tid, row = pos >> 4, pc = pos & 15;
        ksrc[i] = row * HD + ((pc ^ (row & 15)) << 3);
        vsrc[i] = row * HD + ((pc ^ ((row & 3) << 2)) << 3);
    }
    const int ntiles = (qb + 1) * 4;
    auto issue = [&](int t) {
        const int blk = (t < 4) ? qb : (t >> 2) - 1, tt = t & 3, buf = t & 1;
        const size_t g0 = (size_t)(blk * 256 + tt * 64) * HD;
#pragma unroll
        for (int i = 0; i < 2; ++i) {
            __builtin_amdgcn_global_load_lds((const unsigned*)(kbase_g + g0 + ksrc[i]), (LAS unsigned*)(lds + buf * 32768 + (i * 512 + c.tid) * 16), 16, 0, 0);
            __builtin_amdgcn_global_load_lds((const unsigned*)(vbase_g + g0 + vsrc[i]), (LAS unsigned*)(lds + buf * 32768 + 16384 + (i * 512 + c.tid) * 16), 16, 0, 0);
        }
    };
    __syncthreads();
    issue(0);
    asm volatile("s_waitcnt vmcnt(0)" ::: "memory");
    __syncthreads();
    for (int t = 0; t < ntiles; ++t) {
        if (t + 1 < ntiles) issue(t + 1);
        const int blk = (t < 4) ? qb : (t >> 2) - 1, tt = t & 3;
        const int kb0 = blk * 256 + tt * 64;
        const bool own = (t < 4);
        const bool lsel = own || ((sel >> blk) & 1u);
        const bool active = own ? (kb0 <= qb * 256 + w * 32 + 31) : (__ballot(lsel) != 0ull);
        if (active) {
            LAS unsigned char* kl = lds + (t & 1) * 32768;
            const float lb = lsel ? hb : -INFINITY;
            const bool diag = own && (kb0 + 63 > qb * 256 + w * 32);
#pragma unroll
            for (int h32 = 0; h32 < 2; ++h32) {
                f32x16 p0;
                const float lbq = lb * (1.0f / cs), s2q = slope2 * (1.0f / cs);
#pragma unroll
                for (int r = 0; r < 16; ++r) p0[r] = fmaf(s2q, (float)((r & 3) + 8 * (r >> 2)), lbq);
#pragma unroll
                for (int ds = 0; ds < 8; ++ds) {
                    const int ch = ((2 * ds + hh) ^ kq) << 4;
                    const bf16x8 k0 = *(const LAS bf16x8*)(kl + koff[h32] + ch);
                    p0 = __builtin_amdgcn_mfma_f32_32x32x16_bf16(k0, qf[ds], p0, 0, 0, 0);
                }
                float mx0 = -INFINITY;
                const int dq = qrow - kb0 - 32 * h32 - 4 * hh;
#pragma unroll
                for (int r = 0; r < 16; ++r) {
                    if (diag) { if ((r & 3) + 8 * (r >> 2) > dq) p0[r] = -INFINITY; }
                    mx0 = fmaxf(mx0, p0[r]);
                }
                const float tc = slope2 * (float)(kb0 + 32 * h32);
                float tmax = fmaf(mx0, cs, tc);
                tmax = fmaxf(tmax, __shfl_xor(tmax, 32));
                const float mn = fmaxf(m, tmax);
                if (__ballot(mn > m) != 0ull) {
                    const float alpha = __builtin_amdgcn_exp2f(m - mn);
                    l *= alpha;
#pragma unroll
                    for (int db = 0; db < 4; ++db)
#pragma unroll
                        for (int r = 0; r < 16; ++r) o[db][r] *= alpha;
                    m = mn;
                }
                const float c0 = tc - m;
                float ls = 0.f;
#pragma unroll
                for (int r = 0; r < 16; ++r) { const float e0 = __builtin_amdgcn_exp2f(fmaf(p0[r], cs, c0)); p0[r] = e0; ls += e0; }
                l += ls;
                bf16x8 pb[2];
#pragma unroll
                for (int s2 = 0; s2 < 2; ++s2) {
                    u32x4 w0;
#pragma unroll
                    for (int q = 0; q < 4; ++q) w0[q] = pk2(p0[8 * s2 + 2 * q], p0[8 * s2 + 2 * q + 1]);
                    pb[s2] = __builtin_bit_cast(bf16x8, w0);
                }
#pragma unroll
                for (int db = 0; db < 4; ++db) {
#pragma unroll
                    for (int s2 = 0; s2 < 2; ++s2) {
                        const int ks = 2 * h32 + s2;
                        const v4i16_t lo = __builtin_amdgcn_ds_read_tr16_b64_v4i16((LAS v4i16_t*)(kl + voff[db] + (16 * ks) * 256));
                        const v4i16_t hi = __builtin_amdgcn_ds_read_tr16_b64_v4i16((LAS v4i16_t*)(kl + voff[db] + (16 * ks + 8) * 256));
                        bf16x8 vf; vf[0] = lo[0]; vf[1] = lo[1]; vf[2] = lo[2]; vf[3] = lo[3]; vf[4] = hi[0]; vf[5] = hi[1]; vf[6] = hi[2]; vf[7] = hi[3];
                        o[db] = __builtin_amdgcn_mfma_f32_32x32x16_bf16(vf, pb[s2], o[db], 0, 0, 0);
                    }
                }
            }
        }
        asm volatile("s_waitcnt vmcnt(0)" ::: "memory");
        __syncthreads();
    }
    l += __shfl_xor(l, 32);
    const float inv = 1.0f / l;
    const int orow_tok = b * SEQ + qrow, ocol0 = head * HD + 4 * hh;
#pragma unroll
    for (int db = 0; db < 4; ++db)
#pragma unroll
        for (int rq = 0; rq < 4; ++rq) {
            uint2 ov; ov.x = pk2(o[db][4 * rq] * inv, o[db][4 * rq + 1] * inv); ov.y = pk2(o[db][4 * rq + 2] * inv, o[db][4 * rq + 3] * inv);
            *(uint2*)(ATT + stg_off(orow_tok, ocol0 + db * 32 + 8 * rq)) = ov;
        }
}
__device__ __forceinline__ void phase_attn(LAS unsigned char* lds, const GemmCtx& c, const bf16_t* Qb, const bf16_t* Kb, const bf16_t* Vb, const float* KM, bf16_t* ATT) {
    for (int it = blockIdx.x; it < 256; it += gridDim.x) {
        const int p = (gridDim.x == 256) ? vblock(lds) : it;
        const int bh = p >> 2, j = p & 3;
        attn_unit(lds, c, bh, 7 - j, Qb, Kb, Vb, KM, ATT);
        attn_unit(lds, c, bh, j, Qb, Kb, Vb, KM, ATT);
    }
}

#define XB_TMO      128
#define XB_XCNT(j)  (256  + 64 * (j))
#define XB_XSUB(j)  (1280 + 64 * (j))
#define XB_XGEN(j)  (2304 + 64 * (j))
#define XB_TOP      3328
#define XB_TOPGEN   3392
#define XCD_BAR_WORDS 3456
#define XB_SPIN_CAP (1u << 22)
__device__ __forceinline__ unsigned xb_ld(unsigned* p)              { return __hip_atomic_load(p, __ATOMIC_RELAXED, __HIP_MEMORY_SCOPE_AGENT); }
__device__ __forceinline__ unsigned xb_add(unsigned* p, unsigned v) { return __hip_atomic_fetch_add(p, v, __ATOMIC_RELAXED, __HIP_MEMORY_SCOPE_AGENT); }
__device__ __forceinline__ unsigned xb_xcc_id() { return (unsigned)__builtin_amdgcn_s_getreg((3 << 11) | 20) & 0xFu; }
#define XB_SPIN(cond, bar) do { unsigned _sp = 0; while (cond) { __builtin_amdgcn_s_sleep(1); \
    if ((++_sp & 255u) == 0u) { if (xb_ld(&(bar)[XB_TMO])) break; if (_sp > XB_SPIN_CAP) { atomicAdd(&(bar)[XB_TMO], 1u); break; } } } } while (0)
__device__ __forceinline__ void xcd_barrier_complete(unsigned* bar, unsigned x, unsigned& nloc, unsigned& nx) {
    const unsigned G = gridDim.x;
    unsigned sum, cnt, mine, sp = 0u;
    for (;;) {
        sum = 0u; cnt = 0u; mine = 0u;
#pragma unroll
        for (unsigned j = 0; j < 16; ++j) { const unsigned cc = xb_ld(&bar[XB_XCNT(j)]); sum += cc; cnt += (cc > 0u) ? 1u : 0u; mine = (j == x) ? cc : mine; }
        if (sum == G) break;
        __builtin_amdgcn_s_sleep(1);
        if ((++sp & 255u) == 0u) { if (xb_ld(&bar[XB_TMO])) break; if (sp > XB_SPIN_CAP) { atomicAdd(&bar[XB_TMO], 1u); break; } }
    }
    nloc = mine > 0u ? mine : 1u; nx = cnt > 0u ? cnt : 1u;
}
__device__ __forceinline__ void grid_barrier(unsigned* bar, volatile LAS unsigned* st) {
    asm volatile("s_waitcnt vmcnt(0)" ::: "memory");
    __syncthreads();
    if (threadIdx.x == 0) {
        __builtin_amdgcn_s_waitcnt(0);
        const unsigned x = xb_xcc_id();
        unsigned nloc = st[0], nx = st[1];
        if (nloc == 0u) {
            xcd_barrier_complete(bar, x, nloc, nx); st[0] = nloc; st[1] = nx;
            unsigned ok = 1u;
#pragma unroll
            for (unsigned j = 0; j < 16; ++j) { const unsigned cc = xb_ld(&bar[XB_XCNT(j)]); ok &= (j < 8u) ? (cc == 32u ? 1u : 0u) : (cc == 0u ? 1u : 0u); }
            st[3] = ok;
        }
        const unsigned old = xb_add(&bar[XB_XSUB(x)], 1u);
        const unsigned gen = old / nloc;
        if (old + 1u == (gen + 1u) * nloc) {
            __builtin_amdgcn_fence(__ATOMIC_RELEASE, "agent");
            asm volatile("s_waitcnt vmcnt(0)" ::: "memory");
            const unsigned og = xb_add(&bar[XB_TOP], 1u);
            const unsigned tg = og / nx;
            if (og + 1u == (tg + 1u) * nx) xb_add(&bar[XB_TOPGEN], 1u);
            else XB_SPIN(xb_ld(&bar[XB_TOPGEN]) == tg, bar);
            __builtin_amdgcn_fence(__ATOMIC_ACQUIRE, "agent");
            xb_add(&bar[XB_XGEN(x)], 1u);
            asm volatile("s_waitcnt vmcnt(0)" ::: "memory");
        } else {
            XB_SPIN(xb_ld(&bar[XB_XGEN(x)]) == gen, bar);
            __builtin_amdgcn_fence(__ATOMIC_ACQUIRE, "agent");
            asm volatile("s_waitcnt vmcnt(0)" ::: "memory");
        }
    }
    __syncthreads();
}

__global__ void __launch_bounds__(512, 2) mega(MegaArgs a) {
    extern __shared__ __attribute__((aligned(16))) unsigned char lds_raw[];
    LAS unsigned char* lds = (LAS unsigned char*)lds_raw;
    const int ph_lo = a.ph_lo, ph_hi = a.ph_hi;
    volatile LAS unsigned* bst = (volatile LAS unsigned*)(lds + LDS_MISC + 8160);
    if (threadIdx.x == 0) { bst[0] = 0u; bst[1] = 0u; bst[2] = 0xffffu; bst[3] = 0u; }
    if (ph_hi - ph_lo > 1 && threadIdx.x == 0) {
        const unsigned x = xb_xcc_id(); const unsigned rank = xb_add(&((unsigned*)ARG(ws))[XB_XCNT(x)], 1u);
        bst[2] = (x < 8u && rank < 32u) ? x * 32u + rank : 0xffffu;
    }
    __syncthreads();
#ifndef REPEAT_PH
#define REPEAT_PH -1
#endif
#ifndef ABLATE
#define ABLATE 0
#endif
#define IN(k) (ph_lo <= (k) && (k) < ph_hi)
#define SEAM(k) if (IN(k) && IN((k) + 1)) grid_barrier((unsigned*)ARG(ws), bst);
    if (IN(PH_PREP)) { const GemmCtx c = make_ctx(); const int gwave = blockIdx.x * 8 + c.wid, nwaves = gridDim.x * 8; (void)gwave; (void)nwaves;
        norm_rows(ARG(x), ARG(mix_norm), WSP(bf16_t, WS_A1), nullptr, nullptr, gwave, nwaves, c.lane);
        convert_wt<true>(lds, c, ARG(conv_w_in), 6144, WSP(bf16_t, WS_WT));
        convert_wt(lds, c, ARG(conv_w_out), 2048, WSP(bf16_t, WS_WT) + (size_t)6144 * DM);
        convert_wt(lds, c, ARG(w_kv), 4096, WSP(bf16_t, WS_WT) + (size_t)(6144 + 2048) * DM);
        convert_wt(lds, c, ARG(w_q), 2048, WSP(bf16_t, WS_WT) + (size_t)(6144 + 2048 + 4096) * DM);
        convert_wt(lds, c, ARG(w_o), 2048, WSP(bf16_t, WS_WT) + (size_t)(6144 + 2048 + 6144) * DM);
        convert_router(c, ARG(router_group), ARG(router_expert), WSP(bf16_t, WS_WR)); }
    if (IN(PH_PREP) && REPEAT_PH == PH_PREP) grid_barrier((unsigned*)ARG(ws), bst);
    if (IN(PH_PREP) && REPEAT_PH == PH_PREP) { const GemmCtx c = make_ctx(); const int gwave = blockIdx.x * 8 + c.wid, nwaves = gridDim.x * 8; (void)gwave; (void)nwaves;
        norm_rows(ARG(x), ARG(mix_norm), WSP(bf16_t, WS_A1), nullptr, nullptr, gwave, nwaves, c.lane);
        convert_wt<true>(lds, c, ARG(conv_w_in), 6144, WSP(bf16_t, WS_WT));
        convert_wt(lds, c, ARG(conv_w_out), 2048, WSP(bf16_t, WS_WT) + (size_t)6144 * DM);
        convert_wt(lds, c, ARG(w_kv), 4096, WSP(bf16_t, WS_WT) + (size_t)(6144 + 2048) * DM);
        convert_wt(lds, c, ARG(w_q), 2048, WSP(bf16_t, WS_WT) + (size_t)(6144 + 2048 + 4096) * DM);
        convert_wt(lds, c, ARG(w_o), 2048, WSP(bf16_t, WS_WT) + (size_t)(6144 + 2048 + 6144) * DM); }
    SEAM(PH_PREP)
    if (IN(PH_GEMM1)) { const GemmCtx c = make_ctx(); const int gwave = blockIdx.x * 8 + c.wid, nwaves = gridDim.x * 8; (void)gwave; (void)nwaves;
        phase_gemm1(lds, c, WSP(bf16_t, WS_A1), WSP(bf16_t, WS_WT), WSP(bf16_t, WS_BCX)); }
    if (IN(PH_GEMM1) && REPEAT_PH == PH_GEMM1) grid_barrier((unsigned*)ARG(ws), bst);
    if (IN(PH_GEMM1) && REPEAT_PH == PH_GEMM1) { const GemmCtx c = make_ctx(); const int gwave = blockIdx.x * 8 + c.wid, nwaves = gridDim.x * 8; (void)gwave; (void)nwaves;
        phase_gemm1(lds, c, WSP(bf16_t, WS_A1), WSP(bf16_t, WS_WT), WSP(bf16_t, WS_BCX)); }
    SEAM(PH_GEMM1)
    if (IN(PH_CONV)) { const GemmCtx c = make_ctx(); const int gwave = blockIdx.x * 8 + c.wid, nwaves = gridDim.x * 8; (void)gwave; (void)nwaves;
        conv_phase(WSP(bf16_t, WS_BCX), WSP(bf16_t, WS_BCX) + (size_t)NTOK * DM, ARG(conv_w), WSP(bf16_t, WS_Z), blockIdx.x * 512 + c.tid, gridDim.x * 512); }
    if (IN(PH_CONV) && REPEAT_PH == PH_CONV) grid_barrier((unsigned*)ARG(ws), bst);
    if (IN(PH_CONV) && REPEAT_PH == PH_CONV) { const GemmCtx c = make_ctx(); const int gwave = blockIdx.x * 8 + c.wid, nwaves = gridDim.x * 8; (void)gwave; (void)nwaves;
        conv_phase(WSP(bf16_t, WS_BCX), WSP(bf16_t, WS_BCX) + (size_t)NTOK * DM, ARG(conv_w), WSP(bf16_t, WS_Z), blockIdx.x * 512 + c.tid, gridDim.x * 512); }
    SEAM(PH_CONV)
    if (IN(PH_GEMM2)) { const GemmCtx c = make_ctx(); const int gwave = blockIdx.x * 8 + c.wid, nwaves = gridDim.x * 8; (void)gwave; (void)nwaves;
        phase_gemm_resid<false>(lds, c, WSP(bf16_t, WS_Z), WSP(bf16_t, WS_WT) + (size_t)6144 * DM, ARG(x), WSP(bf16_t, WS_HB)); }
    if (IN(PH_GEMM2) && REPEAT_PH == PH_GEMM2) grid_barrier((unsigned*)ARG(ws), bst);
    if (IN(PH_GEMM2) && REPEAT_PH == PH_GEMM2) { const GemmCtx c = make_ctx(); const int gwave = blockIdx.x * 8 + c.wid, nwaves = gridDim.x * 8; (void)gwave; (void)nwaves;
        phase_gemm_resid<false>(lds, c, WSP(bf16_t, WS_Z), WSP(bf16_t, WS_WT) + (size_t)6144 * DM, ARG(x), WSP(bf16_t, WS_HB)); }
    SEAM(PH_GEMM2)
    if (IN(PH_ROUTER0)) { const GemmCtx c = make_ctx(); const int gwave = blockIdx.x * 8 + c.wid, nwaves = gridDim.x * 8; (void)gwave; (void)nwaves;
        phase_router2(lds, c, WSP(bf16_t, WS_HB), ARG(ffn_norm), WSP(bf16_t, WS_WR), WSP(bf16_t, WS_A1), WSP(int, WS_TOKE), WSP(float, WS_TOKW), WSP(float, WS_TOKR)); }
    if (IN(PH_ROUTER0) && REPEAT_PH == PH_ROUTER0) grid_barrier((unsigned*)ARG(ws), bst);
    if (IN(PH_ROUTER0) && REPEAT_PH == PH_ROUTER0) { const GemmCtx c = make_ctx(); const int gwave = blockIdx.x * 8 + c.wid, nwaves = gridDim.x * 8; (void)gwave; (void)nwaves;
        phase_router(lds, c, WSP(bf16_t, WS_HB), ARG(ffn_norm), ARG(router_group), ARG(router_expert), WSP(bf16_t, WS_A1), WSP(int, WS_TOKE), WSP(float, WS_TOKW), WSP(float, WS_TOKR)); }
    SEAM(PH_ROUTER0)
    if (IN(PH_MOEA0)) { const GemmCtx c = make_ctx(); const int gwave = blockIdx.x * 8 + c.wid, nwaves = gridDim.x * 8; (void)gwave; (void)nwaves;
        phase_moe(lds, c, 0); }
    if (IN(PH_MOEA0) && IN(PH_COMBINE0)) grid_barrier((unsigned*)ARG(ws), bst);
    if (IN(PH_COMBINE0)) { const GemmCtx c = make_ctx(); const int gwave = blockIdx.x * 8 + c.wid, nwaves = gridDim.x * 8; (void)gwave; (void)nwaves;
        combine_rows2(WSP(bf16_t, WS_HB), WSP(bf16_t, WS_Y), ARG(kv_norm), WSP(bf16_t, WS_A1), ARG(mix_norm) + DM, WSP(bf16_t, WS_A2), WSP(bf16_t, WS_HB), nullptr, gwave, nwaves, c.lane); }
    if (IN(PH_COMBINE0) && REPEAT_PH == PH_COMBINE0) grid_barrier((unsigned*)ARG(ws), bst);
    if (IN(PH_COMBINE0) && REPEAT_PH == PH_COMBINE0) { const GemmCtx c = make_ctx(); const int gwave = blockIdx.x * 8 + c.wid, nwaves = gridDim.x * 8; (void)gwave; (void)nwaves;
        combine_rows2(WSP(bf16_t, WS_HB), WSP(bf16_t, WS_Y), ARG(kv_norm), WSP(bf16_t, WS_A1), ARG(mix_norm) + DM, WSP(bf16_t, WS_A2), WSP(bf16_t, WS_HB), nullptr, gwave, nwaves, c.lane); }
    SEAM(PH_COMBINE0)
    if (IN(PH_GEMM3)) { const GemmCtx c = make_ctx(); const int gwave = blockIdx.x * 8 + c.wid, nwaves = gridDim.x * 8; (void)gwave; (void)nwaves;
        phase_gemm3(lds, c, WSP(bf16_t, WS_A1), WSP(bf16_t, WS_A2), WSP(bf16_t, WS_WT) + (size_t)(6144 + 2048) * DM, ARG(k_norm), ARG(q_norm),
                                  WSP(bf16_t, WS_BCX), WSP(bf16_t, WS_BCX) + (size_t)NTOK * DM, WSP(bf16_t, WS_BCX) + (size_t)2 * NTOK * DM, WSP(float, WS_KMEAN)); }
    if (IN(PH_GEMM3) && REPEAT_PH == PH_GEMM3) grid_barrier((unsigned*)ARG(ws), bst);
    if (IN(PH_GEMM3) && REPEAT_PH == PH_GEMM3) { const GemmCtx c = make_ctx(); const int gwave = blockIdx.x * 8 + c.wid, nwaves = gridDim.x * 8; (void)gwave; (void)nwaves;
        phase_gemm3(lds, c, WSP(bf16_t, WS_A1), WSP(bf16_t, WS_A2), WSP(bf16_t, WS_WT) + (size_t)(6144 + 2048) * DM, ARG(k_norm), ARG(q_norm),
                                  WSP(bf16_t, WS_BCX), WSP(bf16_t, WS_BCX) + (size_t)NTOK * DM, WSP(bf16_t, WS_BCX) + (size_t)2 * NTOK * DM, WSP(float, WS_KMEAN)); }
    SEAM(PH_GEMM3)
    if (IN(PH_ATTN)) { const GemmCtx c = make_ctx(); const int gwave = blockIdx.x * 8 + c.wid, nwaves = gridDim.x * 8; (void)gwave; (void)nwaves;
        phase_attn(lds, c, WSP(bf16_t, WS_BCX) + (size_t)2 * NTOK * DM, WSP(bf16_t, WS_BCX), WSP(bf16_t, WS_BCX) + (size_t)NTOK * DM, WSP(float, WS_KMEAN), WSP(bf16_t, WS_Z)); }
    if (IN(PH_ATTN) && REPEAT_PH == PH_ATTN) grid_barrier((unsigned*)ARG(ws), bst);
    if (IN(PH_ATTN) && REPEAT_PH == PH_ATTN) { const GemmCtx c = make_ctx(); const int gwave = blockIdx.x * 8 + c.wid, nwaves = gridDim.x * 8; (void)gwave; (void)nwaves;
        phase_attn(lds, c, WSP(bf16_t, WS_BCX) + (size_t)2 * NTOK * DM, WSP(bf16_t, WS_BCX), WSP(bf16_t, WS_BCX) + (size_t)NTOK * DM, WSP(float, WS_KMEAN), WSP(bf16_t, WS_Z)); }
    SEAM(PH_ATTN)
    if (IN(PH_GEMM4)) { const GemmCtx c = make_ctx(); const int gwave = blockIdx.x * 8 + c.wid, nwaves = gridDim.x * 8; (void)gwave; (void)nwaves;
        phase_gemm_resid<true>(lds, c, WSP(bf16_t, WS_Z), WSP(bf16_t, WS_WT) + (size_t)(6144 + 2048 + 6144) * DM, WSP(bf16_t, WS_HB), WSP(bf16_t, WS_HB)); }
    if (IN(PH_GEMM4) && REPEAT_PH == PH_GEMM4) grid_barrier((unsigned*)ARG(ws), bst);
    if (IN(PH_GEMM4) && REPEAT_PH == PH_GEMM4) { const GemmCtx c = make_ctx(); const int gwave = blockIdx.x * 8 + c.wid, nwaves = gridDim.x * 8; (void)gwave; (void)nwaves;
        phase_gemm_resid<true>(lds, c, WSP(bf16_t, WS_Z), WSP(bf16_t, WS_WT) + (size_t)(6144 + 2048 + 6144) * DM, WSP(bf16_t, WS_HB), WSP(bf16_t, WS_HB)); }
    SEAM(PH_GEMM4)
    if (IN(PH_ROUTER1)) { const GemmCtx c = make_ctx(); const int gwave = blockIdx.x * 8 + c.wid, nwaves = gridDim.x * 8; (void)gwave; (void)nwaves;
        phase_router2(lds, c, WSP(bf16_t, WS_HB), ARG(ffn_norm) + DM, WSP(bf16_t, WS_WR) + (size_t)2 * 48 * DM, WSP(bf16_t, WS_A1), WSP(int, WS_TOKE) + 2 * NTOK, WSP(float, WS_TOKW) + 2 * NTOK, WSP(float, WS_TOKR) + NTOK); }
    if (IN(PH_ROUTER1) && REPEAT_PH == PH_ROUTER1) grid_barrier((unsigned*)ARG(ws), bst);
    if (IN(PH_ROUTER1) && REPEAT_PH == PH_ROUTER1) { const GemmCtx c = make_ctx(); const int gwave = blockIdx.x * 8 + c.wid, nwaves = gridDim.x * 8; (void)gwave; (void)nwaves;
        phase_router(lds, c, WSP(bf16_t, WS_HB), ARG(ffn_norm) + DM, ARG(router_group) + (size_t)DM * NG, ARG(router_expert) + (size_t)DM * NE, WSP(bf16_t, WS_A1), WSP(int, WS_TOKE) + 2 * NTOK, WSP(float, WS_TOKW) + 2 * NTOK, WSP(float, WS_TOKR) + NTOK); }
    SEAM(PH_ROUTER1)
    if (IN(PH_MOEA1)) { const GemmCtx c = make_ctx(); const int gwave = blockIdx.x * 8 + c.wid, nwaves = gridDim.x * 8; (void)gwave; (void)nwaves;
        phase_moe(lds, c, 1); }
    if (IN(PH_MOEA1) && IN(PH_COMBINE1)) grid_barrier((unsigned*)ARG(ws), bst);
    if (IN(PH_COMBINE1)) { const GemmCtx c = make_ctx(); const int gwave = blockIdx.x * 8 + c.wid, nwaves = gridDim.x * 8; (void)gwave; (void)nwaves;
        combine_rows2(WSP(bf16_t, WS_HB), WSP(bf16_t, WS_Y), nullptr, nullptr, nullptr, nullptr, nullptr, ARG(H), gwave, nwaves, c.lane); }
    if (IN(PH_COMBINE1) && REPEAT_PH == PH_COMBINE1) grid_barrier((unsigned*)ARG(ws), bst);
    if (IN(PH_COMBINE1) && REPEAT_PH == PH_COMBINE1) { const GemmCtx c = make_ctx(); const int gwave = blockIdx.x * 8 + c.wid, nwaves = gridDim.x * 8; (void)gwave; (void)nwaves;
        combine_rows2(WSP(bf16_t, WS_HB), WSP(bf16_t, WS_Y), nullptr, nullptr, nullptr, nullptr, nullptr, ARG(H), gwave, nwaves, c.lane); }
#undef IN
#undef SEAM
}

extern "C" void kernel_launch(void* const* d_in, const int* in_sizes, int n_in, void* d_out, int out_size, void* d_ws, size_t ws_size, hipStream_t stream) {
    const float* x = (const float*)d_in[0];
    const float* mix_norm = (const float*)d_in[1];
    const float* ffn_norm = (const float*)d_in[2];
    const float* conv_w_in = (const float*)d_in[3];
    const float* conv_w = (const float*)d_in[4];
    const float* conv_w_out = (const float*)d_in[5];
    const float* kv_norm = (const float*)d_in[6];
    const float* w_kv = (const float*)d_in[7];
    const float* k_norm = (const float*)d_in[8];
    const float* w_q = (const float*)d_in[9];
    const float* q_norm = (const float*)d_in[10];
    const float* w_o = (const float*)d_in[11];
    const float* router_group = (const float*)d_in[12];
    const float* router_expert = (const float*)d_in[13];
    const float* w_gate = (const float*)d_in[14];
    const float* w_up = (const float*)d_in[15];
    const float* w_down = (const float*)d_in[16];
    float* H = (float*)d_out;
    unsigned char* ws = (unsigned char*)d_ws;
    if (ws_size < WS_END) { fprintf(stderr, "workspace too small: %zu < %zu\n", ws_size, (size_t)WS_END); return; }
    int* cnt = (int*)(ws + WS_CNT);
    bf16_t* A1 = (bf16_t*)(ws + WS_A1); bf16_t* A2 = (bf16_t*)(ws + WS_A2);
    bf16_t* BCX = (bf16_t*)(ws + WS_BCX);
    bf16_t* Kb = (bf16_t*)(ws + WS_BCX); bf16_t* Vb = Kb + (size_t)NTOK * DM; bf16_t* Qb = Vb + (size_t)NTOK * DM;
    bf16_t* Z = (bf16_t*)(ws + WS_Z); bf16_t* ATT = Z;
    bf16_t* ACT = (bf16_t*)(ws + WS_ACT); bf16_t* Y = (bf16_t*)(ws + WS_Y);
    float* KM = (float*)(ws + WS_KMEAN);
    int* list = (int*)(ws + WS_LIST); float* tokw = (float*)(ws + WS_TOKW); int* toke = (int*)(ws + WS_TOKE);
    float* T = (float*)(ws + WS_T);
    const size_t nd = (size_t)NTOK * DM;
    static bool attr = false;
    if (!attr) { (void)hipFuncSetAttribute((const void*)mega, hipFuncAttributeMaxDynamicSharedMemorySize, LDS_BYTES); attr = true; }
    MegaArgs ma{};
    ma.x = x; ma.mix_norm = mix_norm; ma.ffn_norm = ffn_norm; ma.conv_w_in = conv_w_in; ma.conv_w = conv_w; ma.conv_w_out = conv_w_out;
    ma.kv_norm = kv_norm; ma.w_kv = w_kv; ma.k_norm = k_norm; ma.w_q = w_q; ma.q_norm = q_norm; ma.w_o = w_o;
    ma.router_group = router_group; ma.router_expert = router_expert; ma.w_gate = w_gate; ma.w_up = w_up; ma.w_down = w_down;
    ma.H = H; ma.ws = ws;
    static int grid = 0;
    if (!grid) {
        int dev = 0, cus = 0, per_cu = 0;
        (void)hipGetDevice(&dev);
        (void)hipDeviceGetAttribute(&cus, hipDeviceAttributeMultiprocessorCount, dev);
        (void)hipOccupancyMaxActiveBlocksPerMultiprocessor(&per_cu, (const void*)mega, 512, LDS_BYTES);
        if (per_cu < 1) per_cu = 1;
        grid = cus * 1;
        if (grid > 256) grid = 256;
    }
    (void)hipMemsetAsync(ws + WS_CTL, 0, 16384, stream);
    ma.ph_lo = 0; ma.ph_hi = PH_END;
    void* kargs[] = {&ma};
    hipError_t le = hipLaunchCooperativeKernel((const void*)mega, dim3(grid), dim3(512), kargs, LDS_BYTES, stream);
    if (le != hipSuccess) fprintf(stderr, "cooperative launch failed: %s (grid %d)\n", hipGetErrorString(le), grid);
}
```

```cpp
#include <hip/hip_runtime.h>
#include <cstdint>
#include <cstddef>
#include <cstdio>

constexpr int NTOK = 8192, DM = 2048, SEQ = 2048, NBATCH = 4, NH = 16, HD = 128, NBLK = 8, BLK = 256;
constexpr int NE = 32, DE = 512, NG = 4, EPG = 8;
constexpr float EPS = 1e-6f;
constexpr int LDP = DM + 128;

typedef unsigned short bf16_t;
typedef float f32x4 __attribute__((ext_vector_type(4)));

constexpr size_t MB = 1024 * 1024;
constexpr size_t WS_CTL = 0;
constexpr size_t WS_CNT = 64 * 1024;
constexpr size_t WS_A1 = 1 * MB;
constexpr size_t WS_A2 = WS_A1 + 36 * MB;
constexpr size_t WS_BCX = WS_A2 + 36 * MB;
constexpr size_t WS_Z = WS_BCX + 96 * MB;
constexpr size_t WS_ACT = WS_Z + 36 * MB;
constexpr size_t WS_Y = WS_ACT + 16 * MB;
constexpr size_t WS_KMEAN = WS_Y + 64 * MB;
constexpr size_t WS_LIST = WS_KMEAN + 1 * MB;
constexpr size_t WS_TOKW = WS_LIST + 2 * MB;
constexpr size_t WS_TOKE = WS_TOKW + 1 * MB;
constexpr size_t WS_T = WS_TOKE + 1 * MB;
constexpr size_t WS_WT = WS_T;
constexpr size_t WS_HB = WS_T + 96 * MB;
constexpr size_t WS_TOKR = WS_TOKW + 512 * 1024;
constexpr size_t WS_END = WS_T + 192 * MB;

__device__ __forceinline__ unsigned pk2(float lo, float hi) {
    typedef float f2 __attribute__((ext_vector_type(2)));
    typedef __bf16 b2 __attribute__((ext_vector_type(2)));
    f2 v = {lo, hi}; b2 b = __builtin_convertvector(v, b2); return __builtin_bit_cast(unsigned, b);
}
__device__ __forceinline__ float bflo(unsigned u) { return __uint_as_float(u << 16); }
__device__ __forceinline__ float bfhi(unsigned u) { return __uint_as_float(u & 0xffff0000u); }
__device__ __forceinline__ float bf2f(bf16_t b) { return __uint_as_float((unsigned)b << 16); }
__device__ __forceinline__ float wave_sum(float v) {
#pragma unroll
    for (int o = 1; o < 64; o <<= 1) v += __shfl_xor(v, o);
    return v;
}
__device__ __forceinline__ float wave_max(float v) {
#pragma unroll
    for (int o = 1; o < 64; o <<= 1) v = fmaxf(v, __shfl_xor(v, o));
    return v;
}

__device__ __forceinline__ size_t stg_off(int row, int k) {
    const int r = row & 255;
    return ((size_t)((row >> 8) * 64 + (k >> 5)) * 8192) + (size_t)((r * 64 + (((((k & 31) >> 3)) ^ ((0 - (r >> 2)) & 3)) << 4)) >> 1) + (k & 7);
}
__device__ __forceinline__ void norm_rows(const float* __restrict__ src, const float* g1, bf16_t* o1, const float* g2, bf16_t* o2,
                                          int gwave, int nwaves, int lane) {
    for (int row = gwave; row < NTOK; row += nwaves) {
        const f32x4* p = (const f32x4*)(src + (size_t)row * DM);
        f32x4 v[8]; float ss = 0.f;
#pragma unroll
        for (int i = 0; i < 8; ++i) { v[i] = p[lane + 64 * i]; ss += v[i][0] * v[i][0] + v[i][1] * v[i][1] + v[i][2] * v[i][2] + v[i][3] * v[i][3]; }
        ss = wave_sum(ss);
        const float r = rsqrtf(ss * (1.0f / DM) + EPS);
#pragma unroll
        for (int i = 0; i < 8; ++i) {
            const int c = 4 * (lane + 64 * i);
            const f32x4 g = *(const f32x4*)(g1 + c);
            uint2 o; o.x = pk2(v[i][0] * r * g[0], v[i][1] * r * g[1]); o.y = pk2(v[i][2] * r * g[2], v[i][3] * r * g[3]);
            *(uint2*)(o1 + stg_off(row, c)) = o;
            if (g2) {
                const f32x4 h = *(const f32x4*)(g2 + c);
                uint2 q; q.x = pk2(v[i][0] * r * h[0], v[i][1] * r * h[1]); q.y = pk2(v[i][2] * r * h[2], v[i][3] * r * h[3]);
                *(uint2*)(o2 + stg_off(row, c)) = q;
            }
        }
    }
}

__device__ __forceinline__ void combine_rows(float* H, const bf16_t* __restrict__ Y, const float* g1, bf16_t* o1, const float* g2, bf16_t* o2,
                                             int gwave, int nwaves, int lane) {
    for (int row = gwave; row < NTOK; row += nwaves) {
        f32x4* p = (f32x4*)(H + (size_t)row * DM);
        const uint2* y0 = (const uint2*)(Y + (size_t)(2 * row) * DM);
        const uint2* y1 = (const uint2*)(Y + (size_t)(2 * row + 1) * DM);
        f32x4 v[8]; float ss = 0.f;
#pragma unroll
        for (int i = 0; i < 8; ++i) {
            v[i] = p[lane + 64 * i];
            const uint2 a = y0[lane + 64 * i], b = y1[lane + 64 * i];
            v[i][0] += bflo(a.x) + bflo(b.x); v[i][1] += bfhi(a.x) + bfhi(b.x);
            v[i][2] += bflo(a.y) + bflo(b.y); v[i][3] += bfhi(a.y) + bfhi(b.y);
            p[lane + 64 * i] = v[i];
            ss += v[i][0] * v[i][0] + v[i][1] * v[i][1] + v[i][2] * v[i][2] + v[i][3] * v[i][3];
        }
        if (g1) {
            ss = wave_sum(ss);
            const float r = rsqrtf(ss * (1.0f / DM) + EPS);
#pragma unroll
            for (int i = 0; i < 8; ++i) {
                const int c = 4 * (lane + 64 * i);
                if (g2 == nullptr) {
                    uint2 o; o.x = pk2(v[i][0] * r, v[i][1] * r); o.y = pk2(v[i][2] * r, v[i][3] * r);
                    *(uint2*)(o1 + stg_off(row, c)) = o;
                } else {
                    const f32x4 g = *(const f32x4*)(g1 + c);
                    uint2 o; o.x = pk2(v[i][0] * r * g[0], v[i][1] * r * g[1]); o.y = pk2(v[i][2] * r * g[2], v[i][3] * r * g[3]);
                    *(uint2*)(o1 + stg_off(row, c)) = o;
                    const f32x4 h = *(const f32x4*)(g2 + c);
                    uint2 q; q.x = pk2(v[i][0] * r * h[0], v[i][1] * r * h[1]); q.y = pk2(v[i][2] * r * h[2], v[i][3] * r * h[3]);
                    *(uint2*)(o2 + stg_off(row, c)) = q;
                }
            }
        }
    }
}

__device__ __forceinline__ void combine_rows2(const bf16_t* __restrict__ HBin, const bf16_t* __restrict__ Y, const float* g1, bf16_t* o1, const float* g2, bf16_t* o2,
                                              bf16_t* HBout, float* OUT, int gwave, int nwaves, int lane) {
    for (int row = gwave; row < NTOK; row += nwaves) {
        const uint2* hp = (const uint2*)(HBin + (size_t)row * DM);
        const uint2* y0 = (const uint2*)(Y + (size_t)(2 * row) * DM);
        const uint2* y1 = (const uint2*)(Y + (size_t)(2 * row + 1) * DM);
        f32x4 v[8]; float ss = 0.f;
#pragma unroll
        for (int i = 0; i < 8; ++i) {
            const uint2 h = hp[lane + 64 * i], a = y0[lane + 64 * i], b = y1[lane + 64 * i];
            v[i][0] = bflo(h.x) + (bflo(a.x) + bflo(b.x)); v[i][1] = bfhi(h.x) + (bfhi(a.x) + bfhi(b.x));
            v[i][2] = bflo(h.y) + (bflo(a.y) + bflo(b.y)); v[i][3] = bfhi(h.y) + (bfhi(a.y) + bfhi(b.y));
            if (HBout) { uint2 o; o.x = pk2(v[i][0], v[i][1]); o.y = pk2(v[i][2], v[i][3]); *(uint2*)(HBout + (size_t)row * DM + 4 * (lane + 64 * i)) = o; }
            if (OUT) *(f32x4*)(OUT + (size_t)row * DM + 4 * (lane + 64 * i)) = v[i];
            ss += v[i][0] * v[i][0] + v[i][1] * v[i][1] + v[i][2] * v[i][2] + v[i][3] * v[i][3];
        }
        if (g1) {
            ss = wave_sum(ss);
            const float r = rsqrtf(ss * (1.0f / DM) + EPS);
#pragma unroll
            for (int i = 0; i < 8; ++i) {
                const int c = 4 * (lane + 64 * i);
                if (g2 == nullptr) {
                    uint2 o; o.x = pk2(v[i][0] * r, v[i][1] * r); o.y = pk2(v[i][2] * r, v[i][3] * r);
                    *(uint2*)(o1 + stg_off(row, c)) = o;
                } else {
                    const f32x4 g = *(const f32x4*)(g1 + c);
                    uint2 o; o.x = pk2(v[i][0] * r * g[0], v[i][1] * r * g[1]); o.y = pk2(v[i][2] * r * g[2], v[i][3] * r * g[3]);
                    *(uint2*)(o1 + stg_off(row, c)) = o;
                    const f32x4 h = *(const f32x4*)(g2 + c);
                    uint2 q; q.x = pk2(v[i][0] * r * h[0], v[i][1] * r * h[1]); q.y = pk2(v[i][2] * r * h[2], v[i][3] * r * h[3]);
                    *(uint2*)(o2 + stg_off(row, c)) = q;
                }
            }
        }
    }
}

__device__ __forceinline__ void conv_phase(const bf16_t* __restrict__ Bb, const bf16_t* __restrict__ U, const float* __restrict__ cw, bf16_t* Z, int gthread, int nthreads) {
    for (int item = gthread; item < (NTOK / 16) * (DM / 8); item += nthreads) {
        const int co = item & 255, trun = item >> 8;
        const int t0 = trun * 16, s0 = t0 & (SEQ - 1);
        const int c0 = co * 8;
        float w0[8], w1[8], w2[8];
#pragma unroll
        for (int e = 0; e < 8; ++e) { w0[e] = cw[c0 + e]; w1[e] = cw[DM + c0 + e]; w2[e] = cw[2 * DM + c0 + e]; }
        float um2[8], um1[8];
#pragma unroll
        for (int e = 0; e < 8; ++e) { um2[e] = 0.f; um1[e] = 0.f; }
        if (s0 >= 2) {
            const uint4 a = *(const uint4*)(U + (size_t)(t0 - 2) * DM + c0), b = *(const uint4*)(U + (size_t)(t0 - 1) * DM + c0);
            const unsigned av[4] = {a.x, a.y, a.z, a.w}, bv[4] = {b.x, b.y, b.z, b.w};
#pragma unroll
            for (int e = 0; e < 4; ++e) { um2[2 * e] = bflo(av[e]); um2[2 * e + 1] = bfhi(av[e]); um1[2 * e] = bflo(bv[e]); um1[2 * e + 1] = bfhi(bv[e]); }
        }
        for (int t = t0; t < t0 + 16; ++t) {
            const uint4 bg = *(const uint4*)(Bb + (size_t)t * DM + c0), uu = *(const uint4*)(U + (size_t)t * DM + c0);
            const unsigned bgv[4] = {bg.x, bg.y, bg.z, bg.w}, uv[4] = {uu.x, uu.y, uu.z, uu.w};
            unsigned ov[4];
#pragma unroll
            for (int e = 0; e < 4; ++e) {
                const float ua = bflo(uv[e]), ub = bfhi(uv[e]);
                const float ca = w0[2 * e] * um2[2 * e] + w1[2 * e] * um1[2 * e] + w2[2 * e] * ua;
                const float cb = w0[2 * e + 1] * um2[2 * e + 1] + w1[2 * e + 1] * um1[2 * e + 1] + w2[2 * e + 1] * ub;
                ov[e] = pk2(bflo(bgv[e]) * ca, bfhi(bgv[e]) * cb);
                um2[2 * e] = um1[2 * e]; um2[2 * e + 1] = um1[2 * e + 1]; um1[2 * e] = ua; um1[2 * e + 1] = ub;
            }
            *(uint4*)(Z + stg_off(t, c0)) = make_uint4(ov[0], ov[1], ov[2], ov[3]);
        }
    }
}

__global__ void __launch_bounds__(512) k_prep(const float* x, const float* g, bf16_t* a1, int* cnt) {
    const int gt = blockIdx.x * 512 + threadIdx.x;
    if (gt < 2 * NE) cnt[gt] = 0;
    norm_rows(x, g, a1, nullptr, nullptr, gt >> 6, (gridDim.x * 512) >> 6, threadIdx.x & 63);
}
__global__ void __launch_bounds__(512) k_conv(const bf16_t* BCX, const float* cw, bf16_t* Z) {
    conv_phase(BCX, BCX + (size_t)NTOK * DM, cw, Z, blockIdx.x * 512 + threadIdx.x, gridDim.x * 512);
}
__global__ void __launch_bounds__(512) k_combine(float* H, const bf16_t* Y, const float* g1, bf16_t* o1, const float* g2, bf16_t* o2) {
    const int gt = blockIdx.x * 512 + threadIdx.x;
    combine_rows(H, Y, g1, o1, g2, o2, gt >> 6, (gridDim.x * 512) >> 6, threadIdx.x & 63);
}

__global__ void __launch_bounds__(512) naive_gemm(const bf16_t* __restrict__ A, const float* __restrict__ W, float* T, int N, int ldt, int coff) {
    __shared__ float sA[4 * DM];
    const int tid = threadIdx.x, n = blockIdx.x * 512 + tid;
    for (int half = 0; half < 2; ++half) {
    const int m0 = blockIdx.y * 8 + half * 4;
    __syncthreads();
    for (int i = tid; i < 4 * DM; i += 512) sA[i] = bf2f(A[(size_t)(m0 + (i >> 11)) * DM + (i & 2047)]);
    __syncthreads();
    float acc[4];
#pragma unroll
    for (int r = 0; r < 4; ++r) acc[r] = 0.f;
    for (int k = 0; k < DM; k += 4) {
        const float w0 = W[(size_t)k * N + n], w1 = W[(size_t)(k + 1) * N + n], w2 = W[(size_t)(k + 2) * N + n], w3 = W[(size_t)(k + 3) * N + n];
#pragma unroll
        for (int r = 0; r < 4; ++r) { const f32x4 a = *(const f32x4*)&sA[r * DM + k]; acc[r] += a[0] * w0 + a[1] * w1 + a[2] * w2 + a[3] * w3; }
    }
#pragma unroll
    for (int r = 0; r < 4; ++r) T[(size_t)(m0 + r) * ldt + coff + n] = acc[r];
    }
}
__global__ void naive_epi_bf16(const float* T, bf16_t* O, size_t n) { size_t i = (size_t)blockIdx.x * blockDim.x + threadIdx.x; if (i < n) O[i] = (bf16_t)(pk2(T[i], 0.f) & 0xffff); }
__global__ void naive_epi_resid(const float* R, const float* T, float* H, size_t n) { size_t i = (size_t)blockIdx.x * blockDim.x + threadIdx.x; if (i < n) H[i] = R[i] + T[i]; }
__global__ void __launch_bounds__(256) naive_epi_kvq(const float* T, const float* kn, const float* qn, bf16_t* Kb, bf16_t* Vb, bf16_t* Qb) {
    const int gw = (blockIdx.x * 256 + threadIdx.x) >> 6, lane = threadIdx.x & 63;
    if (gw >= NTOK * 48) return;
    const int tok = gw / 48, rem = gw % 48, which = rem / 16, h = rem % 16;
    const float* src = T + (size_t)tok * 6144 + which * 2048 + h * 128 + 2 * lane;
    float v0 = src[0], v1 = src[1];
    if (which != 1) {
        const float ss = wave_sum(v0 * v0 + v1 * v1);
        const float r = rsqrtf(ss * (1.0f / HD) + EPS);
        const float* g = (which == 0) ? kn : qn;
        v0 = v0 * r * g[2 * lane]; v1 = v1 * r * g[2 * lane + 1];
    }
    const int b = tok / SEQ, s = tok % SEQ;
    bf16_t* dst = (which == 0 ? Kb : (which == 1 ? Vb : Qb)) + ((size_t)(b * NH + h) * SEQ + s) * HD + 2 * lane;
    *(unsigned*)dst = pk2(v0, v1);
}
__global__ void naive_kmean(const bf16_t* Kb, float* KM) {
    const int i = blockIdx.x * blockDim.x + threadIdx.x;
    if (i >= NBATCH * NH * NBLK * HD) return;
    const int d = i & 127, blk = (i >> 7) & 7, bh = i >> 10;
    float s = 0.f;
    for (int r = 0; r < BLK; ++r) s += bf2f(Kb[((size_t)bh * SEQ + blk * BLK + r) * HD + d]);
    KM[i] = s * (1.0f / BLK);
}

__global__ void __launch_bounds__(256) naive_router(const float* __restrict__ H, const float* g, const float* __restrict__ wrg, const float* __restrict__ wre,
                                                    bf16_t* AF, int* cnt, int* list, float* tokw, int* toke) {
    const int tok = (blockIdx.x * 256 + threadIdx.x) >> 6, lane = threadIdx.x & 63;
    if (tok >= NTOK) return;
    const f32x4* p = (const f32x4*)(H + (size_t)tok * DM);
    f32x4 v[8]; float ss = 0.f;
#pragma unroll
    for (int i = 0; i < 8; ++i) { v[i] = p[lane + 64 * i]; ss += v[i][0] * v[i][0] + v[i][1] * v[i][1] + v[i][2] * v[i][2] + v[i][3] * v[i][3]; }
    ss = wave_sum(ss);
    const float r = rsqrtf(ss * (1.0f / DM) + EPS);
    float acc[36];
#pragma unroll
    for (int c = 0; c < 36; ++c) acc[c] = 0.f;
#pragma unroll
    for (int i = 0; i < 8; ++i) {
        const int c0 = 4 * (lane + 64 * i);
        const f32x4 gg = *(const f32x4*)(g + c0);
        f32x4 y; y[0] = v[i][0] * r * gg[0]; y[1] = v[i][1] * r * gg[1]; y[2] = v[i][2] * r * gg[2]; y[3] = v[i][3] * r * gg[3];
        uint2 o; o.x = pk2(y[0], y[1]); o.y = pk2(y[2], y[3]);
        *(uint2*)(AF + (size_t)tok * DM + c0) = o;
#pragma unroll
        for (int e = 0; e < 4; ++e) {
            const int k = c0 + e;
            const f32x4 wg = *(const f32x4*)(wrg + (size_t)k * 4);
#pragma unroll
            for (int c = 0; c < 4; ++c) acc[c] += y[e] * wg[c];
#pragma unroll
            for (int q = 0; q < 8; ++q) {
                const f32x4 w = *(const f32x4*)(wre + (size_t)k * 32 + 4 * q);
#pragma unroll
                for (int c = 0; c < 4; ++c) acc[4 + 4 * q + c] += y[e] * w[c];
            }
        }
    }
#pragma unroll
    for (int c = 0; c < 36; ++c) acc[c] = wave_sum(acc[c]);
    if (lane == 0) {
        int gs = 0; float gm = acc[0];
#pragma unroll
        for (int c = 1; c < 4; ++c) if (acc[c] > gm) { gm = acc[c]; gs = c; }
        float den = 0.f;
#pragma unroll
        for (int c = 0; c < 4; ++c) den += __expf(acc[c] - gm);
        const float gw = 1.0f / den;
        float el[8];
#pragma unroll
        for (int c = 0; c < 8; ++c) {
            float x = 0.f;
#pragma unroll
            for (int gg = 0; gg < 4; ++gg) x = (gs == gg) ? acc[4 + gg * 8 + c] : x;
            el[c] = x;
        }
        int i0 = 0; float t0 = el[0];
#pragma unroll
        for (int c = 1; c < 8; ++c) if (el[c] > t0) { t0 = el[c]; i0 = c; }
        int i1 = -1; float t1 = -INFINITY;
#pragma unroll
        for (int c = 0; c < 8; ++c) if (c != i0 && el[c] > t1) { t1 = el[c]; i1 = c; }
        const float e1 = __expf(t1 - t0);
        const float w0 = gw / (1.0f + e1), w1 = gw * e1 / (1.0f + e1);
        const int ex0 = gs * 8 + i0, ex1 = gs * 8 + i1;
        tokw[tok * 2] = w0; tokw[tok * 2 + 1] = w1; toke[tok * 2] = ex0; toke[tok * 2 + 1] = ex1;
    }
}

__global__ void __launch_bounds__(512) naive_build_lists(const int* toke, int* cnt, int* list) {
    __shared__ int part[512];
    const int e = blockIdx.x, tid = threadIdx.x;
    int c = 0;
    for (int i = 0; i < 32; ++i) c += (toke[tid * 32 + i] == e);
    part[tid] = c;
    __syncthreads();
    int off = 0;
    for (int j = 0; j < tid; ++j) off += part[j];
    for (int i = 0; i < 32; ++i) if (toke[tid * 32 + i] == e) list[e * NTOK + off++] = tid * 32 + i;
    if (tid == 511) cnt[e] = off;
}
__global__ void __launch_bounds__(512) naive_moe_a(const bf16_t* __restrict__ AF, const float* __restrict__ Wg, const float* __restrict__ Wu,
                                                   const int* cnt, const int* list, bf16_t* ACT) {
    __shared__ float sA[4 * DM];
    __shared__ int srs[8];
    const int e = blockIdx.y, c0 = blockIdx.x * 4, n = cnt[e], tid = threadIdx.x;
    if (c0 >= n) return;
    if (tid < 4) srs[tid] = (c0 + tid < n) ? list[e * NTOK + c0 + tid] : -1;
    __syncthreads();
    for (int i = tid; i < 4 * DM; i += 512) { const int sr = srs[i >> 11]; sA[i] = sr >= 0 ? bf2f(AF[(size_t)(sr >> 1) * DM + (i & 2047)]) : 0.f; }
    __syncthreads();
    float ag[4], au[4];
#pragma unroll
    for (int r = 0; r < 4; ++r) { ag[r] = 0.f; au[r] = 0.f; }
    const float* wg = Wg + (size_t)e * DM * DE + tid; const float* wu = Wu + (size_t)e * DM * DE + tid;
    for (int k = 0; k < DM; k += 4) {
        float g4[4], u4[4];
#pragma unroll
        for (int q = 0; q < 4; ++q) { g4[q] = wg[(size_t)(k + q) * DE]; u4[q] = wu[(size_t)(k + q) * DE]; }
#pragma unroll
        for (int r = 0; r < 4; ++r) { const f32x4 a = *(const f32x4*)&sA[r * DM + k];
            ag[r] += a[0] * g4[0] + a[1] * g4[1] + a[2] * g4[2] + a[3] * g4[3];
            au[r] += a[0] * u4[0] + a[1] * u4[1] + a[2] * u4[2] + a[3] * u4[3]; }
    }
#pragma unroll
    for (int r = 0; r < 4; ++r) { const int sr = srs[r]; if (sr >= 0) { const float gv = ag[r]; const float a = gv / (1.0f + __expf(-gv)) * au[r];
        ACT[(size_t)sr * DE + tid] = (bf16_t)(pk2(a, 0.f) & 0xffff); } }
}
__global__ void __launch_bounds__(512) naive_moe_b(const bf16_t* __restrict__ ACT, const float* __restrict__ Wd, const int* cnt, const int* list,
                                                   const float* tokw, bf16_t* Y) {
    __shared__ float sA[8 * DE];
    __shared__ int srs[8];
    const int e = blockIdx.y, c0 = blockIdx.x * 8, n = cnt[e], tid = threadIdx.x;
    if (c0 >= n) return;
    if (tid < 8) srs[tid] = (c0 + tid < n) ? list[e * NTOK + c0 + tid] : -1;
    __syncthreads();
    for (int i = tid; i < 8 * DE; i += 512) { const int sr = srs[i >> 9]; sA[i] = sr >= 0 ? bf2f(ACT[(size_t)sr * DE + (i & 511)]) : 0.f; }
    __syncthreads();
    float acc[8][4];
#pragma unroll
    for (int r = 0; r < 8; ++r)
#pragma unroll
        for (int q = 0; q < 4; ++q) acc[r][q] = 0.f;
    const float* wd = Wd + (size_t)e * DE * DM + tid;
    for (int k = 0; k < DE; ++k) {
        float w[4];
#pragma unroll
        for (int q = 0; q < 4; ++q) w[q] = wd[(size_t)k * DM + 512 * q];
#pragma unroll
        for (int r = 0; r < 8; ++r) { const float a = sA[r * DE + k];
#pragma unroll
            for (int q = 0; q < 4; ++q) acc[r][q] += a * w[q]; }
    }
#pragma unroll
    for (int r = 0; r < 8; ++r) { const int sr = srs[r]; if (sr >= 0) { const float w = tokw[sr];
#pragma unroll
        for (int q = 0; q < 4; ++q) Y[(size_t)sr * DM + tid + 512 * q] = (bf16_t)(pk2(acc[r][q] * w, 0.f) & 0xffff); } }
}

__global__ void __launch_bounds__(256) naive_attn(const bf16_t* __restrict__ Qb, const bf16_t* __restrict__ Kb, const bf16_t* __restrict__ Vb,
                                                  const float* __restrict__ KM, bf16_t* ATT) {
    const int gw = (blockIdx.x * 256 + threadIdx.x) >> 6, lane = threadIdx.x & 63;
    if (gw >= NBATCH * NH * SEQ) return;
    const int s = gw % SEQ, bh = gw / SEQ, h = bh % NH, b = bh / NH;
    const int i = s / BLK;
    const unsigned qq = *(const unsigned*)(Qb + ((size_t)bh * SEQ + s) * HD + 2 * lane);
    const float q0 = bflo(qq), q1 = bfhi(qq);
    float gate[8];
#pragma unroll
    for (int n = 0; n < 8; ++n) {
        const float* km = KM + ((size_t)bh * NBLK + n) * HD + 2 * lane;
        gate[n] = wave_sum(q0 * km[0] + q1 * km[1]);
    }
    unsigned sel = 0;
#pragma unroll
    for (int n = 0; n < 8; ++n) {
        int rank = 0;
#pragma unroll
        for (int m = 0; m < 8; ++m) if (m < i && m != n && (gate[m] > gate[n] || (gate[m] == gate[n] && m < n))) ++rank;
        if (n < i && rank < 3) sel |= 1u << n;
    }
    const float slope = exp2f(-8.0f * (float)(h + 1) / (float)NH);
    const float scale = 0.08838834764831845f;
    float m = -INFINITY, l = 0.f, o0 = 0.f, o1 = 0.f;
    for (int jj = 0; jj <= i; ++jj) {
        const int j = (jj == 0) ? i : jj - 1;
        if (j != i && !((sel >> j) & 1)) continue;
        for (int c = 0; c < 4; ++c) {
            const int kbase = j * BLK + c * 64;
            if (j == i && kbase > s) break;
            const int kk = kbase + lane;
            const bf16_t* krow = Kb + ((size_t)bh * SEQ + kk) * HD;
            float dot = 0.f;
            for (int d2 = 0; d2 < 64; ++d2) {
                const float qa = __shfl(q0, d2), qb = __shfl(q1, d2);
                const unsigned kv = *(const unsigned*)(krow + 2 * d2);
                dot += qa * bflo(kv) + qb * bfhi(kv);
            }
            const bool valid = (j < i) || (kk <= s);
            const float sc = valid ? dot * scale - slope * (float)(s - kk) : -INFINITY;
            const float mx = wave_max(sc);
            const float mn = fmaxf(m, mx);
            const float p = valid ? __expf(sc - mn) : 0.f;
            const float alpha = __expf(m - mn);
            l = l * alpha + wave_sum(p);
            o0 *= alpha; o1 *= alpha; m = mn;
            for (int t = 0; t < 64; ++t) {
                const float pt = __shfl(p, t);
                const unsigned vv = *(const unsigned*)(Vb + ((size_t)bh * SEQ + kbase + t) * HD + 2 * lane);
                o0 += pt * bflo(vv); o1 += pt * bfhi(vv);
            }
        }
    }
    const float inv = 1.0f / l;
    *(unsigned*)(ATT + ((size_t)(b * SEQ + s)) * DM + h * HD + 2 * lane) = pk2(o0 * inv, o1 * inv);
}


#define LAS __attribute__((address_space(3)))
typedef short bf16x8 __attribute__((ext_vector_type(8)));
typedef unsigned u32x4 __attribute__((ext_vector_type(4)));
constexpr int LDS_GEMM = 131072;
constexpr int LDS_MISC = LDS_GEMM;
constexpr int LDS_BYTES = LDS_GEMM + 8192;

__device__ __forceinline__ int lds_off(int row, int chunk) { return row * 128 + ((chunk ^ (((row >> 1) & 7) ^ ((row >> 4) & 1))) << 4); }

struct GemmCtx { int tid, lane, wid, wr, wc, fr, fq; };
__device__ __forceinline__ GemmCtx make_ctx() {
    GemmCtx c; int t = threadIdx.x; asm volatile("" : "+v"(t));
    c.tid = t; c.lane = c.tid & 63; c.wid = __builtin_amdgcn_readfirstlane(c.tid >> 6);
    c.wr = c.wid >> 1; c.wc = c.wid & 1; c.fr = c.lane & 15; c.fq = c.lane >> 4; return c;
}

__device__ __forceinline__ int a_chunk_off(int tid) { const int r = tid >> 3; return (((tid & 7) ^ (((r >> 1) & 7) ^ ((r >> 4) & 1))) << 3); }
template <int ABL = 0> __device__ __forceinline__ void gemm_tile_f32w(LAS unsigned char* lds, const GemmCtx& c, const bf16_t* Abase, const unsigned (&aoff)[4], const float* Bbase, unsigned boff0,
                                               int brow0, int bkg, int ldw, int nk, f32x4 (&acc)[4][8]) {
#pragma unroll
    for (int mi = 0; mi < 4; ++mi)
#pragma unroll
        for (int ni = 0; ni < 8; ++ni) acc[mi][ni] = (f32x4){0.f, 0.f, 0.f, 0.f};
    LAS unsigned char* bw0 = lds + 65536 + lds_off(brow0, bkg);
    LAS unsigned char* bw2 = lds + 65536 + lds_off(brow0 + 2, bkg);
    typedef const __attribute__((address_space(1))) f32x4* gf4p;
    const __attribute__((address_space(1))) char* Bg = (const __attribute__((address_space(1))) char*)Bbase;
    const __attribute__((address_space(1))) char* Ag = (const __attribute__((address_space(1))) char*)Abase;
    const int x0 = c.fq ^ (c.fr >> 1);
    int foff[2][2];
#pragma unroll
    for (int par = 0; par < 2; ++par)
#pragma unroll
        for (int k32 = 0; k32 < 2; ++k32) foff[par][k32] = c.fr * 128 + ((x0 ^ (k32 * 4 + par)) << 4);
    const int abase = (c.wr * 64) * 128, bbase = 65536 + (c.wc * 128) * 128;
    LAS unsigned char* adst = lds + c.tid * 16;
    const unsigned ldw4 = (unsigned)ldw * 4u;

    f32x4 rb[8];
    auto gload = [&](int kt, int buf) {
#pragma unroll
        for (int i = 0; i < 4; ++i)
            if (ABL != 3) __builtin_amdgcn_global_load_lds((const __attribute__((address_space(1))) unsigned*)(Ag + (size_t)((aoff[i] + (unsigned)kt * 64u) * 2u)), (LAS unsigned*)(adst + buf * 32768 + i * 8192), 16, 0, 0);
        const unsigned vo = boff0 * 4u;
#pragma unroll
        for (int j = 0; j < 8; ++j) { if (ABL != 2) rb[j] = *(gf4p)((Bg + (size_t)((unsigned)(kt * 64 + j) * ldw4)) + (size_t)vo); else rb[j] = (f32x4){1.f, 2.f, 3.f, (float)kt}; }
    };
    auto lstore = [&](int buf) {
#pragma unroll
        for (int i = 0; i < 4; ++i) {
            u32x4 w; w[0] = pk2(rb[0][i], rb[1][i]); w[1] = pk2(rb[2][i], rb[3][i]); w[2] = pk2(rb[4][i], rb[5][i]); w[3] = pk2(rb[6][i], rb[7][i]);
            *(LAS u32x4*)((i < 2 ? bw0 : bw2) + buf * 32768 + (i & 1) * 128) = w;
        }
    };
    gload(0, 0); lstore(0);
    asm volatile("s_waitcnt vmcnt(0)" ::: "memory");
    __syncthreads();
    for (int kt = 0; kt < nk; ++kt) {
        const int cur = kt & 1;
        if (kt + 1 < nk) gload(kt + 1, cur ^ 1);
#pragma unroll
        for (int k32 = 0; k32 < 2; ++k32) {
            bf16x8 af[4];
#pragma unroll
            for (int mi = 0; mi < 4; ++mi) af[mi] = *(const LAS bf16x8*)(lds + cur * 32768 + abase + mi * 2048 + foff[mi & 1][k32]);
#pragma unroll
            for (int ni = 0; ni < 8; ++ni) {
                const bf16x8 bfr = *(const LAS bf16x8*)(lds + cur * 32768 + bbase + ni * 2048 + foff[ni & 1][k32]);
#pragma unroll
                for (int mi = 0; mi < 4; ++mi) { if (ABL != 1) acc[mi][ni] = __builtin_amdgcn_mfma_f32_16x16x32_bf16(bfr, af[mi], acc[mi][ni], 0, 0, 0); else { acc[mi][ni][0] += __builtin_bit_cast(float, (int)bfr[0]) ; acc[mi][ni][1] += __builtin_bit_cast(float, (int)af[mi][0]); } }
            }
        }
        if (kt + 1 < nk) lstore(cur ^ 1);
        asm volatile("s_waitcnt vmcnt(0)" ::: "memory");
        __syncthreads();
    }
}

__device__ __forceinline__ void gemm_tile_bf16(LAS unsigned char* lds, const GemmCtx& c, const bf16_t* Abase, unsigned aoff0, unsigned aoff1, const bf16_t* Bbase, unsigned boff0, unsigned boff1,
                                               int nk, f32x4 (&acc)[4][8], unsigned bstage = 32u, unsigned astage = 32u,
                                               bool pre = false, bool nxt = false, const bf16_t* An = nullptr, unsigned na0 = 0u, unsigned nb0 = 0u) {
#pragma unroll
    for (int mi = 0; mi < 4; ++mi)
#pragma unroll
        for (int ni = 0; ni < 8; ++ni) acc[mi][ni] = (f32x4){0.f, 0.f, 0.f, 0.f};
    typedef const __attribute__((address_space(1))) unsigned* gu32p;
    const __attribute__((address_space(1))) char* Ag = (const __attribute__((address_space(1))) char*)Abase;
    const __attribute__((address_space(1))) char* Bg = (const __attribute__((address_space(1))) char*)Bbase;
    LAS unsigned char* dst = lds + c.tid * 16;
    const int fo = c.fr * 64 + ((c.fq ^ ((0 - (c.fr >> 2)) & 3)) << 4);
    LAS unsigned char* fa = lds + c.wr * 4096 + fo;
    LAS unsigned char* fb = lds + 16384 + c.wc * 8192 + fo;
    auto issue = [&](int kt) {
        const int st = (kt & 3) * 32768;
        const unsigned ko = (unsigned)kt * astage, kb = (unsigned)kt * bstage;
        __builtin_amdgcn_global_load_lds((gu32p)(Ag + (size_t)((aoff0 + ko) * 2u)), (LAS unsigned*)(dst + st), 16, 0, 0);
        __builtin_amdgcn_global_load_lds((gu32p)(Ag + (size_t)((aoff1 + ko) * 2u)), (LAS unsigned*)(dst + st + 8192), 16, 0, 0);
        __builtin_amdgcn_global_load_lds((gu32p)(Bg + (size_t)((boff0 + kb) * 2u)), (LAS unsigned*)(dst + st + 16384), 16, 0, 0);
        __builtin_amdgcn_global_load_lds((gu32p)(Bg + (size_t)((boff1 + kb) * 2u)), (LAS unsigned*)(dst + st + 16384 + 8192), 16, 0, 0);
    };
#define RING_BAR() do { __builtin_amdgcn_sched_barrier(0); __builtin_amdgcn_s_barrier(); __builtin_amdgcn_sched_barrier(0); asm volatile("" ::: "memory"); } while (0)
    const bool g1 = c.wid >= 4;
    if (!pre) { issue(0); issue(1); issue(2); }
    asm volatile("s_waitcnt vmcnt(8)" ::: "memory");
    RING_BAR();
    if (g1) RING_BAR();
    for (int s = 0; s < nk; ++s) {
        const int st = (s & 3) * 32768;
        bf16x8 af[4], bfv[8];
#pragma unroll
        for (int mi = 0; mi < 4; ++mi) af[mi] = *(const LAS bf16x8*)(fa + st + mi * 1024);
#pragma unroll
        for (int ni = 0; ni < 8; ++ni) bfv[ni] = *(const LAS bf16x8*)(fb + st + ni * 1024);
        __builtin_amdgcn_sched_barrier(0);
        if (s + 3 < nk) issue(s + 3);
        if (g1) {
            if (s <= nk - 4) asm volatile("s_waitcnt vmcnt(8)" ::: "memory");
            else if (s == nk - 3) asm volatile("s_waitcnt vmcnt(4)" ::: "memory");
            else if (s == nk - 2) asm volatile("s_waitcnt vmcnt(0)" ::: "memory");
        }
        __builtin_amdgcn_s_waitcnt(0xC07F);
        RING_BAR();
#pragma unroll
        for (int ni = 0; ni < 8; ++ni)
#pragma unroll
            for (int mi = 0; mi < 4; ++mi) acc[mi][ni] = __builtin_amdgcn_mfma_f32_16x16x32_bf16(bfv[ni], af[mi], acc[mi][ni], 0, 0, 0);
        if (!g1) {
            if (s <= nk - 4) asm volatile("s_waitcnt vmcnt(8)" ::: "memory");
            else if (s == nk - 3) asm volatile("s_waitcnt vmcnt(4)" ::: "memory");
            else if (s == nk - 2) asm volatile("s_waitcnt vmcnt(0)" ::: "memory");
        }
        RING_BAR();
    }
    if (!g1) RING_BAR();
    if (nxt) {
        const __attribute__((address_space(1))) char* Ang = (const __attribute__((address_space(1))) char*)An;
#pragma unroll
        for (int kt = 0; kt < 3; ++kt) {
            const int st = kt * 32768;
            const unsigned ko = (unsigned)kt * astage, kb = (unsigned)kt * bstage;
            __builtin_amdgcn_global_load_lds((gu32p)(Ang + (size_t)((na0 + ko) * 2u)), (LAS unsigned*)(dst + st), 16, 0, 0);
            __builtin_amdgcn_global_load_lds((gu32p)(Ang + (size_t)((na0 + 4096u + ko) * 2u)), (LAS unsigned*)(dst + st + 8192), 16, 0, 0);
            __builtin_amdgcn_global_load_lds((gu32p)(Bg + (size_t)((nb0 + kb) * 2u)), (LAS unsigned*)(dst + st + 16384), 16, 0, 0);
            __builtin_amdgcn_global_load_lds((gu32p)(Bg + (size_t)((nb0 + 4096u + kb) * 2u)), (LAS unsigned*)(dst + st + 16384 + 8192), 16, 0, 0);
        }
    }
#undef RING_BAR
}
__device__ __forceinline__ unsigned ring_off(int tid, int row0, int ld) {
    return (unsigned)((row0 + (tid >> 2)) * ld + ((((tid & 3) ^ ((0 - (tid >> 4)) & 3))) << 3));
}

template <bool CONVIN = false> __device__ __forceinline__ void convert_wt(LAS unsigned char* lds, const GemmCtx& c, const float* __restrict__ W, int N, bf16_t* WT, const float* gk = nullptr) {
    LAS float* tile = (LAS float*)lds;
    const int ntn = N / 64, ntiles = (DM / 64) * ntn;
    for (int t = blockIdx.x; t < ntiles; t += gridDim.x) {
        const int kt = t / ntn, nt = t % ntn;
        __syncthreads();
#pragma unroll
        for (int i = 0; i < 2; ++i) {
            const int idx = i * 512 + c.tid, kr = idx >> 4, c4 = (idx & 15) * 4;
            f32x4 v = *(const f32x4*)(W + (size_t)(kt * 64 + kr) * N + nt * 64 + c4);
            if (gk) { const float gg = gk[kt * 64 + kr]; v[0] *= gg; v[1] *= gg; v[2] *= gg; v[3] *= gg; }
            tile[kr * 65 + c4] = v[0]; tile[kr * 65 + c4 + 1] = v[1]; tile[kr * 65 + c4 + 2] = v[2]; tile[kr * 65 + c4 + 3] = v[3];
        }
        __syncthreads();
        {
            const int n = c.tid >> 3, k8 = (c.tid & 7) * 8;
            u32x4 o;
#pragma unroll
            for (int q = 0; q < 4; ++q) o[q] = pk2(tile[(k8 + 2 * q) * 65 + n], tile[(k8 + 2 * q + 1) * 65 + n]);
            {
                int nrow = nt * 64 + n;
                if (CONVIN && nrow >= 2048) {
                    const int which = (nrow - 2048) >> 11, ch = (nrow - 2048) & 2047, hd = ch & 127;
                    nrow = 2048 + (ch >> 7) * 256 + (hd >> 6) * 128 + (2 * ((hd >> 4) & 3) + which) * 16 + (hd & 15);
                }
                const int pn = nrow >> 8, r = nrow & 255, kk = kt * 64 + k8, j = kk >> 5, lc = (kk & 31) >> 3;
                *(u32x4*)(WT + ((size_t)(pn * 64 + j) * 8192) + (r * 64 + ((lc ^ ((0 - (r >> 2)) & 3)) << 4)) / 2) = o;
            }
        }
    }
}

struct MegaArgs {
    const float* x; const float* mix_norm; const float* ffn_norm; const float* conv_w_in; const float* conv_w; const float* conv_w_out;
    const float* kv_norm; const float* w_kv; const float* k_norm; const float* w_q; const float* q_norm; const float* w_o;
    const float* router_group; const float* router_expert; const float* w_gate; const float* w_up; const float* w_down;
    float* H; unsigned char* ws; int ph_lo, ph_hi;
};
enum { PH_PREP = 0, PH_GEMM1 = 1, PH_CONV = 2, PH_GEMM2 = 3, PH_ROUTER0 = 4, PH_MOEA0 = 5, PH_MOEB0 = 6, PH_COMBINE0 = 7, PH_GEMM3 = 8, PH_ATTN = 9, PH_GEMM4 = 10,
       PH_ROUTER1 = 11, PH_MOEA1 = 12, PH_MOEB1 = 13, PH_COMBINE1 = 14, PH_END = 15 };

__device__ __forceinline__ int vblock(LAS unsigned char* lds) {
    volatile LAS unsigned* bst = (volatile LAS unsigned*)(lds + LDS_MISC + 8160);
    const unsigned v = bst[2], ok = bst[3];
    const int b = blockIdx.x;
    return __builtin_amdgcn_readfirstlane((ok && v < 256u) ? (int)v : ((b & 7) * 32 + (b >> 3)));
}
__device__ __forceinline__ bool dense_tile(LAS unsigned char* lds, int it, int ntn, int& pm, int& pn) {
    const int b = blockIdx.x, G = gridDim.x;
    const int t = it * G + b;
    if (G != 256) { if (t >= 32 * ntn) return false; pm = t % 32; pn = t / 32; return true; }
    const int r = it; if (r * 8 >= ntn) return false;
    const int vb = vblock(lds); const int x = vb >> 5, j = vb & 31; pm = 4 * x + (j & 3); pn = 8 * r + (j >> 2); return true;
}

template <bool RBF> __device__ __forceinline__ void phase_gemm_resid(LAS unsigned char* lds, const GemmCtx& c, const bf16_t* A, const bf16_t* WT, const void* R, bf16_t* HB) {
    int pm, pn; bool have = dense_tile(lds, 0, DM / 256, pm, pn), pre = false;
    for (int it = 0; have; ++it) {
        int npm = 0, npn = 0; const bool hn = dense_tile(lds, it + 1, DM / 256, npm, npn);
        f32x4 acc[4][8];
        gemm_tile_bf16(lds, c, A, (unsigned)(pm * 64 * 8192 + c.tid * 8), (unsigned)(pm * 64 * 8192 + 4096 + c.tid * 8), WT, (unsigned)(pn * 64 * 8192 + c.tid * 8), (unsigned)(pn * 64 * 8192 + 4096 + c.tid * 8), DM / 32, acc, 8192u, 8192u,
                       pre, hn, A, (unsigned)(npm * 64 * 8192 + c.tid * 8), (unsigned)(npn * 64 * 8192 + c.tid * 8));
#pragma unroll
        for (int mi = 0; mi < 4; ++mi) {
            const size_t row = (size_t)pm * 256 + c.wr * 64 + mi * 16 + c.fr;
#pragma unroll
            for (int ni = 0; ni < 8; ++ni) {
                const size_t idx = row * DM + pn * 256 + c.wc * 128 + ni * 16 + c.fq * 4;
                f32x4 r;
                if (RBF) { const uint2 h = *(const uint2*)((const bf16_t*)R + idx); r[0] = bflo(h.x); r[1] = bfhi(h.x); r[2] = bflo(h.y); r[3] = bfhi(h.y); }
                else r = *(const f32x4*)((const float*)R + idx);
                r = r + acc[mi][ni];
                uint2 o; o.x = pk2(r[0], r[1]); o.y = pk2(r[2], r[3]);
                *(uint2*)(HB + idx) = o;
            }
        }
        pm = npm; pn = npn; have = hn; pre = hn;
    }
}

__device__ __forceinline__ void phase_gemm1(LAS unsigned char* lds, const GemmCtx& c, const bf16_t* A, const bf16_t* WT, bf16_t* O) {
    int pm, pn; bool have = dense_tile(lds, 0, 6144 / 256, pm, pn), pre = false;
    for (int it = 0; have; ++it) {
        int npm = 0, npn = 0; const bool hn = dense_tile(lds, it + 1, 6144 / 256, npm, npn);
        f32x4 acc[4][8];
        const int lpm = pm, lpn = pn;
        gemm_tile_bf16(lds, c, A, (unsigned)(lpm * 64 * 8192 + c.tid * 8), (unsigned)(lpm * 64 * 8192 + 4096 + c.tid * 8), WT, (unsigned)(lpn * 64 * 8192 + c.tid * 8), (unsigned)(lpn * 64 * 8192 + 4096 + c.tid * 8), DM / 32, acc, 8192u, 8192u,
                       pre, hn, A, (unsigned)(npm * 64 * 8192 + c.tid * 8), (unsigned)(npn * 64 * 8192 + c.tid * 8));
#pragma unroll
        for (int mi = 0; mi < 4; ++mi) {
            const size_t row = (size_t)pm * 256 + c.wr * 64 + mi * 16 + c.fr;
            if (pn < 8) {
#pragma unroll
                for (int ni = 0; ni < 8; ++ni) {
                    uint2 o; o.x = pk2(acc[mi][ni][0], acc[mi][ni][1]); o.y = pk2(acc[mi][ni][2], acc[mi][ni][3]);
                    *(uint2*)(O + row * DM + pn * 256 + c.wc * 128 + ni * 16 + c.fq * 4) = o;
                }
            } else {
                bf16_t* U = O + (size_t)NTOK * DM;
#pragma unroll
                for (int p = 0; p < 4; ++p) {
                    uint2 o; o.x = pk2(acc[mi][2 * p][0] * acc[mi][2 * p + 1][0], acc[mi][2 * p][1] * acc[mi][2 * p + 1][1]);
                    o.y = pk2(acc[mi][2 * p][2] * acc[mi][2 * p + 1][2], acc[mi][2 * p][3] * acc[mi][2 * p + 1][3]);
                    *(uint2*)(U + row * DM + (pn - 8) * 128 + c.wc * 64 + p * 16 + c.fq * 4) = o;
                }
            }
        }
        pm = npm; pn = npn; have = hn; pre = hn;
    }
}

__device__ __forceinline__ void phase_gemm3(LAS unsigned char* lds, const GemmCtx& c, const bf16_t* AKV, const bf16_t* AQ, const bf16_t* WT,
                                            const float* kn, const float* qn, bf16_t* Kb, bf16_t* Vb, bf16_t* Qb, float* KM) {
    int pm, pn; bool have = dense_tile(lds, 0, 24, pm, pn), pre = false;
    for (int it = 0; have; ++it) {
        int npm = 0, npn = 0; const bool hn = dense_tile(lds, it + 1, 24, npm, npn);
        const bool isq = pn >= 16;
        const bf16_t* A = isq ? AQ : AKV;
        f32x4 acc[4][8];
        gemm_tile_bf16(lds, c, A, (unsigned)(pm * 64 * 8192 + c.tid * 8), (unsigned)(pm * 64 * 8192 + 4096 + c.tid * 8), WT, (unsigned)(pn * 64 * 8192 + c.tid * 8), (unsigned)(pn * 64 * 8192 + 4096 + c.tid * 8), DM / 32, acc, 8192u, 8192u,
                       pre, hn, (npn >= 16) ? AQ : AKV, (unsigned)(npm * 64 * 8192 + c.tid * 8), (unsigned)(npn * 64 * 8192 + c.tid * 8));
        const int which = pn >> 3;
        const int head = (pn & 7) * 2 + c.wc;
        bf16_t* dst = which == 0 ? Kb : (which == 1 ? Vb : Qb);
        const float* gn = which == 0 ? kn : qn;
        float colsum[8][4];
#pragma unroll
        for (int ni = 0; ni < 8; ++ni)
#pragma unroll
            for (int e = 0; e < 4; ++e) colsum[ni][e] = 0.f;
#pragma unroll
        for (int mi = 0; mi < 4; ++mi) {
            const int tok = pm * 256 + c.wr * 64 + mi * 16 + c.fr;
            const int b = tok >> 11, sq = tok & 2047;
            float r = 1.f;
            if (which != 1) {
                float ss = 0.f;
#pragma unroll
                for (int ni = 0; ni < 8; ++ni)
#pragma unroll
                    for (int e = 0; e < 4; ++e) ss += acc[mi][ni][e] * acc[mi][ni][e];
                ss += __shfl_xor(ss, 16); ss += __shfl_xor(ss, 32);
                r = rsqrtf(ss * (1.0f / HD) + EPS);
            }
            bf16_t* orow = dst + ((size_t)(b * NH + head) * SEQ + sq) * HD + c.fq * 4;
#pragma unroll
            for (int ni = 0; ni < 8; ++ni) {
                f32x4 v = acc[mi][ni];
                if (which != 1) { const f32x4 g = *(const f32x4*)(gn + ni * 16 + c.fq * 4); v[0] = v[0] * r * g[0]; v[1] = v[1] * r * g[1]; v[2] = v[2] * r * g[2]; v[3] = v[3] * r * g[3]; }
                if (which == 0) {
#pragma unroll
                    for (int e = 0; e < 4; ++e) colsum[ni][e] += v[e];
                }
                uint2 o; o.x = pk2(v[0], v[1]); o.y = pk2(v[2], v[3]);
                *(uint2*)(orow + ni * 16) = o;
            }
        }
        if (which == 0) {
            LAS float* red = (LAS float*)(lds + LDS_MISC);
#pragma unroll
            for (int ni = 0; ni < 8; ++ni)
#pragma unroll
                for (int e = 0; e < 4; ++e) {
                    float v = colsum[ni][e];
                    v += __shfl_xor(v, 1); v += __shfl_xor(v, 2); v += __shfl_xor(v, 4); v += __shfl_xor(v, 8);
                    if (c.fr == 0) red[(c.wr * 2 + c.wc) * 128 + ni * 16 + c.fq * 4 + e] = v;
                }
            __syncthreads();
            if (c.tid < 256) {
                const int wc2 = c.tid >> 7, d = c.tid & 127;
                const float sum = ((red[(0 * 2 + wc2) * 128 + d] + red[(1 * 2 + wc2) * 128 + d]) + red[(2 * 2 + wc2) * 128 + d]) + red[(3 * 2 + wc2) * 128 + d];
                const int hd2 = (pn & 7) * 2 + wc2, b = pm >> 3, blk = pm & 7;
                KM[((size_t)(b * NH + hd2) * NBLK + blk) * HD + d] = sum * (1.0f / BLK);
            }
            __syncthreads();
        }
        pm = npm; pn = npn; have = hn; pre = hn;
    }
}

template <int OFF> __device__ __forceinline__ unsigned long long karg64() {
    unsigned long long v; auto k = __builtin_amdgcn_kernarg_segment_ptr();
    asm volatile("s_load_dwordx2 %0, %1, %2\n\ts_waitcnt lgkmcnt(0)" : "=s"(v) : "s"(k), "i"(OFF) : "memory");
    return v;
}
#define ARG(field) ((decltype(MegaArgs::field))karg64<offsetof(MegaArgs, field)>())
#define WSP(T, off) ((T*)((unsigned char*)ARG(ws) + (off)))

__device__ __forceinline__ void moe_counts(LAS int* misc, const GemmCtx& c, const int* toke) {
    if (c.tid < 32) misc[c.tid] = 0;
    __syncthreads();
    typedef int i32x4 __attribute__((ext_vector_type(4)));
    const i32x4* tp = (const i32x4*)(toke + c.tid * 32);
#pragma unroll
    for (int i = 0; i < 8; ++i) {
        const i32x4 v = tp[i];
        atomicAdd((int*)&misc[v[0]], 1); atomicAdd((int*)&misc[v[1]], 1); atomicAdd((int*)&misc[v[2]], 1); atomicAdd((int*)&misc[v[3]], 1);
    }
    __syncthreads();
    if (c.tid == 0) { int acc = 0; for (int e = 0; e < NE; ++e) { misc[32 + e] = acc; acc += (misc[e] + 255) >> 8; } misc[32 + NE] = acc; }
    __syncthreads();
}
__device__ __forceinline__ void moe_rowlist(LAS int* misc, const GemmCtx& c, const int* toke, int e, int mt) {
    __syncthreads();
    typedef int i32x4 __attribute__((ext_vector_type(4)));
    int tb = c.tid * 32; asm volatile("" : "+v"(tb));
    const i32x4* tp = (const i32x4*)(toke + tb);
    i32x4 ent[8];
#pragma unroll
    for (int i = 0; i < 8; ++i) ent[i] = tp[i];
    int cntm = 0;
#pragma unroll
    for (int i = 0; i < 8; ++i) cntm += (ent[i][0] == e) + (ent[i][1] == e) + (ent[i][2] == e) + (ent[i][3] == e);
    int incl = cntm;
#pragma unroll
    for (int o = 1; o < 64; o <<= 1) { const int t = __shfl_up(incl, o); if (c.lane >= o) incl += t; }
    if (c.lane == 63) misc[128 + c.wid] = incl;
    if (c.tid < 256) misc[1024 + c.tid] = -1;
    __syncthreads();
    int base = 0;
#pragma unroll
    for (int w = 0; w < 8; ++w) base += (w < c.wid) ? misc[128 + w] : 0;
    int pos = base + incl - cntm - mt * 256;
    if (cntm > 0 && pos < 256 && pos + cntm > 0) {
#pragma unroll
        for (int i = 0; i < 8; ++i)
#pragma unroll
            for (int q = 0; q < 4; ++q) if (ent[i][q] == e) { if (pos >= 0 && pos < 256) misc[1024 + pos] = tb + 4 * i + q; ++pos; }
    }
    __syncthreads();
}
__device__ __forceinline__ bool moe_tile(LAS int* misc, int it, int ntn, int& e, int& mt, int& nt) {
    const int b = blockIdx.x, G = gridDim.x;
    const int t = (G == 256) ? it * 256 + (b & 7) * 32 + (b >> 3) : it * G + b;
    const int total = misc[32 + NE] * ntn;
    if (t >= total) return false;
    const int g = t / ntn; nt = t % ntn;
    int ee = 0;
#pragma unroll
    for (int q = 1; q < NE; ++q) ee += (misc[32 + q] <= g);
    e = ee; mt = g - misc[32 + ee]; return true;
}

__device__ __forceinline__ unsigned xb_ld(unsigned* p);
__device__ __forceinline__ unsigned xb_add(unsigned* p, unsigned v);
#define MOE_CNT_WORD(layer, g) (3584 + (layer) * 128 + (g))
__device__ __forceinline__ bool moe_item(LAS int* misc, int g_total, int it, int& isb, int& g, int& nt) {
    const int b = blockIdx.x, G = gridDim.x;
    const int TA = g_total * 4, TB = g_total * 8;
    if (G != 256 || TA > 512 || TA < 256) {
        const int t = it * G + b;
        if (t >= TA + TB) return false;
        if (t < TA) { isb = 0; g = t >> 2; nt = t & 3; } else { isb = 1; g = (t - TA) >> 3; nt = (t - TA) & 7; }
        return true;
    }
    const int vb = vblock((LAS unsigned char*)misc - LDS_MISC);
    const int nA2 = TA - 256, nl = 256 - nA2;
    const bool heavy = vb < nA2;
    if (it == 0) { isb = 0; g = vb >> 2; nt = vb & 3; return true; }
    int slot = it - 1;
    if (heavy) { if (slot == 0) { const int t = 256 + vb; isb = 0; g = t >> 2; nt = t & 3; return true; } slot -= 1; }
    int i;
    if (heavy) i = 2 * nl + slot * 256 + nl + vb;
    else i = (slot < 2) ? slot * nl + (vb - nA2) : 2 * nl + (slot - 2) * 256 + (vb - nA2);
    if (i >= TB) return false;
    isb = 1; g = i >> 3; nt = i & 7; return true;
}
__device__ __forceinline__ void moe_g2emt(LAS int* misc, int g, int& e, int& mt) {
    int ee = 0;
#pragma unroll
    for (int q = 1; q < NE; ++q) ee += (misc[32 + q] <= g);
    e = __builtin_amdgcn_readfirstlane(ee); mt = __builtin_amdgcn_readfirstlane(g - misc[32 + ee]);
}
__device__ __forceinline__ void phase_moe(LAS unsigned char* lds, const GemmCtx& c, int layer) {
    LAS int* misc = (LAS int*)(lds + LDS_MISC);
    moe_counts(misc, c, WSP(int, WS_TOKE) + layer * 2 * NTOK);
    const int g_total = __builtin_amdgcn_readfirstlane(misc[32 + NE]);
    const int total_it = (g_total * 12 + gridDim.x - 1) / gridDim.x + 3;
    for (int it = 0; it < total_it; ++it) {
        int isb, g, nt; if (!moe_item(misc, g_total, it, isb, g, nt)) continue;
        isb = __builtin_amdgcn_readfirstlane(isb); g = __builtin_amdgcn_readfirstlane(g); nt = __builtin_amdgcn_readfirstlane(nt);
        int e, mt; moe_g2emt(misc, g, e, mt);
        moe_rowlist(misc, c, WSP(int, WS_TOKE) + layer * 2 * NTOK, e, mt);
        f32x4 acc[4][8];
        if (!isb) {
            {
                unsigned ao[4];
#pragma unroll
                for (int i = 0; i < 4; ++i) { const int sr = misc[1024 + (c.tid >> 3) + 64 * i]; ao[i] = (unsigned)((sr < 0 ? 0 : (sr >> 1)) * DM + a_chunk_off(c.tid)); }
                const int mat = c.wid & 1, bkg = (c.wid >> 1) * 2 + (c.lane >> 5), cgm = c.lane & 31;
                const int brow0 = (cgm >> 4) * 128 + (2 * ((cgm >> 2) & 3) + mat) * 16 + (cgm & 3) * 4;
                const float* Wb = (mat ? ARG(w_up) : ARG(w_gate)) + (size_t)(layer * NE + e) * DM * DE + nt * 128;
                gemm_tile_f32w(lds, c, WSP(bf16_t, WS_A1), ao, Wb, (unsigned)((bkg * 8) * DE + 4 * cgm), brow0, bkg, DE, DM / 64, acc);
            }
            bf16_t* ACT = WSP(bf16_t, WS_ACT);
            const float* tokr = WSP(float, WS_TOKR) + layer * NTOK;
#pragma unroll
            for (int mi = 0; mi < 4; ++mi) {
                const int sr = misc[1024 + c.wr * 64 + mi * 16 + c.fr];
                if (sr >= 0) {
                    const float rs = tokr[sr >> 1];
                    bf16_t* orow = ACT + (size_t)sr * DE + nt * 128 + c.wc * 64 + c.fq * 4;
#pragma unroll
                    for (int p = 0; p < 4; ++p) {
                        float a[4];
#pragma unroll
                        for (int q = 0; q < 4; ++q) { const float gv = acc[mi][2 * p][q] * rs; a[q] = gv / (1.0f + __expf(-gv)) * (acc[mi][2 * p + 1][q] * rs); }
                        uint2 o; o.x = pk2(a[0], a[1]); o.y = pk2(a[2], a[3]);
                        *(uint2*)(orow + p * 16) = o;
                    }
                }
            }
            asm volatile("s_waitcnt vmcnt(0)" ::: "memory");
            __syncthreads();
            if (c.tid == 0) {
                __builtin_amdgcn_fence(__ATOMIC_RELEASE, "agent");
                asm volatile("s_waitcnt vmcnt(0)" ::: "memory");
                (void)xb_add((unsigned*)ARG(ws) + MOE_CNT_WORD(layer, g), 1u);
            }
        } else {
            if (c.tid == 0) {
                unsigned* cw = (unsigned*)ARG(ws) + MOE_CNT_WORD(layer, g);
                unsigned sp = 0;
                while (xb_ld(cw) < 4u) { __builtin_amdgcn_s_sleep(2); if (++sp > (1u << 22)) break; }
                __builtin_amdgcn_fence(__ATOMIC_ACQUIRE, "agent");
                asm volatile("s_waitcnt vmcnt(0)" ::: "memory");
            }
            __syncthreads();
            {
                unsigned ao[4];
#pragma unroll
                for (int i = 0; i < 4; ++i) { const int sr = misc[1024 + (c.tid >> 3) + 64 * i]; ao[i] = (unsigned)((sr < 0 ? 0 : sr) * DE + a_chunk_off(c.tid)); }
                const float* Wb = ARG(w_down) + (size_t)(layer * NE + e) * DE * DM + nt * 256;
                gemm_tile_f32w(lds, c, WSP(bf16_t, WS_ACT), ao, Wb, (unsigned)((c.wid * 8) * DM + 4 * c.lane), 4 * c.lane, c.wid, DM, DE / 64, acc);
            }
            bf16_t* Y = WSP(bf16_t, WS_Y);
            const float* tokw = WSP(float, WS_TOKW) + layer * 2 * NTOK;
#pragma unroll
            for (int mi = 0; mi < 4; ++mi) {
                const int sr = misc[1024 + c.wr * 64 + mi * 16 + c.fr];
                if (sr >= 0) {
                    const float w = tokw[sr];
                    bf16_t* orow = Y + (size_t)sr * DM + nt * 256 + c.wc * 128 + c.fq * 4;
#pragma unroll
                    for (int ni = 0; ni < 8; ++ni) {
                        uint2 o; o.x = pk2(acc[mi][ni][0] * w, acc[mi][ni][1] * w); o.y = pk2(acc[mi][ni][2] * w, acc[mi][ni][3] * w);
                        *(uint2*)(orow + ni * 16) = o;
                    }
                }
            }
        }
    }
}

typedef float f32x16 __attribute__((ext_vector_type(16)));
__device__ __forceinline__ void phase_router(LAS unsigned char* lds, const GemmCtx& c, const bf16_t* __restrict__ HB, const float* __restrict__ g,
                                             const float* __restrict__ wrg, const float* __restrict__ wre, bf16_t* AF, int* toke, float* tokw, float* tokr) {
    LAS float* RR = (LAS float*)lds;
    LAS float* YCH = RR + 64;
    LAS float* WRE = YCH + 32 * 260;
    LAS float* WRG = WRE + 256 * 32;
    LAS float* PLOG = WRG + 256 * 4;
    LAS float* PG = PLOG + 8 * 32 * 32;
    for (int tg = blockIdx.x; tg < NTOK / 32; tg += gridDim.x) {
        const int tok0 = tg * 32;
        __syncthreads();
        f32x16 accl;
#pragma unroll
        for (int i = 0; i < 16; ++i) accl[i] = 0.f;
        float accg[4] = {0.f, 0.f, 0.f, 0.f};
        const int ltok = c.tid >> 4, lq = c.tid & 15;
        float ss = 0.f;
        uint2 hbr[1][4]; f32x4 ggr[1][4], wer[1][4], wgr[1];
        auto ldchunk = [&](int kc, int sl) {
#pragma unroll
            for (int j = 0; j < 4; ++j) {
                const int k = kc * 256 + lq * 4 + 64 * j;
                hbr[sl][j] = *(const uint2*)(HB + (size_t)(tok0 + ltok) * DM + k);
                ggr[sl][j] = *(const f32x4*)(g + k);
                wer[sl][j] = *(const f32x4*)(wre + (size_t)kc * 256 * 32 + (c.tid + 512 * j) * 4);
            }
            if (c.tid < 256) wgr[sl] = *(const f32x4*)(wrg + (size_t)kc * 256 * 4 + c.tid * 4);
        };
        ldchunk(0, 0);
        auto chunk = [&](int kc, const int sl) {
#pragma unroll
            for (int j = 0; j < 4; ++j) {
                const int kl = lq * 4 + 64 * j, k = kc * 256 + kl;
                const uint2 hb = hbr[sl][j];
                const f32x4 h = (f32x4){bflo(hb.x), bfhi(hb.x), bflo(hb.y), bfhi(hb.y)};
                ss += h[0] * h[0] + h[1] * h[1] + h[2] * h[2] + h[3] * h[3];
                const f32x4 gg = ggr[sl][j];
                f32x4 y; y[0] = h[0] * gg[0]; y[1] = h[1] * gg[1]; y[2] = h[2] * gg[2]; y[3] = h[3] * gg[3];
                uint2 o; o.x = pk2(y[0], y[1]); o.y = pk2(y[2], y[3]);
                *(uint2*)(AF + (size_t)(tok0 + ltok) * DM + k) = o;
                *(LAS f32x4*)(YCH + ltok * 260 + kl) = y;
            }
#pragma unroll
            for (int j = 0; j < 4; ++j) *(LAS f32x4*)(WRE + (c.tid + 512 * j) * 4) = wer[sl][j];
            if (c.tid < 256) *(LAS f32x4*)(WRG + c.tid * 4) = wgr[sl];
            __syncthreads();
            if (kc + 1 < 8) ldchunk(kc + 1, 0);
#pragma unroll
            for (int s2 = 0; s2 < 16; ++s2) {
                const int kk = 32 * c.wid + 2 * s2 + (c.lane >> 5);
                const float av = YCH[(c.lane & 31) * 260 + kk];
                const float bv = WRE[kk * 32 + (c.lane & 31)];
                accl = __builtin_amdgcn_mfma_f32_32x32x2f32(av, bv, accl, 0, 0, 0);
            }
            {
                const int t2 = c.tid & 31, ks = c.tid >> 5;
#pragma unroll
                for (int kk = 0; kk < 16; ++kk) {
                    const float yv = YCH[t2 * 260 + ks * 16 + kk];
                    const f32x4 wv = *(const LAS f32x4*)(WRG + (ks * 16 + kk) * 4);
                    accg[0] += yv * wv[0]; accg[1] += yv * wv[1]; accg[2] += yv * wv[2]; accg[3] += yv * wv[3];
                }
            }
            __syncthreads();
        };
#pragma unroll 1
        for (int kc = 0; kc < 8; ++kc) chunk(kc, 0);
        ss += __shfl_xor(ss, 1); ss += __shfl_xor(ss, 2); ss += __shfl_xor(ss, 4); ss += __shfl_xor(ss, 8);
        if (lq == 0) { const float r = rsqrtf(ss * (1.0f / DM) + EPS); RR[ltok] = r; tokr[tok0 + ltok] = r; }
#pragma unroll
        for (int r = 0; r < 16; ++r) PLOG[(c.wid * 32 + ((r & 3) + 8 * (r >> 2) + 4 * (c.lane >> 5))) * 32 + (c.lane & 31)] = accl[r];
        {
            const int t2 = c.tid & 31, ks = c.tid >> 5;
            *(LAS f32x4*)(PG + (ks * 32 + t2) * 4) = (f32x4){accg[0], accg[1], accg[2], accg[3]};
        }
        __syncthreads();
        if (c.tid < 32) {
            const int t2 = c.tid;
            const float rr = RR[t2];
            float gl[4] = {0.f, 0.f, 0.f, 0.f};
#pragma unroll
            for (int ks = 0; ks < 16; ++ks) { const f32x4 v = *(const LAS f32x4*)(PG + (ks * 32 + t2) * 4); gl[0] += v[0]; gl[1] += v[1]; gl[2] += v[2]; gl[3] += v[3]; }
#pragma unroll
            for (int q = 0; q < 4; ++q) gl[q] *= rr;
            int gs = 0; float gm = gl[0];
#pragma unroll
            for (int q = 1; q < 4; ++q) if (gl[q] > gm) { gm = gl[q]; gs = q; }
            float den = 0.f;
#pragma unroll
            for (int q = 0; q < 4; ++q) den += __expf(gl[q] - gm);
            const float gw = 1.0f / den;
            float el[8];
#pragma unroll
            for (int q = 0; q < 8; ++q) {
                float v = 0.f;
#pragma unroll
                for (int w = 0; w < 8; ++w) v += PLOG[(w * 32 + t2) * 32 + gs * 8 + q];
                el[q] = v * rr;
            }
            int i0 = 0; float t0 = el[0];
#pragma unroll
            for (int q = 1; q < 8; ++q) if (el[q] > t0) { t0 = el[q]; i0 = q; }
            int i1 = -1; float t1 = -INFINITY;
#pragma unroll
            for (int q = 0; q < 8; ++q) if (q != i0 && el[q] > t1) { t1 = el[q]; i1 = q; }
            const float e1 = __expf(t1 - t0);
            const int tok = tok0 + t2;
            tokw[tok * 2] = gw / (1.0f + e1); tokw[tok * 2 + 1] = gw * e1 / (1.0f + e1);
            toke[tok * 2] = gs * 8 + i0; toke[tok * 2 + 1] = gs * 8 + i1;
        }
    }
}

typedef short v4i16_t __attribute__((ext_vector_type(4)));
__device__ __forceinline__ float bfs2f(short v) { return __uint_as_float(((unsigned)(unsigned short)v) << 16); }
__device__ __forceinline__ void attn_unit(LAS unsigned char* lds, const GemmCtx& c, int bh, int qb, const bf16_t* __restrict__ Qb, const bf16_t* __restrict__ Kb,
                                          const bf16_t* __restrict__ Vb, const float* __restrict__ KM, bf16_t* ATT) {
    const int lane = c.lane, w = c.wid, r32 = lane & 31, hh = lane >> 5;
    const int head = bh & 15, b = bh >> 4;
    const float LOG2E = 1.4426950408889634f;
    const float slope2 = exp2f(-8.0f * (float)(head + 1) / (float)NH) * LOG2E;
    const float cs = 0.08838834764831845f * LOG2E;
    const int qrow = qb * 256 + w * 32 + r32;
    bf16x8 qf[8];
    {
        const bf16_t* qp = Qb + ((size_t)bh * SEQ + qrow) * HD + 8 * hh;
#pragma unroll
        for (int ds = 0; ds < 8; ++ds) qf[ds] = *(const bf16x8*)(qp + 16 * ds);
    }
    unsigned sel = 0;
    if (qb > 0) {
        float gate[7];
#pragma unroll
        for (int n = 0; n < 7; ++n) {
            float part = 0.f;
            if (n < qb) {
                const float* km = KM + ((size_t)bh * NBLK + n) * HD + 8 * hh;
#pragma unroll
                for (int ds = 0; ds < 8; ++ds) {
                    const f32x4 k0 = *(const f32x4*)(km + 16 * ds), k1 = *(const f32x4*)(km + 16 * ds + 4);
                    part += bfs2f(qf[ds][0]) * k0[0] + bfs2f(qf[ds][1]) * k0[1] + bfs2f(qf[ds][2]) * k0[2] + bfs2f(qf[ds][3]) * k0[3]
                          + bfs2f(qf[ds][4]) * k1[0] + bfs2f(qf[ds][5]) * k1[1] + bfs2f(qf[ds][6]) * k1[2] + bfs2f(qf[ds][7]) * k1[3];
                }
                part += __shfl_xor(part, 32);
                asm volatile("" : "+v"(part) :: "memory");
            }
            gate[n] = part;
        }
#pragma unroll
        for (int n = 0; n < 7; ++n) {
            int rank = 0;
#pragma unroll
            for (int m2 = 0; m2 < 7; ++m2) if (m2 != n && m2 < qb && (gate[m2] > gate[n] || (gate[m2] == gate[n] && m2 < n))) ++rank;
            if (n < qb && rank < 3) sel |= 1u << n;
        }
    }
    const float hb = slope2 * (float)(4 * hh);
    f32x16 o[4];
#pragma unroll
    for (int db = 0; db < 4; ++db)
#pragma unroll
        for (int r = 0; r < 16; ++r) o[db][r] = 0.f;
    float m = -INFINITY, l = 0.f;
    const int kq = r32 & 15;
    int koff[2];
    koff[0] = r32 * 256; koff[1] = (r32 + 32) * 256;
    const int vq = (lane & 15) >> 2, vp = lane & 3, dhalf = (lane >> 4) & 1;
    int voff[4];
#pragma unroll
    for (int db = 0; db < 4; ++db) voff[db] = 16384 + (4 * hh + vq) * 256 + (((((db ^ vq) << 2) | (dhalf * 2 + (vp >> 1))) << 4)) + (vp & 1) * 8;
    const bf16_t* kbase_g = Kb + (size_t)bh * SEQ * HD;
    const bf16_t* vbase_g = Vb + (size_t)bh * SEQ * HD;
    int ksrc[2], vsrc[2];
#pragma unroll
    for (int i = 0; i < 2; ++i) {
        const int pos = i * 512 + c.tid, row = pos >> 4, pc = pos & 15;
        ksrc[i] = row * HD + ((pc ^ (row & 15)) << 3);
        vsrc[i] = row * HD + ((pc ^ ((row & 3) << 2)) << 3);
    }
    const int ntiles = (qb + 1) * 4;
    auto issue = [&](int t) {
        const int blk = (t < 4) ? qb : (t >> 2) - 1, tt = t & 3, buf = t & 1;
        const size_t g0 = (size_t)(blk * 256 + tt * 64) * HD;
#pragma unroll
        for (int i = 0; i < 2; ++i) {
            __builtin_amdgcn_global_load_lds((const unsigned*)(kbase_g + g0 + ksrc[i]), (LAS unsigned*)(lds + buf * 32768 + (i * 512 + c.tid) * 16), 16, 0, 0);
            __builtin_amdgcn_global_load_lds((const unsigned*)(vbase_g + g0 + vsrc[i]), (LAS unsigned*)(lds + buf * 32768 + 16384 + (i * 512 + c.tid) * 16), 16, 0, 0);
        }
    };
    __syncthreads();
    issue(0);
    asm volatile("s_waitcnt vmcnt(0)" ::: "memory");
    __syncthreads();
    for (int t = 0; t < ntiles; ++t) {
        if (t + 1 < ntiles) issue(t + 1);
        const int blk = (t < 4) ? qb : (t >> 2) - 1, tt = t & 3;
        const int kb0 = blk * 256 + tt * 64;
        const bool own = (t < 4);
        const bool lsel = own || ((sel >> blk) & 1u);
        const bool active = own ? (kb0 <= qb * 256 + w * 32 + 31) : (__ballot(lsel) != 0ull);
        if (active) {
            LAS unsigned char* kl = lds + (t & 1) * 32768;
            const float lb = lsel ? hb : -INFINITY;
            const bool diag = own && (kb0 + 63 > qb * 256 + w * 32);
#pragma unroll
            for (int h32 = 0; h32 < 2; ++h32) {
                f32x16 p0;
                const float lbq = lb * (1.0f / cs), s2q = slope2 * (1.0f / cs);
#pragma unroll
                for (int r = 0; r < 16; ++r) p0[r] = fmaf(s2q, (float)((r & 3) + 8 * (r >> 2)), lbq);
#pragma unroll
                for (int ds = 0; ds < 8; ++ds) {
                    const int ch = ((2 * ds + hh) ^ kq) << 4;
                    const bf16x8 k0 = *(const LAS bf16x8*)(kl + koff[h32] + ch);
                    p0 = __builtin_amdgcn_mfma_f32_32x32x16_bf16(k0, qf[ds], p0, 0, 0, 0);
                }
                float mx0 = -INFINITY;
                const int dq = qrow - kb0 - 32 * h32 - 4 * hh;
#pragma unroll
                for (int r = 0; r < 16; ++r) {
                    if (diag) { if ((r & 3) + 8 * (r >> 2) > dq) p0[r] = -INFINITY; }
                    mx0 = fmaxf(mx0, p0[r]);
                }
                const float tc = slope2 * (float)(kb0 + 32 * h32);
                float tmax = fmaf(mx0, cs, tc);
                tmax = fmaxf(tmax, __shfl_xor(tmax, 32));
                const float mn = fmaxf(m, tmax);
                if (__ballot(mn > m) != 0ull) {
                    const float alpha = __builtin_amdgcn_exp2f(m - mn);
                    l *= alpha;
#pragma unroll
                    for (int db = 0; db < 4; ++db)
#pragma unroll
                        for (int r = 0; r < 16; ++r) o[db][r] *= alpha;
                    m = mn;
                }
                const float c0 = tc - m;
                float ls = 0.f;
#pragma unroll
                for (int r = 0; r < 16; ++r) { const float e0 = __builtin_amdgcn_exp2f(fmaf(p0[r], cs, c0)); p0[r] = e0; ls += e0; }
                l += ls;
                bf16x8 pb[2];
#pragma unroll
                for (int s2 = 0; s2 < 2; ++s2) {
                    u32x4 w0;
#pragma unroll
                    for (int q = 0; q < 4; ++q) w0[q] = pk2(p0[8 * s2 + 2 * q], p0[8 * s2 + 2 * q + 1]);
                    pb[s2] = __builtin_bit_cast(bf16x8, w0);
                }
#pragma unroll
                for (int db = 0; db < 4; ++db) {
#pragma unroll
                    for (int s2 = 0; s2 < 2; ++s2) {
                        const int ks = 2 * h32 + s2;
                        const v4i16_t lo = __builtin_amdgcn_ds_read_tr16_b64_v4i16((LAS v4i16_t*)(kl + voff[db] + (16 * ks) * 256));
                        const v4i16_t hi = __builtin_amdgcn_ds_read_tr16_b64_v4i16((LAS v4i16_t*)(kl + voff[db] + (16 * ks + 8) * 256));
                        bf16x8 vf; vf[0] = lo[0]; vf[1] = lo[1]; vf[2] = lo[2]; vf[3] = lo[3]; vf[4] = hi[0]; vf[5] = hi[1]; vf[6] = hi[2]; vf[7] = hi[3];
                        o[db] = __builtin_amdgcn_mfma_f32_32x32x16_bf16(vf, pb[s2], o[db], 0, 0, 0);
                    }
                }
            }
        }
        asm volatile("s_waitcnt vmcnt(0)" ::: "memory");
        __syncthreads();
    }
    l += __shfl_xor(l, 32);
    const float inv = 1.0f / l;
    const int orow_tok = b * SEQ + qrow, ocol0 = head * HD + 4 * hh;
#pragma unroll
    for (int db = 0; db < 4; ++db)
#pragma unroll
        for (int rq = 0; rq < 4; ++rq) {
            uint2 ov; ov.x = pk2(o[db][4 * rq] * inv, o[db][4 * rq + 1] * inv); ov.y = pk2(o[db][4 * rq + 2] * inv, o[db][4 * rq + 3] * inv);
            *(uint2*)(ATT + stg_off(orow_tok, ocol0 + db * 32 + 8 * rq)) = ov;
        }
}
__device__ __forceinline__ void phase_attn(LAS unsigned char* lds, const GemmCtx& c, const bf16_t* Qb, const bf16_t* Kb, const bf16_t* Vb, const float* KM, bf16_t* ATT) {
    for (int it = blockIdx.x; it < 256; it += gridDim.x) {
        const int p = (gridDim.x == 256) ? vblock(lds) : it;
        const int bh = p >> 2, j = p & 3;
        attn_unit(lds, c, bh, 7 - j, Qb, Kb, Vb, KM, ATT);
        attn_unit(lds, c, bh, j, Qb, Kb, Vb, KM, ATT);
    }
}

#define XB_TMO      128
#define XB_XCNT(j)  (256  + 64 * (j))
#define XB_XSUB(j)  (1280 + 64 * (j))
#define XB_XGEN(j)  (2304 + 64 * (j))
#define XB_TOP      3328
#define XB_TOPGEN   3392
#define XCD_BAR_WORDS 3456
#define XB_SPIN_CAP (1u << 22)
__device__ __forceinline__ unsigned xb_ld(unsigned* p)              { return __hip_atomic_load(p, __ATOMIC_RELAXED, __HIP_MEMORY_SCOPE_AGENT); }
__device__ __forceinline__ unsigned xb_add(unsigned* p, unsigned v) { return __hip_atomic_fetch_add(p, v, __ATOMIC_RELAXED, __HIP_MEMORY_SCOPE_AGENT); }
__device__ __forceinline__ unsigned xb_xcc_id() { return (unsigned)__builtin_amdgcn_s_getreg((3 << 11) | 20) & 0xFu; }
#define XB_SPIN(cond, bar) do { unsigned _sp = 0; while (cond) { __builtin_amdgcn_s_sleep(1); \
    if ((++_sp & 255u) == 0u) { if (xb_ld(&(bar)[XB_TMO])) break; if (_sp > XB_SPIN_CAP) { atomicAdd(&(bar)[XB_TMO], 1u); break; } } } } while (0)
__device__ __forceinline__ void xcd_barrier_complete(unsigned* bar, unsigned x, unsigned& nloc, unsigned& nx) {
    const unsigned G = gridDim.x;
    unsigned sum, cnt, mine, sp = 0u;
    for (;;) {
        sum = 0u; cnt = 0u; mine = 0u;
#pragma unroll
        for (unsigned j = 0; j < 16; ++j) { const unsigned cc = xb_ld(&bar[XB_XCNT(j)]); sum += cc; cnt += (cc > 0u) ? 1u : 0u; mine = (j == x) ? cc : mine; }
        if (sum == G) break;
        __builtin_amdgcn_s_sleep(1);
        if ((++sp & 255u) == 0u) { if (xb_ld(&bar[XB_TMO])) break; if (sp > XB_SPIN_CAP) { atomicAdd(&bar[XB_TMO], 1u); break; } }
    }
    nloc = mine > 0u ? mine : 1u; nx = cnt > 0u ? cnt : 1u;
}
__device__ __forceinline__ void grid_barrier(unsigned* bar, volatile LAS unsigned* st) {
    asm volatile("s_waitcnt vmcnt(0)" ::: "memory");
    __syncthreads();
    if (threadIdx.x == 0) {
        __builtin_amdgcn_s_waitcnt(0);
        const unsigned x = xb_xcc_id();
        unsigned nloc = st[0], nx = st[1];
        if (nloc == 0u) {
            xcd_barrier_complete(bar, x, nloc, nx); st[0] = nloc; st[1] = nx;
            unsigned ok = 1u;
#pragma unroll
            for (unsigned j = 0; j < 16; ++j) { const unsigned cc = xb_ld(&bar[XB_XCNT(j)]); ok &= (j < 8u) ? (cc == 32u ? 1u : 0u) : (cc == 0u ? 1u : 0u); }
            st[3] = ok;
        }
        const unsigned old = xb_add(&bar[XB_XSUB(x)], 1u);
        const unsigned gen = old / nloc;
        if (old + 1u == (gen + 1u) * nloc) {
            __builtin_amdgcn_fence(__ATOMIC_RELEASE, "agent");
            asm volatile("s_waitcnt vmcnt(0)" ::: "memory");
            const unsigned og = xb_add(&bar[XB_TOP], 1u);
            const unsigned tg = og / nx;
            if (og + 1u == (tg + 1u) * nx) xb_add(&bar[XB_TOPGEN], 1u);
            else XB_SPIN(xb_ld(&bar[XB_TOPGEN]) == tg, bar);
            __builtin_amdgcn_fence(__ATOMIC_ACQUIRE, "agent");
            xb_add(&bar[XB_XGEN(x)], 1u);
            asm volatile("s_waitcnt vmcnt(0)" ::: "memory");
        } else {
            XB_SPIN(xb_ld(&bar[XB_XGEN(x)]) == gen, bar);
            __builtin_amdgcn_fence(__ATOMIC_ACQUIRE, "agent");
            asm volatile("s_waitcnt vmcnt(0)" ::: "memory");
        }
    }
    __syncthreads();
}

__global__ void __launch_bounds__(512, 2) mega(MegaArgs a) {
    extern __shared__ __attribute__((aligned(16))) unsigned char lds_raw[];
    LAS unsigned char* lds = (LAS unsigned char*)lds_raw;
    const int ph_lo = a.ph_lo, ph_hi = a.ph_hi;
    volatile LAS unsigned* bst = (volatile LAS unsigned*)(lds + LDS_MISC + 8160);
    if (threadIdx.x == 0) { bst[0] = 0u; bst[1] = 0u; bst[2] = 0xffffu; bst[3] = 0u; }
    if (ph_hi - ph_lo > 1 && threadIdx.x == 0) {
        const unsigned x = xb_xcc_id(); const unsigned rank = xb_add(&((unsigned*)ARG(ws))[XB_XCNT(x)], 1u);
        bst[2] = (x < 8u && rank < 32u) ? x * 32u + rank : 0xffffu;
    }
    __syncthreads();
#ifndef REPEAT_PH
#define REPEAT_PH -1
#endif
#ifndef ABLATE
#define ABLATE 0
#endif
#define IN(k) (ph_lo <= (k) && (k) < ph_hi)
#define SEAM(k) if (IN(k) && IN((k) + 1)) grid_barrier((unsigned*)ARG(ws), bst);
    if (IN(PH_PREP)) { const GemmCtx c = make_ctx(); const int gwave = blockIdx.x * 8 + c.wid, nwaves = gridDim.x * 8; (void)gwave; (void)nwaves;
        norm_rows(ARG(x), ARG(mix_norm), WSP(bf16_t, WS_A1), nullptr, nullptr, gwave, nwaves, c.lane);
        convert_wt<true>(lds, c, ARG(conv_w_in), 6144, WSP(bf16_t, WS_WT));
        convert_wt(lds, c, ARG(conv_w_out), 2048, WSP(bf16_t, WS_WT) + (size_t)6144 * DM);
        convert_wt(lds, c, ARG(w_kv), 4096, WSP(bf16_t, WS_WT) + (size_t)(6144 + 2048) * DM, ARG(kv_norm));
        convert_wt(lds, c, ARG(w_q), 2048, WSP(bf16_t, WS_WT) + (size_t)(6144 + 2048 + 4096) * DM, ARG(mix_norm) + DM);
        convert_wt(lds, c, ARG(w_o), 2048, WSP(bf16_t, WS_WT) + (size_t)(6144 + 2048 + 6144) * DM); }
    if (IN(PH_PREP) && REPEAT_PH == PH_PREP) grid_barrier((unsigned*)ARG(ws), bst);
    if (IN(PH_PREP) && REPEAT_PH == PH_PREP) { const GemmCtx c = make_ctx(); const int gwave = blockIdx.x * 8 + c.wid, nwaves = gridDim.x * 8; (void)gwave; (void)nwaves;
        norm_rows(ARG(x), ARG(mix_norm), WSP(bf16_t, WS_A1), nullptr, nullptr, gwave, nwaves, c.lane);
        convert_wt<true>(lds, c, ARG(conv_w_in), 6144, WSP(bf16_t, WS_WT));
        convert_wt(lds, c, ARG(conv_w_out), 2048, WSP(bf16_t, WS_WT) + (size_t)6144 * DM);
        convert_wt(lds, c, ARG(w_kv), 4096, WSP(bf16_t, WS_WT) + (size_t)(6144 + 2048) * DM, ARG(kv_norm));
        convert_wt(lds, c, ARG(w_q), 2048, WSP(bf16_t, WS_WT) + (size_t)(6144 + 2048 + 4096) * DM, ARG(mix_norm) + DM);
        convert_wt(lds, c, ARG(w_o), 2048, WSP(bf16_t, WS_WT) + (size_t)(6144 + 2048 + 6144) * DM); }
    SEAM(PH_PREP)
    if (IN(PH_GEMM1)) { const GemmCtx c = make_ctx(); const int gwave = blockIdx.x * 8 + c.wid, nwaves = gridDim.x * 8; (void)gwave; (void)nwaves;
        phase_gemm1(lds, c, WSP(bf16_t, WS_A1), WSP(bf16_t, WS_WT), WSP(bf16_t, WS_BCX)); }
    if (IN(PH_GEMM1) && REPEAT_PH == PH_GEMM1) grid_barrier((unsigned*)ARG(ws), bst);
    if (IN(PH_GEMM1) && REPEAT_PH == PH_GEMM1) { const GemmCtx c = make_ctx(); const int gwave = blockIdx.x * 8 + c.wid, nwaves = gridDim.x * 8; (void)gwave; (void)nwaves;
        phase_gemm1(lds, c, WSP(bf16_t, WS_A1), WSP(bf16_t, WS_WT), WSP(bf16_t, WS_BCX)); }
    SEAM(PH_GEMM1)
    if (IN(PH_CONV)) { const GemmCtx c = make_ctx(); const int gwave = blockIdx.x * 8 + c.wid, nwaves = gridDim.x * 8; (void)gwave; (void)nwaves;
        conv_phase(WSP(bf16_t, WS_BCX), WSP(bf16_t, WS_BCX) + (size_t)NTOK * DM, ARG(conv_w), WSP(bf16_t, WS_Z), blockIdx.x * 512 + c.tid, gridDim.x * 512); }
    if (IN(PH_CONV) && REPEAT_PH == PH_CONV) grid_barrier((unsigned*)ARG(ws), bst);
    if (IN(PH_CONV) && REPEAT_PH == PH_CONV) { const GemmCtx c = make_ctx(); const int gwave = blockIdx.x * 8 + c.wid, nwaves = gridDim.x * 8; (void)gwave; (void)nwaves;
        conv_phase(WSP(bf16_t, WS_BCX), WSP(bf16_t, WS_BCX) + (size_t)NTOK * DM, ARG(conv_w), WSP(bf16_t, WS_Z), blockIdx.x * 512 + c.tid, gridDim.x * 512); }
    SEAM(PH_CONV)
    if (IN(PH_GEMM2)) { const GemmCtx c = make_ctx(); const int gwave = blockIdx.x * 8 + c.wid, nwaves = gridDim.x * 8; (void)gwave; (void)nwaves;
        phase_gemm_resid<false>(lds, c, WSP(bf16_t, WS_Z), WSP(bf16_t, WS_WT) + (size_t)6144 * DM, ARG(x), WSP(bf16_t, WS_HB)); }
    if (IN(PH_GEMM2) && REPEAT_PH == PH_GEMM2) grid_barrier((unsigned*)ARG(ws), bst);
    if (IN(PH_GEMM2) && REPEAT_PH == PH_GEMM2) { const GemmCtx c = make_ctx(); const int gwave = blockIdx.x * 8 + c.wid, nwaves = gridDim.x * 8; (void)gwave; (void)nwaves;
        phase_gemm_resid<false>(lds, c, WSP(bf16_t, WS_Z), WSP(bf16_t, WS_WT) + (size_t)6144 * DM, ARG(x), WSP(bf16_t, WS_HB)); }
    SEAM(PH_GEMM2)
    if (IN(PH_ROUTER0)) { const GemmCtx c = make_ctx(); const int gwave = blockIdx.x * 8 + c.wid, nwaves = gridDim.x * 8; (void)gwave; (void)nwaves;
        phase_router(lds, c, WSP(bf16_t, WS_HB), ARG(ffn_norm), ARG(router_group), ARG(router_expert), WSP(bf16_t, WS_A1), WSP(int, WS_TOKE), WSP(float, WS_TOKW), WSP(float, WS_TOKR)); }
    if (IN(PH_ROUTER0) && REPEAT_PH == PH_ROUTER0) grid_barrier((unsigned*)ARG(ws), bst);
    if (IN(PH_ROUTER0) && REPEAT_PH == PH_ROUTER0) { const GemmCtx c = make_ctx(); const int gwave = blockIdx.x * 8 + c.wid, nwaves = gridDim.x * 8; (void)gwave; (void)nwaves;
        phase_router(lds, c, WSP(bf16_t, WS_HB), ARG(ffn_norm), ARG(router_group), ARG(router_expert), WSP(bf16_t, WS_A1), WSP(int, WS_TOKE), WSP(float, WS_TOKW), WSP(float, WS_TOKR)); }
    SEAM(PH_ROUTER0)
    if (IN(PH_MOEA0)) { const GemmCtx c = make_ctx(); const int gwave = blockIdx.x * 8 + c.wid, nwaves = gridDim.x * 8; (void)gwave; (void)nwaves;
        phase_moe(lds, c, 0); }
    if (IN(PH_MOEA0) && IN(PH_COMBINE0)) grid_barrier((unsigned*)ARG(ws), bst);
    if (IN(PH_COMBINE0)) { const GemmCtx c = make_ctx(); const int gwave = blockIdx.x * 8 + c.wid, nwaves = gridDim.x * 8; (void)gwave; (void)nwaves;
        combine_rows2(WSP(bf16_t, WS_HB), WSP(bf16_t, WS_Y), ARG(kv_norm), WSP(bf16_t, WS_A1), nullptr, nullptr, WSP(bf16_t, WS_HB), nullptr, gwave, nwaves, c.lane); }
    if (IN(PH_COMBINE0) && REPEAT_PH == PH_COMBINE0) grid_barrier((unsigned*)ARG(ws), bst);
    if (IN(PH_COMBINE0) && REPEAT_PH == PH_COMBINE0) { const GemmCtx c = make_ctx(); const int gwave = blockIdx.x * 8 + c.wid, nwaves = gridDim.x * 8; (void)gwave; (void)nwaves;
        combine_rows2(WSP(bf16_t, WS_HB), WSP(bf16_t, WS_Y), ARG(kv_norm), WSP(bf16_t, WS_A1), nullptr, nullptr, WSP(bf16_t, WS_HB), nullptr, gwave, nwaves, c.lane); }
    SEAM(PH_COMBINE0)
    if (IN(PH_GEMM3)) { const GemmCtx c = make_ctx(); const int gwave = blockIdx.x * 8 + c.wid, nwaves = gridDim.x * 8; (void)gwave; (void)nwaves;
        phase_gemm3(lds, c, WSP(bf16_t, WS_A1), WSP(bf16_t, WS_A1), WSP(bf16_t, WS_WT) + (size_t)(6144 + 2048) * DM, ARG(k_norm), ARG(q_norm),
                                  WSP(bf16_t, WS_BCX), WSP(bf16_t, WS_BCX) + (size_t)NTOK * DM, WSP(bf16_t, WS_BCX) + (size_t)2 * NTOK * DM, WSP(float, WS_KMEAN)); }
    if (IN(PH_GEMM3) && REPEAT_PH == PH_GEMM3) grid_barrier((unsigned*)ARG(ws), bst);
    if (IN(PH_GEMM3) && REPEAT_PH == PH_GEMM3) { const GemmCtx c = make_ctx(); const int gwave = blockIdx.x * 8 + c.wid, nwaves = gridDim.x * 8; (void)gwave; (void)nwaves;
        phase_gemm3(lds, c, WSP(bf16_t, WS_A1), WSP(bf16_t, WS_A1), WSP(bf16_t, WS_WT) + (size_t)(6144 + 2048) * DM, ARG(k_norm), ARG(q_norm),
                                  WSP(bf16_t, WS_BCX), WSP(bf16_t, WS_BCX) + (size_t)NTOK * DM, WSP(bf16_t, WS_BCX) + (size_t)2 * NTOK * DM, WSP(float, WS_KMEAN)); }
    SEAM(PH_GEMM3)
    if (IN(PH_ATTN)) { const GemmCtx c = make_ctx(); const int gwave = blockIdx.x * 8 + c.wid, nwaves = gridDim.x * 8; (void)gwave; (void)nwaves;
        phase_attn(lds, c, WSP(bf16_t, WS_BCX) + (size_t)2 * NTOK * DM, WSP(bf16_t, WS_BCX), WSP(bf16_t, WS_BCX) + (size_t)NTOK * DM, WSP(float, WS_KMEAN), WSP(bf16_t, WS_Z)); }
    if (IN(PH_ATTN) && REPEAT_PH == PH_ATTN) grid_barrier((unsigned*)ARG(ws), bst);
    if (IN(PH_ATTN) && REPEAT_PH == PH_ATTN) { const GemmCtx c = make_ctx(); const int gwave = blockIdx.x * 8 + c.wid, nwaves = gridDim.x * 8; (void)gwave; (void)nwaves;
        phase_attn(lds, c, WSP(bf16_t, WS_BCX) + (size_t)2 * NTOK * DM, WSP(bf16_t, WS_BCX), WSP(bf16_t, WS_BCX) + (size_t)NTOK * DM, WSP(float, WS_KMEAN), WSP(bf16_t, WS_Z)); }
    SEAM(PH_ATTN)
    if (IN(PH_GEMM4)) { const GemmCtx c = make_ctx(); const int gwave = blockIdx.x * 8 + c.wid, nwaves = gridDim.x * 8; (void)gwave; (void)nwaves;
        phase_gemm_resid<true>(lds, c, WSP(bf16_t, WS_Z), WSP(bf16_t, WS_WT) + (size_t)(6144 + 2048 + 6144) * DM, WSP(bf16_t, WS_HB), WSP(bf16_t, WS_HB)); }
    if (IN(PH_GEMM4) && REPEAT_PH == PH_GEMM4) grid_barrier((unsigned*)ARG(ws), bst);
    if (IN(PH_GEMM4) && REPEAT_PH == PH_GEMM4) { const GemmCtx c = make_ctx(); const int gwave = blockIdx.x * 8 + c.wid, nwaves = gridDim.x * 8; (void)gwave; (void)nwaves;
        phase_gemm_resid<true>(lds, c, WSP(bf16_t, WS_Z), WSP(bf16_t, WS_WT) + (size_t)(6144 + 2048 + 6144) * DM, WSP(bf16_t, WS_HB), WSP(bf16_t, WS_HB)); }
    SEAM(PH_GEMM4)
    if (IN(PH_ROUTER1)) { const GemmCtx c = make_ctx(); const int gwave = blockIdx.x * 8 + c.wid, nwaves = gridDim.x * 8; (void)gwave; (void)nwaves;
        phase_router(lds, c, WSP(bf16_t, WS_HB), ARG(ffn_norm) + DM, ARG(router_group) + (size_t)DM * NG, ARG(router_expert) + (size_t)DM * NE, WSP(bf16_t, WS_A1), WSP(int, WS_TOKE) + 2 * NTOK, WSP(float, WS_TOKW) + 2 * NTOK, WSP(float, WS_TOKR) + NTOK); }
    if (IN(PH_ROUTER1) && REPEAT_PH == PH_ROUTER1) grid_barrier((unsigned*)ARG(ws), bst);
    if (IN(PH_ROUTER1) && REPEAT_PH == PH_ROUTER1) { const GemmCtx c = make_ctx(); const int gwave = blockIdx.x * 8 + c.wid, nwaves = gridDim.x * 8; (void)gwave; (void)nwaves;
        phase_router(lds, c, WSP(bf16_t, WS_HB), ARG(ffn_norm) + DM, ARG(router_group) + (size_t)DM * NG, ARG(router_expert) + (size_t)DM * NE, WSP(bf16_t, WS_A1), WSP(int, WS_TOKE) + 2 * NTOK, WSP(float, WS_TOKW) + 2 * NTOK, WSP(float, WS_TOKR) + NTOK); }
    SEAM(PH_ROUTER1)
    if (IN(PH_MOEA1)) { const GemmCtx c = make_ctx(); const int gwave = blockIdx.x * 8 + c.wid, nwaves = gridDim.x * 8; (void)gwave; (void)nwaves;
        phase_moe(lds, c, 1); }
    if (IN(PH_MOEA1) && IN(PH_COMBINE1)) grid_barrier((unsigned*)ARG(ws), bst);
    if (IN(PH_COMBINE1)) { const GemmCtx c = make_ctx(); const int gwave = blockIdx.x * 8 + c.wid, nwaves = gridDim.x * 8; (void)gwave; (void)nwaves;
        combine_rows2(WSP(bf16_t, WS_HB), WSP(bf16_t, WS_Y), nullptr, nullptr, nullptr, nullptr, nullptr, ARG(H), gwave, nwaves, c.lane); }
    if (IN(PH_COMBINE1) && REPEAT_PH == PH_COMBINE1) grid_barrier((unsigned*)ARG(ws), bst);
    if (IN(PH_COMBINE1) && REPEAT_PH == PH_COMBINE1) { const GemmCtx c = make_ctx(); const int gwave = blockIdx.x * 8 + c.wid, nwaves = gridDim.x * 8; (void)gwave; (void)nwaves;
        combine_rows2(WSP(bf16_t, WS_HB), WSP(bf16_t, WS_Y), nullptr, nullptr, nullptr, nullptr, nullptr, ARG(H), gwave, nwaves, c.lane); }
#undef IN
#undef SEAM
}

extern "C" void kernel_launch(void* const* d_in, const int* in_sizes, int n_in, void* d_out, int out_size, void* d_ws, size_t ws_size, hipStream_t stream) {
    const float* x = (const float*)d_in[0];
    const float* mix_norm = (const float*)d_in[1];
    const float* ffn_norm = (const float*)d_in[2];
    const float* conv_w_in = (const float*)d_in[3];
    const float* conv_w = (const float*)d_in[4];
    const float* conv_w_out = (const float*)d_in[5];
    const float* kv_norm = (const float*)d_in[6];
    const float* w_kv = (const float*)d_in[7];
    const float* k_norm = (const float*)d_in[8];
    const float* w_q = (const float*)d_in[9];
    const float* q_norm = (const float*)d_in[10];
    const float* w_o = (const float*)d_in[11];
    const float* router_group = (const float*)d_in[12];
    const float* router_expert = (const float*)d_in[13];
    const float* w_gate = (const float*)d_in[14];
    const float* w_up = (const float*)d_in[15];
    const float* w_down = (const float*)d_in[16];
    float* H = (float*)d_out;
    unsigned char* ws = (unsigned char*)d_ws;
    if (ws_size < WS_END) { fprintf(stderr, "workspace too small: %zu < %zu\n", ws_size, (size_t)WS_END); return; }
    int* cnt = (int*)(ws + WS_CNT);
    bf16_t* A1 = (bf16_t*)(ws + WS_A1); bf16_t* A2 = (bf16_t*)(ws + WS_A2);
    bf16_t* BCX = (bf16_t*)(ws + WS_BCX);
    bf16_t* Kb = (bf16_t*)(ws + WS_BCX); bf16_t* Vb = Kb + (size_t)NTOK * DM; bf16_t* Qb = Vb + (size_t)NTOK * DM;
    bf16_t* Z = (bf16_t*)(ws + WS_Z); bf16_t* ATT = Z;
    bf16_t* ACT = (bf16_t*)(ws + WS_ACT); bf16_t* Y = (bf16_t*)(ws + WS_Y);
    float* KM = (float*)(ws + WS_KMEAN);
    int* list = (int*)(ws + WS_LIST); float* tokw = (float*)(ws + WS_TOKW); int* toke = (int*)(ws + WS_TOKE);
    float* T = (float*)(ws + WS_T);
    const size_t nd = (size_t)NTOK * DM;
    static bool attr = false;
    if (!attr) { (void)hipFuncSetAttribute((const void*)mega, hipFuncAttributeMaxDynamicSharedMemorySize, LDS_BYTES); attr = true; }
    MegaArgs ma{};
    ma.x = x; ma.mix_norm = mix_norm; ma.ffn_norm = ffn_norm; ma.conv_w_in = conv_w_in; ma.conv_w = conv_w; ma.conv_w_out = conv_w_out;
    ma.kv_norm = kv_norm; ma.w_kv = w_kv; ma.k_norm = k_norm; ma.w_q = w_q; ma.q_norm = q_norm; ma.w_o = w_o;
    ma.router_group = router_group; ma.router_expert = router_expert; ma.w_gate = w_gate; ma.w_up = w_up; ma.w_down = w_down;
    ma.H = H; ma.ws = ws;
    static int grid = 0;
    if (!grid) {
        int dev = 0, cus = 0, per_cu = 0;
        (void)hipGetDevice(&dev);
        (void)hipDeviceGetAttribute(&cus, hipDeviceAttributeMultiprocessorCount, dev);
        (void)hipOccupancyMaxActiveBlocksPerMultiprocessor(&per_cu, (const void*)mega, 512, LDS_BYTES);
        if (per_cu < 1) per_cu = 1;
        grid = cus * 1;
        if (grid > 256) grid = 256;
    }
    (void)hipMemsetAsync(ws + WS_CTL, 0, 16384, stream);
    ma.ph_lo = 0; ma.ph_hi = PH_END;
    void* kargs[] = {&ma};
    hipError_t le = hipLaunchCooperativeKernel((const void*)mega, dim3(grid), dim3(512), kargs, LDS_BYTES, stream);
    if (le != hipSuccess) fprintf(stderr, "cooperative launch failed: %s (grid %d)\n", hipGetErrorString(le), grid);
}
```

```cpp
#include <hip/hip_runtime.h>
#include <cstdint>
#include <cstddef>
#include <cstdio>

constexpr int NTOK = 8192, DM = 2048, SEQ = 2048, NBATCH = 4, NH = 16, HD = 128, NBLK = 8, BLK = 256;
constexpr int NE = 32, DE = 512, NG = 4, EPG = 8;
constexpr float EPS = 1e-6f;
constexpr int LDP = DM + 128;

typedef unsigned short bf16_t;
typedef float f32x4 __attribute__((ext_vector_type(4)));

constexpr size_t MB = 1024 * 1024;
constexpr size_t WS_CTL = 0;
constexpr size_t WS_CNT = 64 * 1024;
constexpr size_t WS_A1 = 1 * MB;
constexpr size_t WS_A2 = WS_A1 + 36 * MB;
constexpr size_t WS_BCX = WS_A2 + 36 * MB;
constexpr size_t WS_Z = WS_BCX + 96 * MB;
constexpr size_t WS_ACT = WS_Z + 36 * MB;
constexpr size_t WS_Y = WS_ACT + 16 * MB;
constexpr size_t WS_KMEAN = WS_Y + 64 * MB;
constexpr size_t WS_LIST = WS_KMEAN + 1 * MB;
constexpr size_t WS_TOKW = WS_LIST + 2 * MB;
constexpr size_t WS_TOKE = WS_TOKW + 1 * MB;
constexpr size_t WS_T = WS_TOKE + 1 * MB;
constexpr size_t WS_WT = WS_T;
constexpr size_t WS_HB = WS_T + 96 * MB;
constexpr size_t WS_RINV = WS_TOKW + 640 * 1024;
constexpr size_t WS_TOKR = WS_TOKW + 512 * 1024;
constexpr size_t WS_END = WS_T + 192 * MB;

__device__ __forceinline__ unsigned pk2(float lo, float hi) {
    typedef float f2 __attribute__((ext_vector_type(2)));
    typedef __bf16 b2 __attribute__((ext_vector_type(2)));
    f2 v = {lo, hi}; b2 b = __builtin_convertvector(v, b2); return __builtin_bit_cast(unsigned, b);
}
__device__ __forceinline__ float bflo(unsigned u) { return __uint_as_float(u << 16); }
__device__ __forceinline__ float bfhi(unsigned u) { return __uint_as_float(u & 0xffff0000u); }
__device__ __forceinline__ float bf2f(bf16_t b) { return __uint_as_float((unsigned)b << 16); }
__device__ __forceinline__ float wave_sum(float v) {
#pragma unroll
    for (int o = 1; o < 64; o <<= 1) v += __shfl_xor(v, o);
    return v;
}
__device__ __forceinline__ float wave_max(float v) {
#pragma unroll
    for (int o = 1; o < 64; o <<= 1) v = fmaxf(v, __shfl_xor(v, o));
    return v;
}

__device__ __forceinline__ size_t stg_off(int row, int k) {
    const int r = row & 255;
    return ((size_t)((row >> 8) * 64 + (k >> 5)) * 8192) + (size_t)((r * 64 + (((((k & 31) >> 3)) ^ ((0 - (r >> 2)) & 3)) << 4)) >> 1) + (k & 7);
}
__device__ __forceinline__ void norm_rows(const float* __restrict__ src, const float* g1, bf16_t* o1, const float* g2, bf16_t* o2,
                                          int gwave, int nwaves, int lane) {
    for (int row = gwave; row < NTOK; row += nwaves) {
        const f32x4* p = (const f32x4*)(src + (size_t)row * DM);
        f32x4 v[8]; float ss = 0.f;
#pragma unroll
        for (int i = 0; i < 8; ++i) { v[i] = p[lane + 64 * i]; ss += v[i][0] * v[i][0] + v[i][1] * v[i][1] + v[i][2] * v[i][2] + v[i][3] * v[i][3]; }
        ss = wave_sum(ss);
        const float r = rsqrtf(ss * (1.0f / DM) + EPS);
#pragma unroll
        for (int i = 0; i < 8; ++i) {
            const int c = 4 * (lane + 64 * i);
            const f32x4 g = *(const f32x4*)(g1 + c);
            uint2 o; o.x = pk2(v[i][0] * r * g[0], v[i][1] * r * g[1]); o.y = pk2(v[i][2] * r * g[2], v[i][3] * r * g[3]);
            *(uint2*)(o1 + stg_off(row, c)) = o;
            if (g2) {
                const f32x4 h = *(const f32x4*)(g2 + c);
                uint2 q; q.x = pk2(v[i][0] * r * h[0], v[i][1] * r * h[1]); q.y = pk2(v[i][2] * r * h[2], v[i][3] * r * h[3]);
                *(uint2*)(o2 + stg_off(row, c)) = q;
            }
        }
    }
}

__device__ __forceinline__ void combine_rows(float* H, const bf16_t* __restrict__ Y, const float* g1, bf16_t* o1, const float* g2, bf16_t* o2,
                                             int gwave, int nwaves, int lane) {
    for (int row = gwave; row < NTOK; row += nwaves) {
        f32x4* p = (f32x4*)(H + (size_t)row * DM);
        const uint2* y0 = (const uint2*)(Y + (size_t)(2 * row) * DM);
        const uint2* y1 = (const uint2*)(Y + (size_t)(2 * row + 1) * DM);
        f32x4 v[8]; float ss = 0.f;
#pragma unroll
        for (int i = 0; i < 8; ++i) {
            v[i] = p[lane + 64 * i];
            const uint2 a = y0[lane + 64 * i], b = y1[lane + 64 * i];
            v[i][0] += bflo(a.x) + bflo(b.x); v[i][1] += bfhi(a.x) + bfhi(b.x);
            v[i][2] += bflo(a.y) + bflo(b.y); v[i][3] += bfhi(a.y) + bfhi(b.y);
            p[lane + 64 * i] = v[i];
            ss += v[i][0] * v[i][0] + v[i][1] * v[i][1] + v[i][2] * v[i][2] + v[i][3] * v[i][3];
        }
        if (g1) {
            ss = wave_sum(ss);
            const float r = rsqrtf(ss * (1.0f / DM) + EPS);
#pragma unroll
            for (int i = 0; i < 8; ++i) {
                const int c = 4 * (lane + 64 * i);
                if (g2 == nullptr) {
                    uint2 o; o.x = pk2(v[i][0] * r, v[i][1] * r); o.y = pk2(v[i][2] * r, v[i][3] * r);
                    *(uint2*)(o1 + stg_off(row, c)) = o;
                } else {
                    const f32x4 g = *(const f32x4*)(g1 + c);
                    uint2 o; o.x = pk2(v[i][0] * r * g[0], v[i][1] * r * g[1]); o.y = pk2(v[i][2] * r * g[2], v[i][3] * r * g[3]);
                    *(uint2*)(o1 + stg_off(row, c)) = o;
                    const f32x4 h = *(const f32x4*)(g2 + c);
                    uint2 q; q.x = pk2(v[i][0] * r * h[0], v[i][1] * r * h[1]); q.y = pk2(v[i][2] * r * h[2], v[i][3] * r * h[3]);
                    *(uint2*)(o2 + stg_off(row, c)) = q;
                }
            }
        }
    }
}

__device__ __forceinline__ void combine_rows2(const bf16_t* __restrict__ HBin, const bf16_t* __restrict__ Y, const float* g1, bf16_t* o1, const float* g2, bf16_t* o2,
                                              bf16_t* HBout, float* OUT, int gwave, int nwaves, int lane, float* rs_out = nullptr) {
    for (int row = gwave; row < NTOK; row += nwaves) {
        const uint2* hp = (const uint2*)(HBin + (size_t)row * DM);
        const uint2* y0 = (const uint2*)(Y + (size_t)(2 * row) * DM);
        const uint2* y1 = (const uint2*)(Y + (size_t)(2 * row + 1) * DM);
        f32x4 v[8]; float ss = 0.f;
#pragma unroll
        for (int i = 0; i < 8; ++i) {
            const uint2 h = hp[lane + 64 * i], a = y0[lane + 64 * i], b = y1[lane + 64 * i];
            v[i][0] = bflo(h.x) + (bflo(a.x) + bflo(b.x)); v[i][1] = bfhi(h.x) + (bfhi(a.x) + bfhi(b.x));
            v[i][2] = bflo(h.y) + (bflo(a.y) + bflo(b.y)); v[i][3] = bfhi(h.y) + (bfhi(a.y) + bfhi(b.y));
            if (HBout) { uint2 o; o.x = pk2(v[i][0], v[i][1]); o.y = pk2(v[i][2], v[i][3]); *(uint2*)(HBout + (size_t)row * DM + 4 * (lane + 64 * i)) = o; }
            if (OUT) *(f32x4*)(OUT + (size_t)row * DM + 4 * (lane + 64 * i)) = v[i];
            ss += v[i][0] * v[i][0] + v[i][1] * v[i][1] + v[i][2] * v[i][2] + v[i][3] * v[i][3];
        }
        if (g1) {
            ss = wave_sum(ss);
            const float r = rsqrtf(ss * (1.0f / DM) + EPS);
            if (rs_out && lane == 0) rs_out[row] = sqrtf(ss * (1.0f / DM) + EPS);
#pragma unroll
            for (int i = 0; i < 8; ++i) {
                const int c = 4 * (lane + 64 * i);
                if (g2 == nullptr) {
                    uint2 o; o.x = pk2(v[i][0] * r, v[i][1] * r); o.y = pk2(v[i][2] * r, v[i][3] * r);
                    *(uint2*)(o1 + stg_off(row, c)) = o;
                } else {
                    const f32x4 g = *(const f32x4*)(g1 + c);
                    uint2 o; o.x = pk2(v[i][0] * r * g[0], v[i][1] * r * g[1]); o.y = pk2(v[i][2] * r * g[2], v[i][3] * r * g[3]);
                    *(uint2*)(o1 + stg_off(row, c)) = o;
                    const f32x4 h = *(const f32x4*)(g2 + c);
                    uint2 q; q.x = pk2(v[i][0] * r * h[0], v[i][1] * r * h[1]); q.y = pk2(v[i][2] * r * h[2], v[i][3] * r * h[3]);
                    *(uint2*)(o2 + stg_off(row, c)) = q;
                }
            }
        }
    }
}

__device__ __forceinline__ void conv_phase(const bf16_t* __restrict__ Bb, const bf16_t* __restrict__ U, const float* __restrict__ cw, bf16_t* Z, int gthread, int nthreads) {
    for (int item = gthread; item < (NTOK / 16) * (DM / 8); item += nthreads) {
        const int co = item & 255, trun = item >> 8;
        const int t0 = trun * 16, s0 = t0 & (SEQ - 1);
        const int c0 = co * 8;
        float w0[8], w1[8], w2[8];
#pragma unroll
        for (int e = 0; e < 8; ++e) { w0[e] = cw[c0 + e]; w1[e] = cw[DM + c0 + e]; w2[e] = cw[2 * DM + c0 + e]; }
        float um2[8], um1[8];
#pragma unroll
        for (int e = 0; e < 8; ++e) { um2[e] = 0.f; um1[e] = 0.f; }
        if (s0 >= 2) {
            const uint4 a = *(const uint4*)(U + (size_t)(t0 - 2) * DM + c0), b = *(const uint4*)(U + (size_t)(t0 - 1) * DM + c0);
            const unsigned av[4] = {a.x, a.y, a.z, a.w}, bv[4] = {b.x, b.y, b.z, b.w};
#pragma unroll
            for (int e = 0; e < 4; ++e) { um2[2 * e] = bflo(av[e]); um2[2 * e + 1] = bfhi(av[e]); um1[2 * e] = bflo(bv[e]); um1[2 * e + 1] = bfhi(bv[e]); }
        }
        for (int t = t0; t < t0 + 16; ++t) {
            const uint4 bg = *(const uint4*)(Bb + (size_t)t * DM + c0), uu = *(const uint4*)(U + (size_t)t * DM + c0);
            const unsigned bgv[4] = {bg.x, bg.y, bg.z, bg.w}, uv[4] = {uu.x, uu.y, uu.z, uu.w};
            unsigned ov[4];
#pragma unroll
            for (int e = 0; e < 4; ++e) {
                const float ua = bflo(uv[e]), ub = bfhi(uv[e]);
                const float ca = w0[2 * e] * um2[2 * e] + w1[2 * e] * um1[2 * e] + w2[2 * e] * ua;
                const float cb = w0[2 * e + 1] * um2[2 * e + 1] + w1[2 * e + 1] * um1[2 * e + 1] + w2[2 * e + 1] * ub;
                ov[e] = pk2(bflo(bgv[e]) * ca, bfhi(bgv[e]) * cb);
                um2[2 * e] = um1[2 * e]; um2[2 * e + 1] = um1[2 * e + 1]; um1[2 * e] = ua; um1[2 * e + 1] = ub;
            }
            *(uint4*)(Z + stg_off(t, c0)) = make_uint4(ov[0], ov[1], ov[2], ov[3]);
        }
    }
}

__global__ void __launch_bounds__(512) k_prep(const float* x, const float* g, bf16_t* a1, int* cnt) {
    const int gt = blockIdx.x * 512 + threadIdx.x;
    if (gt < 2 * NE) cnt[gt] = 0;
    norm_rows(x, g, a1, nullptr, nullptr, gt >> 6, (gridDim.x * 512) >> 6, threadIdx.x & 63);
}
__global__ void __launch_bounds__(512) k_conv(const bf16_t* BCX, const float* cw, bf16_t* Z) {
    conv_phase(BCX, BCX + (size_t)NTOK * DM, cw, Z, blockIdx.x * 512 + threadIdx.x, gridDim.x * 512);
}
__global__ void __launch_bounds__(512) k_combine(float* H, const bf16_t* Y, const float* g1, bf16_t* o1, const float* g2, bf16_t* o2) {
    const int gt = blockIdx.x * 512 + threadIdx.x;
    combine_rows(H, Y, g1, o1, g2, o2, gt >> 6, (gridDim.x * 512) >> 6, threadIdx.x & 63);
}

__global__ void __launch_bounds__(512) naive_gemm(const bf16_t* __restrict__ A, const float* __restrict__ W, float* T, int N, int ldt, int coff) {
    __shared__ float sA[4 * DM];
    const int tid = threadIdx.x, n = blockIdx.x * 512 + tid;
    for (int half = 0; half < 2; ++half) {
    const int m0 = blockIdx.y * 8 + half * 4;
    __syncthreads();
    for (int i = tid; i < 4 * DM; i += 512) sA[i] = bf2f(A[(size_t)(m0 + (i >> 11)) * DM + (i & 2047)]);
    __syncthreads();
    float acc[4];
#pragma unroll
    for (int r = 0; r < 4; ++r) acc[r] = 0.f;
    for (int k = 0; k < DM; k += 4) {
        const float w0 = W[(size_t)k * N + n], w1 = W[(size_t)(k + 1) * N + n], w2 = W[(size_t)(k + 2) * N + n], w3 = W[(size_t)(k + 3) * N + n];
#pragma unroll
        for (int r = 0; r < 4; ++r) { const f32x4 a = *(const f32x4*)&sA[r * DM + k]; acc[r] += a[0] * w0 + a[1] * w1 + a[2] * w2 + a[3] * w3; }
    }
#pragma unroll
    for (int r = 0; r < 4; ++r) T[(size_t)(m0 + r) * ldt + coff + n] = acc[r];
    }
}
__global__ void naive_epi_bf16(const float* T, bf16_t* O, size_t n) { size_t i = (size_t)blockIdx.x * blockDim.x + threadIdx.x; if (i < n) O[i] = (bf16_t)(pk2(T[i], 0.f) & 0xffff); }
__global__ void naive_epi_resid(const float* R, const float* T, float* H, size_t n) { size_t i = (size_t)blockIdx.x * blockDim.x + threadIdx.x; if (i < n) H[i] = R[i] + T[i]; }
__global__ void __launch_bounds__(256) naive_epi_kvq(const float* T, const float* kn, const float* qn, bf16_t* Kb, bf16_t* Vb, bf16_t* Qb) {
    const int gw = (blockIdx.x * 256 + threadIdx.x) >> 6, lane = threadIdx.x & 63;
    if (gw >= NTOK * 48) return;
    const int tok = gw / 48, rem = gw % 48, which = rem / 16, h = rem % 16;
    const float* src = T + (size_t)tok * 6144 + which * 2048 + h * 128 + 2 * lane;
    float v0 = src[0], v1 = src[1];
    if (which != 1) {
        const float ss = wave_sum(v0 * v0 + v1 * v1);
        const float r = rsqrtf(ss * (1.0f / HD) + EPS);
        const float* g = (which == 0) ? kn : qn;
        v0 = v0 * r * g[2 * lane]; v1 = v1 * r * g[2 * lane + 1];
    }
    const int b = tok / SEQ, s = tok % SEQ;
    bf16_t* dst = (which == 0 ? Kb : (which == 1 ? Vb : Qb)) + ((size_t)(b * NH + h) * SEQ + s) * HD + 2 * lane;
    *(unsigned*)dst = pk2(v0, v1);
}
__global__ void naive_kmean(const bf16_t* Kb, float* KM) {
    const int i = blockIdx.x * blockDim.x + threadIdx.x;
    if (i >= NBATCH * NH * NBLK * HD) return;
    const int d = i & 127, blk = (i >> 7) & 7, bh = i >> 10;
    float s = 0.f;
    for (int r = 0; r < BLK; ++r) s += bf2f(Kb[((size_t)bh * SEQ + blk * BLK + r) * HD + d]);
    KM[i] = s * (1.0f / BLK);
}

__global__ void __launch_bounds__(256) naive_router(const float* __restrict__ H, const float* g, const float* __restrict__ wrg, const float* __restrict__ wre,
                                                    bf16_t* AF, int* cnt, int* list, float* tokw, int* toke) {
    const int tok = (blockIdx.x * 256 + threadIdx.x) >> 6, lane = threadIdx.x & 63;
    if (tok >= NTOK) return;
    const f32x4* p = (const f32x4*)(H + (size_t)tok * DM);
    f32x4 v[8]; float ss = 0.f;
#pragma unroll
    for (int i = 0; i < 8; ++i) { v[i] = p[lane + 64 * i]; ss += v[i][0] * v[i][0] + v[i][1] * v[i][1] + v[i][2] * v[i][2] + v[i][3] * v[i][3]; }
    ss = wave_sum(ss);
    const float r = rsqrtf(ss * (1.0f / DM) + EPS);
    float acc[36];
#pragma unroll
    for (int c = 0; c < 36; ++c) acc[c] = 0.f;
#pragma unroll
    for (int i = 0; i < 8; ++i) {
        const int c0 = 4 * (lane + 64 * i);
        const f32x4 gg = *(const f32x4*)(g + c0);
        f32x4 y; y[0] = v[i][0] * r * gg[0]; y[1] = v[i][1] * r * gg[1]; y[2] = v[i][2] * r * gg[2]; y[3] = v[i][3] * r * gg[3];
        uint2 o; o.x = pk2(y[0], y[1]); o.y = pk2(y[2], y[3]);
        *(uint2*)(AF + (size_t)tok * DM + c0) = o;
#pragma unroll
        for (int e = 0; e < 4; ++e) {
            const int k = c0 + e;
            const f32x4 wg = *(const f32x4*)(wrg + (size_t)k * 4);
#pragma unroll
            for (int c = 0; c < 4; ++c) acc[c] += y[e] * wg[c];
#pragma unroll
            for (int q = 0; q < 8; ++q) {
                const f32x4 w = *(const f32x4*)(wre + (size_t)k * 32 + 4 * q);
#pragma unroll
                for (int c = 0; c < 4; ++c) acc[4 + 4 * q + c] += y[e] * w[c];
            }
        }
    }
#pragma unroll
    for (int c = 0; c < 36; ++c) acc[c] = wave_sum(acc[c]);
    if (lane == 0) {
        int gs = 0; float gm = acc[0];
#pragma unroll
        for (int c = 1; c < 4; ++c) if (acc[c] > gm) { gm = acc[c]; gs = c; }
        float den = 0.f;
#pragma unroll
        for (int c = 0; c < 4; ++c) den += __expf(acc[c] - gm);
        const float gw = 1.0f / den;
        float el[8];
#pragma unroll
        for (int c = 0; c < 8; ++c) {
            float x = 0.f;
#pragma unroll
            for (int gg = 0; gg < 4; ++gg) x = (gs == gg) ? acc[4 + gg * 8 + c] : x;
            el[c] = x;
        }
        int i0 = 0; float t0 = el[0];
#pragma unroll
        for (int c = 1; c < 8; ++c) if (el[c] > t0) { t0 = el[c]; i0 = c; }
        int i1 = -1; float t1 = -INFINITY;
#pragma unroll
        for (int c = 0; c < 8; ++c) if (c != i0 && el[c] > t1) { t1 = el[c]; i1 = c; }
        const float e1 = __expf(t1 - t0);
        const float w0 = gw / (1.0f + e1), w1 = gw * e1 / (1.0f + e1);
        const int ex0 = gs * 8 + i0, ex1 = gs * 8 + i1;
        tokw[tok * 2] = w0; tokw[tok * 2 + 1] = w1; toke[tok * 2] = ex0; toke[tok * 2 + 1] = ex1;
    }
}

__global__ void __launch_bounds__(512) naive_build_lists(const int* toke, int* cnt, int* list) {
    __shared__ int part[512];
    const int e = blockIdx.x, tid = threadIdx.x;
    int c = 0;
    for (int i = 0; i < 32; ++i) c += (toke[tid * 32 + i] == e);
    part[tid] = c;
    __syncthreads();
    int off = 0;
    for (int j = 0; j < tid; ++j) off += part[j];
    for (int i = 0; i < 32; ++i) if (toke[tid * 32 + i] == e) list[e * NTOK + off++] = tid * 32 + i;
    if (tid == 511) cnt[e] = off;
}
__global__ void __launch_bounds__(512) naive_moe_a(const bf16_t* __restrict__ AF, const float* __restrict__ Wg, const float* __restrict__ Wu,
                                                   const int* cnt, const int* list, bf16_t* ACT) {
    __shared__ float sA[4 * DM];
    __shared__ int srs[8];
    const int e = blockIdx.y, c0 = blockIdx.x * 4, n = cnt[e], tid = threadIdx.x;
    if (c0 >= n) return;
    if (tid < 4) srs[tid] = (c0 + tid < n) ? list[e * NTOK + c0 + tid] : -1;
    __syncthreads();
    for (int i = tid; i < 4 * DM; i += 512) { const int sr = srs[i >> 11]; sA[i] = sr >= 0 ? bf2f(AF[(size_t)(sr >> 1) * DM + (i & 2047)]) : 0.f; }
    __syncthreads();
    float ag[4], au[4];
#pragma unroll
    for (int r = 0; r < 4; ++r) { ag[r] = 0.f; au[r] = 0.f; }
    const float* wg = Wg + (size_t)e * DM * DE + tid; const float* wu = Wu + (size_t)e * DM * DE + tid;
    for (int k = 0; k < DM; k += 4) {
        float g4[4], u4[4];
#pragma unroll
        for (int q = 0; q < 4; ++q) { g4[q] = wg[(size_t)(k + q) * DE]; u4[q] = wu[(size_t)(k + q) * DE]; }
#pragma unroll
        for (int r = 0; r < 4; ++r) { const f32x4 a = *(const f32x4*)&sA[r * DM + k];
            ag[r] += a[0] * g4[0] + a[1] * g4[1] + a[2] * g4[2] + a[3] * g4[3];
            au[r] += a[0] * u4[0] + a[1] * u4[1] + a[2] * u4[2] + a[3] * u4[3]; }
    }
#pragma unroll
    for (int r = 0; r < 4; ++r) { const int sr = srs[r]; if (sr >= 0) { const float gv = ag[r]; const float a = gv / (1.0f + __expf(-gv)) * au[r];
        ACT[(size_t)sr * DE + tid] = (bf16_t)(pk2(a, 0.f) & 0xffff); } }
}
__global__ void __launch_bounds__(512) naive_moe_b(const bf16_t* __restrict__ ACT, const float* __restrict__ Wd, const int* cnt, const int* list,
                                                   const float* tokw, bf16_t* Y) {
    __shared__ float sA[8 * DE];
    __shared__ int srs[8];
    const int e = blockIdx.y, c0 = blockIdx.x * 8, n = cnt[e], tid = threadIdx.x;
    if (c0 >= n) return;
    if (tid < 8) srs[tid] = (c0 + tid < n) ? list[e * NTOK + c0 + tid] : -1;
    __syncthreads();
    for (int i = tid; i < 8 * DE; i += 512) { const int sr = srs[i >> 9]; sA[i] = sr >= 0 ? bf2f(ACT[(size_t)sr * DE + (i & 511)]) : 0.f; }
    __syncthreads();
    float acc[8][4];
#pragma unroll
    for (int r = 0; r < 8; ++r)
#pragma unroll
        for (int q = 0; q < 4; ++q) acc[r][q] = 0.f;
    const float* wd = Wd + (size_t)e * DE * DM + tid;
    for (int k = 0; k < DE; ++k) {
        float w[4];
#pragma unroll
        for (int q = 0; q < 4; ++q) w[q] = wd[(size_t)k * DM + 512 * q];
#pragma unroll
        for (int r = 0; r < 8; ++r) { const float a = sA[r * DE + k];
#pragma unroll
            for (int q = 0; q < 4; ++q) acc[r][q] += a * w[q]; }
    }
#pragma unroll
    for (int r = 0; r < 8; ++r) { const int sr = srs[r]; if (sr >= 0) { const float w = tokw[sr];
#pragma unroll
        for (int q = 0; q < 4; ++q) Y[(size_t)sr * DM + tid + 512 * q] = (bf16_t)(pk2(acc[r][q] * w, 0.f) & 0xffff); } }
}

__global__ void __launch_bounds__(256) naive_attn(const bf16_t* __restrict__ Qb, const bf16_t* __restrict__ Kb, const bf16_t* __restrict__ Vb,
                                                  const float* __restrict__ KM, bf16_t* ATT) {
    const int gw = (blockIdx.x * 256 + threadIdx.x) >> 6, lane = threadIdx.x & 63;
    if (gw >= NBATCH * NH * SEQ) return;
    const int s = gw % SEQ, bh = gw / SEQ, h = bh % NH, b = bh / NH;
    const int i = s / BLK;
    const unsigned qq = *(const unsigned*)(Qb + ((size_t)bh * SEQ + s) * HD + 2 * lane);
    const float q0 = bflo(qq), q1 = bfhi(qq);
    float gate[8];
#pragma unroll
    for (int n = 0; n < 8; ++n) {
        const float* km = KM + ((size_t)bh * NBLK + n) * HD + 2 * lane;
        gate[n] = wave_sum(q0 * km[0] + q1 * km[1]);
    }
    unsigned sel = 0;
#pragma unroll
    for (int n = 0; n < 8; ++n) {
        int rank = 0;
#pragma unroll
        for (int m = 0; m < 8; ++m) if (m < i && m != n && (gate[m] > gate[n] || (gate[m] == gate[n] && m < n))) ++rank;
        if (n < i && rank < 3) sel |= 1u << n;
    }
    const float slope = exp2f(-8.0f * (float)(h + 1) / (float)NH);
    const float scale = 0.08838834764831845f;
    float m = -INFINITY, l = 0.f, o0 = 0.f, o1 = 0.f;
    for (int jj = 0; jj <= i; ++jj) {
        const int j = (jj == 0) ? i : jj - 1;
        if (j != i && !((sel >> j) & 1)) continue;
        for (int c = 0; c < 4; ++c) {
            const int kbase = j * BLK + c * 64;
            if (j == i && kbase > s) break;
            const int kk = kbase + lane;
            const bf16_t* krow = Kb + ((size_t)bh * SEQ + kk) * HD;
            float dot = 0.f;
            for (int d2 = 0; d2 < 64; ++d2) {
                const float qa = __shfl(q0, d2), qb = __shfl(q1, d2);
                const unsigned kv = *(const unsigned*)(krow + 2 * d2);
                dot += qa * bflo(kv) + qb * bfhi(kv);
            }
            const bool valid = (j < i) || (kk <= s);
            const float sc = valid ? dot * scale - slope * (float)(s - kk) : -INFINITY;
            const float mx = wave_max(sc);
            const float mn = fmaxf(m, mx);
            const float p = valid ? __expf(sc - mn) : 0.f;
            const float alpha = __expf(m - mn);
            l = l * alpha + wave_sum(p);
            o0 *= alpha; o1 *= alpha; m = mn;
            for (int t = 0; t < 64; ++t) {
                const float pt = __shfl(p, t);
                const unsigned vv = *(const unsigned*)(Vb + ((size_t)bh * SEQ + kbase + t) * HD + 2 * lane);
                o0 += pt * bflo(vv); o1 += pt * bfhi(vv);
            }
        }
    }
    const float inv = 1.0f / l;
    *(unsigned*)(ATT + ((size_t)(b * SEQ + s)) * DM + h * HD + 2 * lane) = pk2(o0 * inv, o1 * inv);
}


#define LAS __attribute__((address_space(3)))
typedef short bf16x8 __attribute__((ext_vector_type(8)));
typedef unsigned u32x4 __attribute__((ext_vector_type(4)));
constexpr int LDS_GEMM = 131072;
constexpr int LDS_MISC = LDS_GEMM;
constexpr int LDS_BYTES = LDS_GEMM + 8192;

__device__ __forceinline__ int lds_off(int row, int chunk) { return row * 128 + ((chunk ^ (((row >> 1) & 7) ^ ((row >> 4) & 1))) << 4); }

struct GemmCtx { int tid, lane, wid, wr, wc, fr, fq; };
__device__ __forceinline__ GemmCtx make_ctx() {
    GemmCtx c; int t = threadIdx.x; asm volatile("" : "+v"(t));
    c.tid = t; c.lane = c.tid & 63; c.wid = __builtin_amdgcn_readfirstlane(c.tid >> 6);
    c.wr = c.wid >> 1; c.wc = c.wid & 1; c.fr = c.lane & 15; c.fq = c.lane >> 4; return c;
}

__device__ __forceinline__ int a_chunk_off(int tid) { const int r = tid >> 3; return (((tid & 7) ^ (((r >> 1) & 7) ^ ((r >> 4) & 1))) << 3); }
template <int ABL = 0> __device__ __forceinline__ void gemm_tile_f32w(LAS unsigned char* lds, const GemmCtx& c, const bf16_t* Abase, const unsigned (&aoff)[4], const float* Bbase, unsigned boff0,
                                               int brow0, int bkg, int ldw, int nk, f32x4 (&acc)[4][8]) {
#pragma unroll
    for (int mi = 0; mi < 4; ++mi)
#pragma unroll
        for (int ni = 0; ni < 8; ++ni) acc[mi][ni] = (f32x4){0.f, 0.f, 0.f, 0.f};
    LAS unsigned char* bw0 = lds + 65536 + lds_off(brow0, bkg);
    LAS unsigned char* bw2 = lds + 65536 + lds_off(brow0 + 2, bkg);
    typedef const __attribute__((address_space(1))) f32x4* gf4p;
    const __attribute__((address_space(1))) char* Bg = (const __attribute__((address_space(1))) char*)Bbase;
    const __attribute__((address_space(1))) char* Ag = (const __attribute__((address_space(1))) char*)Abase;
    const int x0 = c.fq ^ (c.fr >> 1);
    int foff[2][2];
#pragma unroll
    for (int par = 0; par < 2; ++par)
#pragma unroll
        for (int k32 = 0; k32 < 2; ++k32) foff[par][k32] = c.fr * 128 + ((x0 ^ (k32 * 4 + par)) << 4);
    const int abase = (c.wr * 64) * 128, bbase = 65536 + (c.wc * 128) * 128;
    LAS unsigned char* adst = lds + c.tid * 16;
    const unsigned ldw4 = (unsigned)ldw * 4u;

    f32x4 rb[8];
    auto gload = [&](int kt, int buf) {
#pragma unroll
        for (int i = 0; i < 4; ++i)
            if (ABL != 3) __builtin_amdgcn_global_load_lds((const __attribute__((address_space(1))) unsigned*)(Ag + (size_t)((aoff[i] + (unsigned)kt * 64u) * 2u)), (LAS unsigned*)(adst + buf * 32768 + i * 8192), 16, 0, 0);
        const unsigned vo = boff0 * 4u;
#pragma unroll
        for (int j = 0; j < 8; ++j) { if (ABL != 2) rb[j] = *(gf4p)((Bg + (size_t)((unsigned)(kt * 64 + j) * ldw4)) + (size_t)vo); else rb[j] = (f32x4){1.f, 2.f, 3.f, (float)kt}; }
    };
    auto lstore = [&](int buf) {
#pragma unroll
        for (int i = 0; i < 4; ++i) {
            u32x4 w; w[0] = pk2(rb[0][i], rb[1][i]); w[1] = pk2(rb[2][i], rb[3][i]); w[2] = pk2(rb[4][i], rb[5][i]); w[3] = pk2(rb[6][i], rb[7][i]);
            *(LAS u32x4*)((i < 2 ? bw0 : bw2) + buf * 32768 + (i & 1) * 128) = w;
        }
    };
    gload(0, 0); lstore(0);
    asm volatile("s_waitcnt vmcnt(0)" ::: "memory");
    __syncthreads();
    for (int kt = 0; kt < nk; ++kt) {
        const int cur = kt & 1;
        if (kt + 1 < nk) gload(kt + 1, cur ^ 1);
#pragma unroll
        for (int k32 = 0; k32 < 2; ++k32) {
            bf16x8 af[4];
#pragma unroll
            for (int mi = 0; mi < 4; ++mi) af[mi] = *(const LAS bf16x8*)(lds + cur * 32768 + abase + mi * 2048 + foff[mi & 1][k32]);
#pragma unroll
            for (int ni = 0; ni < 8; ++ni) {
                const bf16x8 bfr = *(const LAS bf16x8*)(lds + cur * 32768 + bbase + ni * 2048 + foff[ni & 1][k32]);
#pragma unroll
                for (int mi = 0; mi < 4; ++mi) { if (ABL != 1) acc[mi][ni] = __builtin_amdgcn_mfma_f32_16x16x32_bf16(bfr, af[mi], acc[mi][ni], 0, 0, 0); else { acc[mi][ni][0] += __builtin_bit_cast(float, (int)bfr[0]) ; acc[mi][ni][1] += __builtin_bit_cast(float, (int)af[mi][0]); } }
            }
        }
        if (kt + 1 < nk) lstore(cur ^ 1);
        asm volatile("s_waitcnt vmcnt(0)" ::: "memory");
        __syncthreads();
    }
}

__device__ __forceinline__ void gemm_tile_bf16(LAS unsigned char* lds, const GemmCtx& c, const bf16_t* Abase, unsigned aoff0, unsigned aoff1, const bf16_t* Bbase, unsigned boff0, unsigned boff1,
                                               int nk, f32x4 (&acc)[4][8], unsigned bstage = 32u, unsigned astage = 32u,
                                               bool pre = false, bool nxt = false, const bf16_t* An = nullptr, unsigned na0 = 0u, unsigned nb0 = 0u) {
#pragma unroll
    for (int mi = 0; mi < 4; ++mi)
#pragma unroll
        for (int ni = 0; ni < 8; ++ni) acc[mi][ni] = (f32x4){0.f, 0.f, 0.f, 0.f};
    typedef const __attribute__((address_space(1))) unsigned* gu32p;
    const __attribute__((address_space(1))) char* Ag = (const __attribute__((address_space(1))) char*)Abase;
    const __attribute__((address_space(1))) char* Bg = (const __attribute__((address_space(1))) char*)Bbase;
    LAS unsigned char* dst = lds + c.tid * 16;
    const int fo = c.fr * 64 + ((c.fq ^ ((0 - (c.fr >> 2)) & 3)) << 4);
    LAS unsigned char* fa = lds + c.wr * 4096 + fo;
    LAS unsigned char* fb = lds + 16384 + c.wc * 8192 + fo;
    auto issue = [&](int kt) {
        const int st = (kt & 3) * 32768;
        const unsigned ko = (unsigned)kt * astage, kb = (unsigned)kt * bstage;
        __builtin_amdgcn_global_load_lds((gu32p)(Ag + (size_t)((aoff0 + ko) * 2u)), (LAS unsigned*)(dst + st), 16, 0, 0);
        __builtin_amdgcn_global_load_lds((gu32p)(Ag + (size_t)((aoff1 + ko) * 2u)), (LAS unsigned*)(dst + st + 8192), 16, 0, 0);
        __builtin_amdgcn_global_load_lds((gu32p)(Bg + (size_t)((boff0 + kb) * 2u)), (LAS unsigned*)(dst + st + 16384), 16, 0, 0);
        __builtin_amdgcn_global_load_lds((gu32p)(Bg + (size_t)((boff1 + kb) * 2u)), (LAS unsigned*)(dst + st + 16384 + 8192), 16, 0, 0);
    };
#define RING_BAR() do { __builtin_amdgcn_sched_barrier(0); __builtin_amdgcn_s_barrier(); __builtin_amdgcn_sched_barrier(0); asm volatile("" ::: "memory"); } while (0)
    const bool g1 = c.wid >= 4;
    if (!pre) { issue(0); issue(1); issue(2); }
    asm volatile("s_waitcnt vmcnt(8)" ::: "memory");
    RING_BAR();
    if (g1) RING_BAR();
    for (int s = 0; s < nk; ++s) {
        const int st = (s & 3) * 32768;
        bf16x8 af[4], bfv[8];
#pragma unroll
        for (int mi = 0; mi < 4; ++mi) af[mi] = *(const LAS bf16x8*)(fa + st + mi * 1024);
#pragma unroll
        for (int ni = 0; ni < 8; ++ni) bfv[ni] = *(const LAS bf16x8*)(fb + st + ni * 1024);
        __builtin_amdgcn_sched_barrier(0);
        if (s + 3 < nk) issue(s + 3);
        if (g1) {
            if (s <= nk - 4) asm volatile("s_waitcnt vmcnt(8)" ::: "memory");
            else if (s == nk - 3) asm volatile("s_waitcnt vmcnt(4)" ::: "memory");
            else if (s == nk - 2) asm volatile("s_waitcnt vmcnt(0)" ::: "memory");
        }
        __builtin_amdgcn_s_waitcnt(0xC07F);
        RING_BAR();
#pragma unroll
        for (int ni = 0; ni < 8; ++ni)
#pragma unroll
            for (int mi = 0; mi < 4; ++mi) acc[mi][ni] = __builtin_amdgcn_mfma_f32_16x16x32_bf16(bfv[ni], af[mi], acc[mi][ni], 0, 0, 0);
        if (!g1) {
            if (s <= nk - 4) asm volatile("s_waitcnt vmcnt(8)" ::: "memory");
            else if (s == nk - 3) asm volatile("s_waitcnt vmcnt(4)" ::: "memory");
            else if (s == nk - 2) asm volatile("s_waitcnt vmcnt(0)" ::: "memory");
        }
        RING_BAR();
    }
    if (!g1) RING_BAR();
    if (nxt) {
        const __attribute__((address_space(1))) char* Ang = (const __attribute__((address_space(1))) char*)An;
#pragma unroll
        for (int kt = 0; kt < 3; ++kt) {
            const int st = kt * 32768;
            const unsigned ko = (unsigned)kt * astage, kb = (unsigned)kt * bstage;
            __builtin_amdgcn_global_load_lds((gu32p)(Ang + (size_t)((na0 + ko) * 2u)), (LAS unsigned*)(dst + st), 16, 0, 0);
            __builtin_amdgcn_global_load_lds((gu32p)(Ang + (size_t)((na0 + 4096u + ko) * 2u)), (LAS unsigned*)(dst + st + 8192), 16, 0, 0);
            __builtin_amdgcn_global_load_lds((gu32p)(Bg + (size_t)((nb0 + kb) * 2u)), (LAS unsigned*)(dst + st + 16384), 16, 0, 0);
            __builtin_amdgcn_global_load_lds((gu32p)(Bg + (size_t)((nb0 + 4096u + kb) * 2u)), (LAS unsigned*)(dst + st + 16384 + 8192), 16, 0, 0);
        }
    }
#undef RING_BAR
}
__device__ __forceinline__ unsigned ring_off(int tid, int row0, int ld) {
    return (unsigned)((row0 + (tid >> 2)) * ld + ((((tid & 3) ^ ((0 - (tid >> 4)) & 3))) << 3));
}

template <bool CONVIN = false> __device__ __forceinline__ void convert_wt(LAS unsigned char* lds, const GemmCtx& c, const float* __restrict__ W, int N, bf16_t* WT, const float* gk = nullptr) {
    LAS float* tile = (LAS float*)lds;
    const int ntn = N / 64, ntiles = (DM / 64) * ntn;
    for (int t = blockIdx.x; t < ntiles; t += gridDim.x) {
        const int kt = t / ntn, nt = t % ntn;
        __syncthreads();
#pragma unroll
        for (int i = 0; i < 2; ++i) {
            const int idx = i * 512 + c.tid, kr = idx >> 4, c4 = (idx & 15) * 4;
            f32x4 v = *(const f32x4*)(W + (size_t)(kt * 64 + kr) * N + nt * 64 + c4);
            if (gk) { const float gg = gk[kt * 64 + kr]; v[0] *= gg; v[1] *= gg; v[2] *= gg; v[3] *= gg; }
            tile[kr * 65 + c4] = v[0]; tile[kr * 65 + c4 + 1] = v[1]; tile[kr * 65 + c4 + 2] = v[2]; tile[kr * 65 + c4 + 3] = v[3];
        }
        __syncthreads();
        {
            const int n = c.tid >> 3, k8 = (c.tid & 7) * 8;
            u32x4 o;
#pragma unroll
            for (int q = 0; q < 4; ++q) o[q] = pk2(tile[(k8 + 2 * q) * 65 + n], tile[(k8 + 2 * q + 1) * 65 + n]);
            {
                int nrow = nt * 64 + n;
                if (CONVIN && nrow >= 2048) {
                    const int which = (nrow - 2048) >> 11, ch = (nrow - 2048) & 2047, hd = ch & 127;
                    nrow = 2048 + (ch >> 7) * 256 + (hd >> 6) * 128 + (2 * ((hd >> 4) & 3) + which) * 16 + (hd & 15);
                }
                const int pn = nrow >> 8, r = nrow & 255, kk = kt * 64 + k8, j = kk >> 5, lc = (kk & 31) >> 3;
                *(u32x4*)(WT + ((size_t)(pn * 64 + j) * 8192) + (r * 64 + ((lc ^ ((0 - (r >> 2)) & 3)) << 4)) / 2) = o;
            }
        }
    }
}

struct MegaArgs {
    const float* x; const float* mix_norm; const float* ffn_norm; const float* conv_w_in; const float* conv_w; const float* conv_w_out;
    const float* kv_norm; const float* w_kv; const float* k_norm; const float* w_q; const float* q_norm; const float* w_o;
    const float* router_group; const float* router_expert; const float* w_gate; const float* w_up; const float* w_down;
    float* H; unsigned char* ws; int ph_lo, ph_hi;
};
enum { PH_PREP = 0, PH_GEMM1 = 1, PH_CONV = 2, PH_GEMM2 = 3, PH_ROUTER0 = 4, PH_MOEA0 = 5, PH_MOEB0 = 6, PH_COMBINE0 = 7, PH_GEMM3 = 8, PH_ATTN = 9, PH_GEMM4 = 10,
       PH_ROUTER1 = 11, PH_MOEA1 = 12, PH_MOEB1 = 13, PH_COMBINE1 = 14, PH_END = 15 };

__device__ __forceinline__ int vblock(LAS unsigned char* lds) {
    volatile LAS unsigned* bst = (volatile LAS unsigned*)(lds + LDS_MISC + 8160);
    const unsigned v = bst[2], ok = bst[3];
    const int b = blockIdx.x;
    return __builtin_amdgcn_readfirstlane((ok && v < 256u) ? (int)v : ((b & 7) * 32 + (b >> 3)));
}
__device__ __forceinline__ bool dense_tile(LAS unsigned char* lds, int it, int ntn, int& pm, int& pn) {
    const int b = blockIdx.x, G = gridDim.x;
    const int t = it * G + b;
    if (G != 256) { if (t >= 32 * ntn) return false; pm = t % 32; pn = t / 32; return true; }
    const int r = it; if (r * 8 >= ntn) return false;
    const int vb = vblock(lds); const int x = vb >> 5, j = vb & 31; pm = 4 * x + (j & 3); pn = 8 * r + (j >> 2); return true;
}

template <int RMODE> __device__ __forceinline__ void phase_gemm_resid(LAS unsigned char* lds, const GemmCtx& c, const bf16_t* A, const bf16_t* WT, const void* R, bf16_t* HB, const float* rsc = nullptr) {
    int pm, pn; bool have = dense_tile(lds, 0, DM / 256, pm, pn), pre = false;
    for (int it = 0; have; ++it) {
        int npm = 0, npn = 0; const bool hn = dense_tile(lds, it + 1, DM / 256, npm, npn);
        f32x4 acc[4][8];
        gemm_tile_bf16(lds, c, A, (unsigned)(pm * 64 * 8192 + c.tid * 8), (unsigned)(pm * 64 * 8192 + 4096 + c.tid * 8), WT, (unsigned)(pn * 64 * 8192 + c.tid * 8), (unsigned)(pn * 64 * 8192 + 4096 + c.tid * 8), DM / 32, acc, 8192u, 8192u,
                       pre, hn, A, (unsigned)(npm * 64 * 8192 + c.tid * 8), (unsigned)(npn * 64 * 8192 + c.tid * 8));
#pragma unroll
        for (int mi = 0; mi < 4; ++mi) {
            const size_t row = (size_t)pm * 256 + c.wr * 64 + mi * 16 + c.fr;
            float sc = 1.f;
            if (RMODE == 2) sc = rsc[row];
#pragma unroll
            for (int ni = 0; ni < 8; ++ni) {
                const size_t idx = row * DM + pn * 256 + c.wc * 128 + ni * 16 + c.fq * 4;
                f32x4 r;
                if (RMODE == 2) { const uint2 h = *(const uint2*)((const bf16_t*)R + stg_off((int)row, pn * 256 + c.wc * 128 + ni * 16 + c.fq * 4)); r[0] = bflo(h.x) * sc; r[1] = bfhi(h.x) * sc; r[2] = bflo(h.y) * sc; r[3] = bfhi(h.y) * sc; }
                else r = *(const f32x4*)((const float*)R + idx);
                r = r + acc[mi][ni];
                uint2 o; o.x = pk2(r[0], r[1]); o.y = pk2(r[2], r[3]);
                *(uint2*)(HB + idx) = o;
            }
        }
        pm = npm; pn = npn; have = hn; pre = hn;
    }
}

__device__ __forceinline__ void phase_gemm1(LAS unsigned char* lds, const GemmCtx& c, const bf16_t* A, const bf16_t* WT, bf16_t* O) {
    int pm, pn; bool have = dense_tile(lds, 0, 6144 / 256, pm, pn), pre = false;
    for (int it = 0; have; ++it) {
        int npm = 0, npn = 0; const bool hn = dense_tile(lds, it + 1, 6144 / 256, npm, npn);
        f32x4 acc[4][8];
        const int lpm = pm, lpn = pn;
        gemm_tile_bf16(lds, c, A, (unsigned)(lpm * 64 * 8192 + c.tid * 8), (unsigned)(lpm * 64 * 8192 + 4096 + c.tid * 8), WT, (unsigned)(lpn * 64 * 8192 + c.tid * 8), (unsigned)(lpn * 64 * 8192 + 4096 + c.tid * 8), DM / 32, acc, 8192u, 8192u,
                       pre, hn, A, (unsigned)(npm * 64 * 8192 + c.tid * 8), (unsigned)(npn * 64 * 8192 + c.tid * 8));
#pragma unroll
        for (int mi = 0; mi < 4; ++mi) {
            const size_t row = (size_t)pm * 256 + c.wr * 64 + mi * 16 + c.fr;
            if (pn < 8) {
#pragma unroll
                for (int ni = 0; ni < 8; ++ni) {
                    uint2 o; o.x = pk2(acc[mi][ni][0], acc[mi][ni][1]); o.y = pk2(acc[mi][ni][2], acc[mi][ni][3]);
                    *(uint2*)(O + row * DM + pn * 256 + c.wc * 128 + ni * 16 + c.fq * 4) = o;
                }
            } else {
                bf16_t* U = O + (size_t)NTOK * DM;
#pragma unroll
                for (int p = 0; p < 4; ++p) {
                    uint2 o; o.x = pk2(acc[mi][2 * p][0] * acc[mi][2 * p + 1][0], acc[mi][2 * p][1] * acc[mi][2 * p + 1][1]);
                    o.y = pk2(acc[mi][2 * p][2] * acc[mi][2 * p + 1][2], acc[mi][2 * p][3] * acc[mi][2 * p + 1][3]);
                    *(uint2*)(U + row * DM + (pn - 8) * 128 + c.wc * 64 + p * 16 + c.fq * 4) = o;
                }
            }
        }
        pm = npm; pn = npn; have = hn; pre = hn;
    }
}

__device__ __forceinline__ void phase_gemm3(LAS unsigned char* lds, const GemmCtx& c, const bf16_t* AKV, const bf16_t* AQ, const bf16_t* WT,
                                            const float* kn, const float* qn, bf16_t* Kb, bf16_t* Vb, bf16_t* Qb, float* KM) {
    int pm, pn; bool have = dense_tile(lds, 0, 24, pm, pn), pre = false;
    for (int it = 0; have; ++it) {
        int npm = 0, npn = 0; const bool hn = dense_tile(lds, it + 1, 24, npm, npn);
        const bool isq = pn >= 16;
        const bf16_t* A = isq ? AQ : AKV;
        f32x4 acc[4][8];
        gemm_tile_bf16(lds, c, A, (unsigned)(pm * 64 * 8192 + c.tid * 8), (unsigned)(pm * 64 * 8192 + 4096 + c.tid * 8), WT, (unsigned)(pn * 64 * 8192 + c.tid * 8), (unsigned)(pn * 64 * 8192 + 4096 + c.tid * 8), DM / 32, acc, 8192u, 8192u,
                       pre, hn, (npn >= 16) ? AQ : AKV, (unsigned)(npm * 64 * 8192 + c.tid * 8), (unsigned)(npn * 64 * 8192 + c.tid * 8));
        const int which = pn >> 3;
        const int head = (pn & 7) * 2 + c.wc;
        bf16_t* dst = which == 0 ? Kb : (which == 1 ? Vb : Qb);
        const float* gn = which == 0 ? kn : qn;
        float colsum[8][4];
#pragma unroll
        for (int ni = 0; ni < 8; ++ni)
#pragma unroll
            for (int e = 0; e < 4; ++e) colsum[ni][e] = 0.f;
#pragma unroll
        for (int mi = 0; mi < 4; ++mi) {
            const int tok = pm * 256 + c.wr * 64 + mi * 16 + c.fr;
            const int b = tok >> 11, sq = tok & 2047;
            float r = 1.f;
            if (which != 1) {
                float ss = 0.f;
#pragma unroll
                for (int ni = 0; ni < 8; ++ni)
#pragma unroll
                    for (int e = 0; e < 4; ++e) ss += acc[mi][ni][e] * acc[mi][ni][e];
                ss += __shfl_xor(ss, 16); ss += __shfl_xor(ss, 32);
                r = rsqrtf(ss * (1.0f / HD) + EPS);
            }
            bf16_t* orow = dst + ((size_t)(b * NH + head) * SEQ + sq) * HD + c.fq * 4;
#pragma unroll
            for (int ni = 0; ni < 8; ++ni) {
                f32x4 v = acc[mi][ni];
                if (which != 1) { const f32x4 g = *(const f32x4*)(gn + ni * 16 + c.fq * 4); v[0] = v[0] * r * g[0]; v[1] = v[1] * r * g[1]; v[2] = v[2] * r * g[2]; v[3] = v[3] * r * g[3]; }
                if (which == 0) {
#pragma unroll
                    for (int e = 0; e < 4; ++e) colsum[ni][e] += v[e];
                }
                uint2 o; o.x = pk2(v[0], v[1]); o.y = pk2(v[2], v[3]);
                *(uint2*)(orow + ni * 16) = o;
            }
        }
        if (which == 0) {
            LAS float* red = (LAS float*)(lds + LDS_MISC);
#pragma unroll
            for (int ni = 0; ni < 8; ++ni)
#pragma unroll
                for (int e = 0; e < 4; ++e) {
                    float v = colsum[ni][e];
                    v += __shfl_xor(v, 1); v += __shfl_xor(v, 2); v += __shfl_xor(v, 4); v += __shfl_xor(v, 8);
                    if (c.fr == 0) red[(c.wr * 2 + c.wc) * 128 + ni * 16 + c.fq * 4 + e] = v;
                }
            __syncthreads();
            if (c.tid < 256) {
                const int wc2 = c.tid >> 7, d = c.tid & 127;
                const float sum = ((red[(0 * 2 + wc2) * 128 + d] + red[(1 * 2 + wc2) * 128 + d]) + red[(2 * 2 + wc2) * 128 + d]) + red[(3 * 2 + wc2) * 128 + d];
                const int hd2 = (pn & 7) * 2 + wc2, b = pm >> 3, blk = pm & 7;
                KM[((size_t)(b * NH + hd2) * NBLK + blk) * HD + d] = sum * (1.0f / BLK);
            }
            __syncthreads();
        }
        pm = npm; pn = npn; have = hn; pre = hn;
    }
}

template <int OFF> __device__ __forceinline__ unsigned long long karg64() {
    unsigned long long v; auto k = __builtin_amdgcn_kernarg_segment_ptr();
    asm volatile("s_load_dwordx2 %0, %1, %2\n\ts_waitcnt lgkmcnt(0)" : "=s"(v) : "s"(k), "i"(OFF) : "memory");
    return v;
}
#define ARG(field) ((decltype(MegaArgs::field))karg64<offsetof(MegaArgs, field)>())
#define WSP(T, off) ((T*)((unsigned char*)ARG(ws) + (off)))

__device__ __forceinline__ void moe_counts(LAS int* misc, const GemmCtx& c, const int* toke) {
    if (c.tid < 32) misc[c.tid] = 0;
    __syncthreads();
    typedef int i32x4 __attribute__((ext_vector_type(4)));
    const i32x4* tp = (const i32x4*)(toke + c.tid * 32);
#pragma unroll
    for (int i = 0; i < 8; ++i) {
        const i32x4 v = tp[i];
        atomicAdd((int*)&misc[v[0]], 1); atomicAdd((int*)&misc[v[1]], 1); atomicAdd((int*)&misc[v[2]], 1); atomicAdd((int*)&misc[v[3]], 1);
    }
    __syncthreads();
    if (c.tid == 0) { int acc = 0; for (int e = 0; e < NE; ++e) { misc[32 + e] = acc; acc += (misc[e] + 255) >> 8; } misc[32 + NE] = acc; }
    __syncthreads();
}
__device__ __forceinline__ void moe_rowlist(LAS int* misc, const GemmCtx& c, const int* toke, int e, int mt) {
    __syncthreads();
    typedef int i32x4 __attribute__((ext_vector_type(4)));
    int tb = c.tid * 32; asm volatile("" : "+v"(tb));
    const i32x4* tp = (const i32x4*)(toke + tb);
    i32x4 ent[8];
#pragma unroll
    for (int i = 0; i < 8; ++i) ent[i] = tp[i];
    int cntm = 0;
#pragma unroll
    for (int i = 0; i < 8; ++i) cntm += (ent[i][0] == e) + (ent[i][1] == e) + (ent[i][2] == e) + (ent[i][3] == e);
    int incl = cntm;
#pragma unroll
    for (int o = 1; o < 64; o <<= 1) { const int t = __shfl_up(incl, o); if (c.lane >= o) incl += t; }
    if (c.lane == 63) misc[128 + c.wid] = incl;
    if (c.tid < 256) misc[1024 + c.tid] = -1;
    __syncthreads();
    int base = 0;
#pragma unroll
    for (int w = 0; w < 8; ++w) base += (w < c.wid) ? misc[128 + w] : 0;
    int pos = base + incl - cntm - mt * 256;
    if (cntm > 0 && pos < 256 && pos + cntm > 0) {
#pragma unroll
        for (int i = 0; i < 8; ++i)
#pragma unroll
            for (int q = 0; q < 4; ++q) if (ent[i][q] == e) { if (pos >= 0 && pos < 256) misc[1024 + pos] = tb + 4 * i + q; ++pos; }
    }
    __syncthreads();
}
__device__ __forceinline__ bool moe_tile(LAS int* misc, int it, int ntn, int& e, int& mt, int& nt) {
    const int b = blockIdx.x, G = gridDim.x;
    const int t = (G == 256) ? it * 256 + (b & 7) * 32 + (b >> 3) : it * G + b;
    const int total = misc[32 + NE] * ntn;
    if (t >= total) return false;
    const int g = t / ntn; nt = t % ntn;
    int ee = 0;
#pragma unroll
    for (int q = 1; q < NE; ++q) ee += (misc[32 + q] <= g);
    e = ee; mt = g - misc[32 + ee]; return true;
}

__device__ __forceinline__ unsigned xb_ld(unsigned* p);
__device__ __forceinline__ unsigned xb_add(unsigned* p, unsigned v);
#define MOE_CNT_WORD(layer, g) (3584 + (layer) * 128 + (g))
__device__ __forceinline__ bool moe_item(LAS int* misc, int g_total, int it, int& isb, int& g, int& nt) {
    const int b = blockIdx.x, G = gridDim.x;
    const int TA = g_total * 4, TB = g_total * 8;
    if (G != 256 || TA > 512 || TA < 256) {
        const int t = it * G + b;
        if (t >= TA + TB) return false;
        if (t < TA) { isb = 0; g = t >> 2; nt = t & 3; } else { isb = 1; g = (t - TA) >> 3; nt = (t - TA) & 7; }
        return true;
    }
    const int vb = vblock((LAS unsigned char*)misc - LDS_MISC);
    const int nA2 = TA - 256, nl = 256 - nA2;
    const bool heavy = vb < nA2;
    if (it == 0) { isb = 0; g = vb >> 2; nt = vb & 3; return true; }
    int slot = it - 1;
    if (heavy) { if (slot == 0) { const int t = 256 + vb; isb = 0; g = t >> 2; nt = t & 3; return true; } slot -= 1; }
    int i;
    if (heavy) i = 2 * nl + slot * 256 + nl + vb;
    else i = (slot < 2) ? slot * nl + (vb - nA2) : 2 * nl + (slot - 2) * 256 + (vb - nA2);
    if (i >= TB) return false;
    isb = 1; g = i >> 3; nt = i & 7; return true;
}
__device__ __forceinline__ void moe_g2emt(LAS int* misc, int g, int& e, int& mt) {
    int ee = 0;
#pragma unroll
    for (int q = 1; q < NE; ++q) ee += (misc[32 + q] <= g);
    e = __builtin_amdgcn_readfirstlane(ee); mt = __builtin_amdgcn_readfirstlane(g - misc[32 + ee]);
}
__device__ __forceinline__ void phase_moe(LAS unsigned char* lds, const GemmCtx& c, int layer) {
    LAS int* misc = (LAS int*)(lds + LDS_MISC);
    moe_counts(misc, c, WSP(int, WS_TOKE) + layer * 2 * NTOK);
    const int g_total = __builtin_amdgcn_readfirstlane(misc[32 + NE]);
    const int total_it = (g_total * 12 + gridDim.x - 1) / gridDim.x + 3;
    for (int it = 0; it < total_it; ++it) {
        int isb, g, nt; if (!moe_item(misc, g_total, it, isb, g, nt)) continue;
        isb = __builtin_amdgcn_readfirstlane(isb); g = __builtin_amdgcn_readfirstlane(g); nt = __builtin_amdgcn_readfirstlane(nt);
        int e, mt; moe_g2emt(misc, g, e, mt);
        moe_rowlist(misc, c, WSP(int, WS_TOKE) + layer * 2 * NTOK, e, mt);
        f32x4 acc[4][8];
        if (!isb) {
            {
                unsigned ao[4];
#pragma unroll
                for (int i = 0; i < 4; ++i) { const int sr = misc[1024 + (c.tid >> 3) + 64 * i]; ao[i] = (unsigned)((sr < 0 ? 0 : (sr >> 1)) * DM + a_chunk_off(c.tid)); }
                const int mat = c.wid & 1, bkg = (c.wid >> 1) * 2 + (c.lane >> 5), cgm = c.lane & 31;
                const int brow0 = (cgm >> 4) * 128 + (2 * ((cgm >> 2) & 3) + mat) * 16 + (cgm & 3) * 4;
                const float* Wb = (mat ? ARG(w_up) : ARG(w_gate)) + (size_t)(layer * NE + e) * DM * DE + nt * 128;
                gemm_tile_f32w(lds, c, WSP(bf16_t, WS_A1), ao, Wb, (unsigned)((bkg * 8) * DE + 4 * cgm), brow0, bkg, DE, DM / 64, acc);
            }
            bf16_t* ACT = WSP(bf16_t, WS_ACT);
            const float* tokr = WSP(float, WS_TOKR) + layer * NTOK;
#pragma unroll
            for (int mi = 0; mi < 4; ++mi) {
                const int sr = misc[1024 + c.wr * 64 + mi * 16 + c.fr];
                if (sr >= 0) {
                    const float rs = tokr[sr >> 1];
                    bf16_t* orow = ACT + (size_t)sr * DE + nt * 128 + c.wc * 64 + c.fq * 4;
#pragma unroll
                    for (int p = 0; p < 4; ++p) {
                        float a[4];
#pragma unroll
                        for (int q = 0; q < 4; ++q) { const float gv = acc[mi][2 * p][q] * rs; a[q] = gv / (1.0f + __expf(-gv)) * (acc[mi][2 * p + 1][q] * rs); }
                        uint2 o; o.x = pk2(a[0], a[1]); o.y = pk2(a[2], a[3]);
                        *(uint2*)(orow + p * 16) = o;
                    }
                }
            }
            asm volatile("s_waitcnt vmcnt(0)" ::: "memory");
            __syncthreads();
            if (c.tid == 0) {
                __builtin_amdgcn_fence(__ATOMIC_RELEASE, "agent");
                asm volatile("s_waitcnt vmcnt(0)" ::: "memory");
                (void)xb_add((unsigned*)ARG(ws) + MOE_CNT_WORD(layer, g), 1u);
            }
        } else {
            if (c.tid == 0) {
                unsigned* cw = (unsigned*)ARG(ws) + MOE_CNT_WORD(layer, g);
                unsigned sp = 0;
                while (xb_ld(cw) < 4u) { __builtin_amdgcn_s_sleep(2); if (++sp > (1u << 22)) break; }
                __builtin_amdgcn_fence(__ATOMIC_ACQUIRE, "agent");
                asm volatile("s_waitcnt vmcnt(0)" ::: "memory");
            }
            __syncthreads();
            {
                unsigned ao[4];
#pragma unroll
                for (int i = 0; i < 4; ++i) { const int sr = misc[1024 + (c.tid >> 3) + 64 * i]; ao[i] = (unsigned)((sr < 0 ? 0 : sr) * DE + a_chunk_off(c.tid)); }
                const float* Wb = ARG(w_down) + (size_t)(layer * NE + e) * DE * DM + nt * 256;
                gemm_tile_f32w(lds, c, WSP(bf16_t, WS_ACT), ao, Wb, (unsigned)((c.wid * 8) * DM + 4 * c.lane), 4 * c.lane, c.wid, DM, DE / 64, acc);
            }
            bf16_t* Y = WSP(bf16_t, WS_Y);
            const float* tokw = WSP(float, WS_TOKW) + layer * 2 * NTOK;
#pragma unroll
            for (int mi = 0; mi < 4; ++mi) {
                const int sr = misc[1024 + c.wr * 64 + mi * 16 + c.fr];
                if (sr >= 0) {
                    const float w = tokw[sr];
                    bf16_t* orow = Y + (size_t)sr * DM + nt * 256 + c.wc * 128 + c.fq * 4;
#pragma unroll
                    for (int ni = 0; ni < 8; ++ni) {
                        uint2 o; o.x = pk2(acc[mi][ni][0] * w, acc[mi][ni][1] * w); o.y = pk2(acc[mi][ni][2] * w, acc[mi][ni][3] * w);
                        *(uint2*)(orow + ni * 16) = o;
                    }
                }
            }
        }
    }
}

typedef float f32x16 __attribute__((ext_vector_type(16)));
__device__ __forceinline__ void phase_router(LAS unsigned char* lds, const GemmCtx& c, const bf16_t* __restrict__ HB, const float* __restrict__ g,
                                             const float* __restrict__ wrg, const float* __restrict__ wre, bf16_t* AF, int* toke, float* tokw, float* tokr) {
    LAS float* RR = (LAS float*)lds;
    LAS float* YCH = RR + 64;
    LAS float* WRE = YCH + 32 * 260;
    LAS float* WRG = WRE + 256 * 32;
    LAS float* PLOG = WRG + 256 * 4;
    LAS float* PG = PLOG + 8 * 32 * 32;
    for (int tg = blockIdx.x; tg < NTOK / 32; tg += gridDim.x) {
        const int tok0 = tg * 32;
        __syncthreads();
        f32x16 accl;
#pragma unroll
        for (int i = 0; i < 16; ++i) accl[i] = 0.f;
        float accg[4] = {0.f, 0.f, 0.f, 0.f};
        const int ltok = c.tid >> 4, lq = c.tid & 15;
        float ss = 0.f;
        uint2 hbr[1][4]; f32x4 ggr[1][4], wer[1][4], wgr[1];
        auto ldchunk = [&](int kc, int sl) {
#pragma unroll
            for (int j = 0; j < 4; ++j) {
                const int k = kc * 256 + lq * 4 + 64 * j;
                hbr[sl][j] = *(const uint2*)(HB + (size_t)(tok0 + ltok) * DM + k);
                ggr[sl][j] = *(const f32x4*)(g + k);
                wer[sl][j] = *(const f32x4*)(wre + (size_t)kc * 256 * 32 + (c.tid + 512 * j) * 4);
            }
            if (c.tid < 256) wgr[sl] = *(const f32x4*)(wrg + (size_t)kc * 256 * 4 + c.tid * 4);
        };
        ldchunk(0, 0);
        auto chunk = [&](int kc, const int sl) {
#pragma unroll
            for (int j = 0; j < 4; ++j) {
                const int kl = lq * 4 + 64 * j, k = kc * 256 + kl;
                const uint2 hb = hbr[sl][j];
                const f32x4 h = (f32x4){bflo(hb.x), bfhi(hb.x), bflo(hb.y), bfhi(hb.y)};
                ss += h[0] * h[0] + h[1] * h[1] + h[2] * h[2] + h[3] * h[3];
                const f32x4 gg = ggr[sl][j];
                f32x4 y; y[0] = h[0] * gg[0]; y[1] = h[1] * gg[1]; y[2] = h[2] * gg[2]; y[3] = h[3] * gg[3];
                uint2 o; o.x = pk2(y[0], y[1]); o.y = pk2(y[2], y[3]);
                *(uint2*)(AF + (size_t)(tok0 + ltok) * DM + k) = o;
                *(LAS f32x4*)(YCH + ltok * 260 + kl) = y;
            }
#pragma unroll
            for (int j = 0; j < 4; ++j) *(LAS f32x4*)(WRE + (c.tid + 512 * j) * 4) = wer[sl][j];
            if (c.tid < 256) *(LAS f32x4*)(WRG + c.tid * 4) = wgr[sl];
            __syncthreads();
            if (kc + 1 < 8) ldchunk(kc + 1, 0);
#pragma unroll
            for (int s2 = 0; s2 < 16; ++s2) {
                const int kk = 32 * c.wid + 2 * s2 + (c.lane >> 5);
                const float av = YCH[(c.lane & 31) * 260 + kk];
                const float bv = WRE[kk * 32 + (c.lane & 31)];
                accl = __builtin_amdgcn_mfma_f32_32x32x2f32(av, bv, accl, 0, 0, 0);
            }
            {
                const int t2 = c.tid & 31, ks = c.tid >> 5;
#pragma unroll
                for (int kk = 0; kk < 16; ++kk) {
                    const float yv = YCH[t2 * 260 + ks * 16 + kk];
                    const f32x4 wv = *(const LAS f32x4*)(WRG + (ks * 16 + kk) * 4);
                    accg[0] += yv * wv[0]; accg[1] += yv * wv[1]; accg[2] += yv * wv[2]; accg[3] += yv * wv[3];
                }
            }
            __syncthreads();
        };
#pragma unroll 1
        for (int kc = 0; kc < 8; ++kc) chunk(kc, 0);
        ss += __shfl_xor(ss, 1); ss += __shfl_xor(ss, 2); ss += __shfl_xor(ss, 4); ss += __shfl_xor(ss, 8);
        if (lq == 0) { const float r = rsqrtf(ss * (1.0f / DM) + EPS); RR[ltok] = r; tokr[tok0 + ltok] = r; }
#pragma unroll
        for (int r = 0; r < 16; ++r) PLOG[(c.wid * 32 + ((r & 3) + 8 * (r >> 2) + 4 * (c.lane >> 5))) * 32 + (c.lane & 31)] = accl[r];
        {
            const int t2 = c.tid & 31, ks = c.tid >> 5;
            *(LAS f32x4*)(PG + (ks * 32 + t2) * 4) = (f32x4){accg[0], accg[1], accg[2], accg[3]};
        }
        __syncthreads();
        if (c.tid < 32) {
            const int t2 = c.tid;
            const float rr = RR[t2];
            float gl[4] = {0.f, 0.f, 0.f, 0.f};
#pragma unroll
            for (int ks = 0; ks < 16; ++ks) { const f32x4 v = *(const LAS f32x4*)(PG + (ks * 32 + t2) * 4); gl[0] += v[0]; gl[1] += v[1]; gl[2] += v[2]; gl[3] += v[3]; }
#pragma unroll
            for (int q = 0; q < 4; ++q) gl[q] *= rr;
            int gs = 0; float gm = gl[0];
#pragma unroll
            for (int q = 1; q < 4; ++q) if (gl[q] > gm) { gm = gl[q]; gs = q; }
            float den = 0.f;
#pragma unroll
            for (int q = 0; q < 4; ++q) den += __expf(gl[q] - gm);
            const float gw = 1.0f / den;
            float el[8];
#pragma unroll
            for (int q = 0; q < 8; ++q) {
                float v = 0.f;
#pragma unroll
                for (int w = 0; w < 8; ++w) v += PLOG[(w * 32 + t2) * 32 + gs * 8 + q];
                el[q] = v * rr;
            }
            int i0 = 0; float t0 = el[0];
#pragma unroll
            for (int q = 1; q < 8; ++q) if (el[q] > t0) { t0 = el[q]; i0 = q; }
            int i1 = -1; float t1 = -INFINITY;
#pragma unroll
            for (int q = 0; q < 8; ++q) if (q != i0 && el[q] > t1) { t1 = el[q]; i1 = q; }
            const float e1 = __expf(t1 - t0);
            const int tok = tok0 + t2;
            tokw[tok * 2] = gw / (1.0f + e1); tokw[tok * 2 + 1] = gw * e1 / (1.0f + e1);
            toke[tok * 2] = gs * 8 + i0; toke[tok * 2 + 1] = gs * 8 + i1;
        }
    }
}

typedef short v4i16_t __attribute__((ext_vector_type(4)));
__device__ __forceinline__ float bfs2f(short v) { return __uint_as_float(((unsigned)(unsigned short)v) << 16); }
__device__ __forceinline__ void attn_unit(LAS unsigned char* lds, const GemmCtx& c, int bh, int qb, const bf16_t* __restrict__ Qb, const bf16_t* __restrict__ Kb,
                                          const bf16_t* __restrict__ Vb, const float* __restrict__ KM, bf16_t* ATT) {
    const int lane = c.lane, w = c.wid, r32 = lane & 31, hh = lane >> 5;
    const int head = bh & 15, b = bh >> 4;
    const float LOG2E = 1.4426950408889634f;
    const float slope2 = exp2f(-8.0f * (float)(head + 1) / (float)NH) * LOG2E;
    const float cs = 0.08838834764831845f * LOG2E;
    const int qrow = qb * 256 + w * 32 + r32;
    bf16x8 qf[8];
    {
        const bf16_t* qp = Qb + ((size_t)bh * SEQ + qrow) * HD + 8 * hh;
#pragma unroll
        for (int ds = 0; ds < 8; ++ds) qf[ds] = *(const bf16x8*)(qp + 16 * ds);
    }
    unsigned sel = 0;
    if (qb > 0) {
        float gate[7];
#pragma unroll
        for (int n = 0; n < 7; ++n) {
            float part = 0.f;
            if (n < qb) {
                const float* km = KM + ((size_t)bh * NBLK + n) * HD + 8 * hh;
#pragma unroll
                for (int ds = 0; ds < 8; ++ds) {
                    const f32x4 k0 = *(const f32x4*)(km + 16 * ds), k1 = *(const f32x4*)(km + 16 * ds + 4);
                    part += bfs2f(qf[ds][0]) * k0[0] + bfs2f(qf[ds][1]) * k0[1] + bfs2f(qf[ds][2]) * k0[2] + bfs2f(qf[ds][3]) * k0[3]
                          + bfs2f(qf[ds][4]) * k1[0] + bfs2f(qf[ds][5]) * k1[1] + bfs2f(qf[ds][6]) * k1[2] + bfs2f(qf[ds][7]) * k1[3];
                }
                part += __shfl_xor(part, 32);
                asm volatile("" : "+v"(part) :: "memory");
            }
            gate[n] = part;
        }
#pragma unroll
        for (int n = 0; n < 7; ++n) {
            int rank = 0;
#pragma unroll
            for (int m2 = 0; m2 < 7; ++m2) if (m2 != n && m2 < qb && (gate[m2] > gate[n] || (gate[m2] == gate[n] && m2 < n))) ++rank;
            if (n < qb && rank < 3) sel |= 1u << n;
        }
    }
    const float hb = slope2 * (float)(4 * hh);
    f32x16 o[4];
#pragma unroll
    for (int db = 0; db < 4; ++db)
#pragma unroll
        for (int r = 0; r < 16; ++r) o[db][r] = 0.f;
    float m = -INFINITY, l = 0.f;
    const int kq = r32 & 15;
    int koff[2];
    koff[0] = r32 * 256; koff[1] = (r32 + 32) * 256;
    const int vq = (lane & 15) >> 2, vp = lane & 3, dhalf = (lane >> 4) & 1;
    int voff[4];
#pragma unroll
    for (int db = 0; db < 4; ++db) voff[db] = 16384 + (4 * hh + vq) * 256 + (((((db ^ vq) << 2) | (dhalf * 2 + (vp >> 1))) << 4)) + (vp & 1) * 8;
    const bf16_t* kbase_g = Kb + (size_t)bh * SEQ * HD;
    const bf16_t* vbase_g = Vb + (size_t)bh * SEQ * HD;
    int ksrc[2], vsrc[2];
#pragma unroll
    for (int i = 0; i < 2; ++i) {
        const int pos = i * 512 + c.tid, row = pos >> 4, pc = pos & 15;
        ksrc[i] = row * HD + ((pc ^ (row & 15)) << 3);
        vsrc[i] = row * HD + ((pc ^ ((row & 3) << 2)) << 3);
    }
    const int ntiles = (qb + 1) * 4;
    auto issue = [&](int t) {
        const int blk = (t < 4) ? qb : (t >> 2) - 1, tt = t & 3, buf = t & 1;
        const size_t g0 = (size_t)(blk * 256 + tt * 64) * HD;
#pragma unroll
        for (int i = 0; i < 2; ++i) {
            __builtin_amdgcn_global_load_lds((const unsigned*)(kbase_g + g0 + ksrc[i]), (LAS unsigned*)(lds + buf * 32768 + (i * 512 + c.tid) * 16), 16, 0, 0);
            __builtin_amdgcn_global_load_lds((const unsigned*)(vbase_g + g0 + vsrc[i]), (LAS unsigned*)(lds + buf * 32768 + 16384 + (i * 512 + c.tid) * 16), 16, 0, 0);
        }
    };
    __syncthreads();
    issue(0);
    asm volatile("s_waitcnt vmcnt(0)" ::: "memory");
    __syncthreads();
    for (int t = 0; t < ntiles; ++t) {
        if (t + 1 < ntiles) issue(t + 1);
        const int blk = (t < 4) ? qb : (t >> 2) - 1, tt = t & 3;
        const int kb0 = blk * 256 + tt * 64;
        const bool own = (t < 4);
        const bool lsel = own || ((sel >> blk) & 1u);
        const bool active = own ? (kb0 <= qb * 256 + w * 32 + 31) : (__ballot(lsel) != 0ull);
        if (active) {
            LAS unsigned char* kl = lds + (t & 1) * 32768;
            const float lb = lsel ? hb : -INFINITY;
            const bool diag = own && (kb0 + 63 > qb * 256 + w * 32);
#pragma unroll
            for (int h32 = 0; h32 < 2; ++h32) {
                f32x16 p0;
                const float lbq = lb * (1.0f / cs), s2q = slope2 * (1.0f / cs);
#pragma unroll
                for (int r = 0; r < 16; ++r) p0[r] = fmaf(s2q, (float)((r & 3) + 8 * (r >> 2)), lbq);
#pragma unroll
                for (int ds = 0; ds < 8; ++ds) {
                    const int ch = ((2 * ds + hh) ^ kq) << 4;
                    const bf16x8 k0 = *(const LAS bf16x8*)(kl + koff[h32] + ch);
                    p0 = __builtin_amdgcn_mfma_f32_32x32x16_bf16(k0, qf[ds], p0, 0, 0, 0);
                }
                float mx0 = -INFINITY;
                const int dq = qrow - kb0 - 32 * h32 - 4 * hh;
#pragma unroll
                for (int r = 0; r < 16; ++r) {
                    if (diag) { if ((r & 3) + 8 * (r >> 2) > dq) p0[r] = -INFINITY; }
                    mx0 = fmaxf(mx0, p0[r]);
                }
                const float tc = slope2 * (float)(kb0 + 32 * h32);
                float tmax = fmaf(mx0, cs, tc);
                tmax = fmaxf(tmax, __shfl_xor(tmax, 32));
                const float mn = fmaxf(m, tmax);
                if (__ballot(mn > m) != 0ull) {
                    const float alpha = __builtin_amdgcn_exp2f(m - mn);
                    l *= alpha;
#pragma unroll
                    for (int db = 0; db < 4; ++db)
#pragma unroll
                        for (int r = 0; r < 16; ++r) o[db][r] *= alpha;
                    m = mn;
                }
                const float c0 = tc - m;
                float ls = 0.f;
#pragma unroll
                for (int r = 0; r < 16; ++r) { const float e0 = __builtin_amdgcn_exp2f(fmaf(p0[r], cs, c0)); p0[r] = e0; ls += e0; }
                l += ls;
                bf16x8 pb[2];
#pragma unroll
                for (int s2 = 0; s2 < 2; ++s2) {
                    u32x4 w0;
#pragma unroll
                    for (int q = 0; q < 4; ++q) w0[q] = pk2(p0[8 * s2 + 2 * q], p0[8 * s2 + 2 * q + 1]);
                    pb[s2] = __builtin_bit_cast(bf16x8, w0);
                }
#pragma unroll
                for (int db = 0; db < 4; ++db) {
#pragma unroll
                    for (int s2 = 0; s2 < 2; ++s2) {
                        const int ks = 2 * h32 + s2;
                        const v4i16_t lo = __builtin_amdgcn_ds_read_tr16_b64_v4i16((LAS v4i16_t*)(kl + voff[db] + (16 * ks) * 256));
                        const v4i16_t hi = __builtin_amdgcn_ds_read_tr16_b64_v4i16((LAS v4i16_t*)(kl + voff[db] + (16 * ks + 8) * 256));
                        bf16x8 vf; vf[0] = lo[0]; vf[1] = lo[1]; vf[2] = lo[2]; vf[3] = lo[3]; vf[4] = hi[0]; vf[5] = hi[1]; vf[6] = hi[2]; vf[7] = hi[3];
                        o[db] = __builtin_amdgcn_mfma_f32_32x32x16_bf16(vf, pb[s2], o[db], 0, 0, 0);
                    }
                }
            }
        }
        asm volatile("s_waitcnt vmcnt(0)" ::: "memory");
        __syncthreads();
    }
    l += __shfl_xor(l, 32);
    const float inv = 1.0f / l;
    const int orow_tok = b * SEQ + qrow, ocol0 = head * HD + 4 * hh;
#pragma unroll
    for (int db = 0; db < 4; ++db)
#pragma unroll
        for (int rq = 0; rq < 4; ++rq) {
            uint2 ov; ov.x = pk2(o[db][4 * rq] * inv, o[db][4 * rq + 1] * inv); ov.y = pk2(o[db][4 * rq + 2] * inv, o[db][4 * rq + 3] * inv);
            *(uint2*)(ATT + stg_off(orow_tok, ocol0 + db * 32 + 8 * rq)) = ov;
        }
}
__device__ __forceinline__ void phase_attn(LAS unsigned char* lds, const GemmCtx& c, const bf16_t* Qb, const bf16_t* Kb, const bf16_t* Vb, const float* KM, bf16_t* ATT) {
    for (int it = blockIdx.x; it < 256; it += gridDim.x) {
        const int p = (gridDim.x == 256) ? vblock(lds) : it;
        const int bh = p >> 2, j = p & 3;
        attn_unit(lds, c, bh, 7 - j, Qb, Kb, Vb, KM, ATT);
        attn_unit(lds, c, bh, j, Qb, Kb, Vb, KM, ATT);
    }
}

#define XB_TMO      128
#define XB_XCNT(j)  (256  + 64 * (j))
#define XB_XSUB(j)  (1280 + 64 * (j))
#define XB_XGEN(j)  (2304 + 64 * (j))
#define XB_TOP      3328
#define XB_TOPGEN   3392
#define XCD_BAR_WORDS 3456
#define XB_SPIN_CAP (1u << 22)
__device__ __forceinline__ unsigned xb_ld(unsigned* p)              { return __hip_atomic_load(p, __ATOMIC_RELAXED, __HIP_MEMORY_SCOPE_AGENT); }
__device__ __forceinline__ unsigned xb_add(unsigned* p, unsigned v) { return __hip_atomic_fetch_add(p, v, __ATOMIC_RELAXED, __HIP_MEMORY_SCOPE_AGENT); }
__device__ __forceinline__ unsigned xb_xcc_id() { return (unsigned)__builtin_amdgcn_s_getreg((3 << 11) | 20) & 0xFu; }
#define XB_SPIN(cond, bar) do { unsigned _sp = 0; while (cond) { __builtin_amdgcn_s_sleep(1); \
    if ((++_sp & 255u) == 0u) { if (xb_ld(&(bar)[XB_TMO])) break; if (_sp > XB_SPIN_CAP) { atomicAdd(&(bar)[XB_TMO], 1u); break; } } } } while (0)
__device__ __forceinline__ void xcd_barrier_complete(unsigned* bar, unsigned x, unsigned& nloc, unsigned& nx) {
    const unsigned G = gridDim.x;
    unsigned sum, cnt, mine, sp = 0u;
    for (;;) {
        sum = 0u; cnt = 0u; mine = 0u;
#pragma unroll
        for (unsigned j = 0; j < 16; ++j) { const unsigned cc = xb_ld(&bar[XB_XCNT(j)]); sum += cc; cnt += (cc > 0u) ? 1u : 0u; mine = (j == x) ? cc : mine; }
        if (sum == G) break;
        __builtin_amdgcn_s_sleep(1);
        if ((++sp & 255u) == 0u) { if (xb_ld(&bar[XB_TMO])) break; if (sp > XB_SPIN_CAP) { atomicAdd(&bar[XB_TMO], 1u); break; } }
    }
    nloc = mine > 0u ? mine : 1u; nx = cnt > 0u ? cnt : 1u;
}
__device__ __forceinline__ void grid_barrier(unsigned* bar, volatile LAS unsigned* st) {
    asm volatile("s_waitcnt vmcnt(0)" ::: "memory");
    __syncthreads();
    if (threadIdx.x == 0) {
        __builtin_amdgcn_s_waitcnt(0);
        const unsigned x = xb_xcc_id();
        unsigned nloc = st[0], nx = st[1];
        if (nloc == 0u) {
            xcd_barrier_complete(bar, x, nloc, nx); st[0] = nloc; st[1] = nx;
            unsigned ok = 1u;
#pragma unroll
            for (unsigned j = 0; j < 16; ++j) { const unsigned cc = xb_ld(&bar[XB_XCNT(j)]); ok &= (j < 8u) ? (cc == 32u ? 1u : 0u) : (cc == 0u ? 1u : 0u); }
            st[3] = ok;
        }
        const unsigned old = xb_add(&bar[XB_XSUB(x)], 1u);
        const unsigned gen = old / nloc;
        if (old + 1u == (gen + 1u) * nloc) {
            __builtin_amdgcn_fence(__ATOMIC_RELEASE, "agent");
            asm volatile("s_waitcnt vmcnt(0)" ::: "memory");
            const unsigned og = xb_add(&bar[XB_TOP], 1u);
            const unsigned tg = og / nx;
            if (og + 1u == (tg + 1u) * nx) xb_add(&bar[XB_TOPGEN], 1u);
            else XB_SPIN(xb_ld(&bar[XB_TOPGEN]) == tg, bar);
            __builtin_amdgcn_fence(__ATOMIC_ACQUIRE, "agent");
            xb_add(&bar[XB_XGEN(x)], 1u);
            asm volatile("s_waitcnt vmcnt(0)" ::: "memory");
        } else {
            XB_SPIN(xb_ld(&bar[XB_XGEN(x)]) == gen, bar);
            __builtin_amdgcn_fence(__ATOMIC_ACQUIRE, "agent");
            asm volatile("s_waitcnt vmcnt(0)" ::: "memory");
        }
    }
    __syncthreads();
}

__global__ void __launch_bounds__(512, 2) mega(MegaArgs a) {
    extern __shared__ __attribute__((aligned(16))) unsigned char lds_raw[];
    LAS unsigned char* lds = (LAS unsigned char*)lds_raw;
    const int ph_lo = a.ph_lo, ph_hi = a.ph_hi;
    volatile LAS unsigned* bst = (volatile LAS unsigned*)(lds + LDS_MISC + 8160);
    if (threadIdx.x == 0) { bst[0] = 0u; bst[1] = 0u; bst[2] = 0xffffu; bst[3] = 0u; }
    if (ph_hi - ph_lo > 1 && threadIdx.x == 0) {
        const unsigned x = xb_xcc_id(); const unsigned rank = xb_add(&((unsigned*)ARG(ws))[XB_XCNT(x)], 1u);
        bst[2] = (x < 8u && rank < 32u) ? x * 32u + rank : 0xffffu;
    }
    __syncthreads();
#ifndef REPEAT_PH
#define REPEAT_PH -1
#endif
#ifndef ABLATE
#define ABLATE 0
#endif
#define IN(k) (ph_lo <= (k) && (k) < ph_hi)
#define SEAM(k) if (IN(k) && IN((k) + 1)) grid_barrier((unsigned*)ARG(ws), bst);
    if (IN(PH_PREP)) { const GemmCtx c = make_ctx(); const int gwave = blockIdx.x * 8 + c.wid, nwaves = gridDim.x * 8; (void)gwave; (void)nwaves;
        norm_rows(ARG(x), ARG(mix_norm), WSP(bf16_t, WS_A1), nullptr, nullptr, gwave, nwaves, c.lane);
        convert_wt<true>(lds, c, ARG(conv_w_in), 6144, WSP(bf16_t, WS_WT));
        convert_wt(lds, c, ARG(conv_w_out), 2048, WSP(bf16_t, WS_WT) + (size_t)6144 * DM);
        convert_wt(lds, c, ARG(w_kv), 4096, WSP(bf16_t, WS_WT) + (size_t)(6144 + 2048) * DM, ARG(kv_norm));
        convert_wt(lds, c, ARG(w_q), 2048, WSP(bf16_t, WS_WT) + (size_t)(6144 + 2048 + 4096) * DM, ARG(mix_norm) + DM);
        convert_wt(lds, c, ARG(w_o), 2048, WSP(bf16_t, WS_WT) + (size_t)(6144 + 2048 + 6144) * DM); }
    if (IN(PH_PREP) && REPEAT_PH == PH_PREP) grid_barrier((unsigned*)ARG(ws), bst);
    if (IN(PH_PREP) && REPEAT_PH == PH_PREP) { const GemmCtx c = make_ctx(); const int gwave = blockIdx.x * 8 + c.wid, nwaves = gridDim.x * 8; (void)gwave; (void)nwaves;
        norm_rows(ARG(x), ARG(mix_norm), WSP(bf16_t, WS_A1), nullptr, nullptr, gwave, nwaves, c.lane);
        convert_wt<true>(lds, c, ARG(conv_w_in), 6144, WSP(bf16_t, WS_WT));
        convert_wt(lds, c, ARG(conv_w_out), 2048, WSP(bf16_t, WS_WT) + (size_t)6144 * DM);
        convert_wt(lds, c, ARG(w_kv), 4096, WSP(bf16_t, WS_WT) + (size_t)(6144 + 2048) * DM, ARG(kv_norm));
        convert_wt(lds, c, ARG(w_q), 2048, WSP(bf16_t, WS_WT) + (size_t)(6144 + 2048 + 4096) * DM, ARG(mix_norm) + DM);
        convert_wt(lds, c, ARG(w_o), 2048, WSP(bf16_t, WS_WT) + (size_t)(6144 + 2048 + 6144) * DM); }
    SEAM(PH_PREP)
    if (IN(PH_GEMM1)) { const GemmCtx c = make_ctx(); const int gwave = blockIdx.x * 8 + c.wid, nwaves = gridDim.x * 8; (void)gwave; (void)nwaves;
        phase_gemm1(lds, c, WSP(bf16_t, WS_A1), WSP(bf16_t, WS_WT), WSP(bf16_t, WS_BCX)); }
    if (IN(PH_GEMM1) && REPEAT_PH == PH_GEMM1) grid_barrier((unsigned*)ARG(ws), bst);
    if (IN(PH_GEMM1) && REPEAT_PH == PH_GEMM1) { const GemmCtx c = make_ctx(); const int gwave = blockIdx.x * 8 + c.wid, nwaves = gridDim.x * 8; (void)gwave; (void)nwaves;
        phase_gemm1(lds, c, WSP(bf16_t, WS_A1), WSP(bf16_t, WS_WT), WSP(bf16_t, WS_BCX)); }
    SEAM(PH_GEMM1)
    if (IN(PH_CONV)) { const GemmCtx c = make_ctx(); const int gwave = blockIdx.x * 8 + c.wid, nwaves = gridDim.x * 8; (void)gwave; (void)nwaves;
        conv_phase(WSP(bf16_t, WS_BCX), WSP(bf16_t, WS_BCX) + (size_t)NTOK * DM, ARG(conv_w), WSP(bf16_t, WS_Z), blockIdx.x * 512 + c.tid, gridDim.x * 512); }
    if (IN(PH_CONV) && REPEAT_PH == PH_CONV) grid_barrier((unsigned*)ARG(ws), bst);
    if (IN(PH_CONV) && REPEAT_PH == PH_CONV) { const GemmCtx c = make_ctx(); const int gwave = blockIdx.x * 8 + c.wid, nwaves = gridDim.x * 8; (void)gwave; (void)nwaves;
        conv_phase(WSP(bf16_t, WS_BCX), WSP(bf16_t, WS_BCX) + (size_t)NTOK * DM, ARG(conv_w), WSP(bf16_t, WS_Z), blockIdx.x * 512 + c.tid, gridDim.x * 512); }
    SEAM(PH_CONV)
    if (IN(PH_GEMM2)) { const GemmCtx c = make_ctx(); const int gwave = blockIdx.x * 8 + c.wid, nwaves = gridDim.x * 8; (void)gwave; (void)nwaves;
        phase_gemm_resid<0>(lds, c, WSP(bf16_t, WS_Z), WSP(bf16_t, WS_WT) + (size_t)6144 * DM, ARG(x), WSP(bf16_t, WS_HB)); }
    if (IN(PH_GEMM2) && REPEAT_PH == PH_GEMM2) grid_barrier((unsigned*)ARG(ws), bst);
    if (IN(PH_GEMM2) && REPEAT_PH == PH_GEMM2) { const GemmCtx c = make_ctx(); const int gwave = blockIdx.x * 8 + c.wid, nwaves = gridDim.x * 8; (void)gwave; (void)nwaves;
        phase_gemm_resid<0>(lds, c, WSP(bf16_t, WS_Z), WSP(bf16_t, WS_WT) + (size_t)6144 * DM, ARG(x), WSP(bf16_t, WS_HB)); }
    SEAM(PH_GEMM2)
    if (IN(PH_ROUTER0)) { const GemmCtx c = make_ctx(); const int gwave = blockIdx.x * 8 + c.wid, nwaves = gridDim.x * 8; (void)gwave; (void)nwaves;
        phase_router(lds, c, WSP(bf16_t, WS_HB), ARG(ffn_norm), ARG(router_group), ARG(router_expert), WSP(bf16_t, WS_A1), WSP(int, WS_TOKE), WSP(float, WS_TOKW), WSP(float, WS_TOKR)); }
    if (IN(PH_ROUTER0) && REPEAT_PH == PH_ROUTER0) grid_barrier((unsigned*)ARG(ws), bst);
    if (IN(PH_ROUTER0) && REPEAT_PH == PH_ROUTER0) { const GemmCtx c = make_ctx(); const int gwave = blockIdx.x * 8 + c.wid, nwaves = gridDim.x * 8; (void)gwave; (void)nwaves;
        phase_router(lds, c, WSP(bf16_t, WS_HB), ARG(ffn_norm), ARG(router_group), ARG(router_expert), WSP(bf16_t, WS_A1), WSP(int, WS_TOKE), WSP(float, WS_TOKW), WSP(float, WS_TOKR)); }
    SEAM(PH_ROUTER0)
    if (IN(PH_MOEA0)) { const GemmCtx c = make_ctx(); const int gwave = blockIdx.x * 8 + c.wid, nwaves = gridDim.x * 8; (void)gwave; (void)nwaves;
        phase_moe(lds, c, 0); }
    if (IN(PH_MOEA0) && IN(PH_COMBINE0)) grid_barrier((unsigned*)ARG(ws), bst);
    if (IN(PH_COMBINE0)) { const GemmCtx c = make_ctx(); const int gwave = blockIdx.x * 8 + c.wid, nwaves = gridDim.x * 8; (void)gwave; (void)nwaves;
        combine_rows2(WSP(bf16_t, WS_HB), WSP(bf16_t, WS_Y), ARG(kv_norm), WSP(bf16_t, WS_A1), nullptr, nullptr, nullptr, nullptr, gwave, nwaves, c.lane, WSP(float, WS_RINV)); }
    if (IN(PH_COMBINE0) && REPEAT_PH == PH_COMBINE0) grid_barrier((unsigned*)ARG(ws), bst);
    if (IN(PH_COMBINE0) && REPEAT_PH == PH_COMBINE0) { const GemmCtx c = make_ctx(); const int gwave = blockIdx.x * 8 + c.wid, nwaves = gridDim.x * 8; (void)gwave; (void)nwaves;
        combine_rows2(WSP(bf16_t, WS_HB), WSP(bf16_t, WS_Y), ARG(kv_norm), WSP(bf16_t, WS_A1), nullptr, nullptr, nullptr, nullptr, gwave, nwaves, c.lane, WSP(float, WS_RINV)); }
    SEAM(PH_COMBINE0)
    if (IN(PH_GEMM3)) { const GemmCtx c = make_ctx(); const int gwave = blockIdx.x * 8 + c.wid, nwaves = gridDim.x * 8; (void)gwave; (void)nwaves;
        phase_gemm3(lds, c, WSP(bf16_t, WS_A1), WSP(bf16_t, WS_A1), WSP(bf16_t, WS_WT) + (size_t)(6144 + 2048) * DM, ARG(k_norm), ARG(q_norm),
                                  WSP(bf16_t, WS_BCX), WSP(bf16_t, WS_BCX) + (size_t)NTOK * DM, WSP(bf16_t, WS_BCX) + (size_t)2 * NTOK * DM, WSP(float, WS_KMEAN)); }
    if (IN(PH_GEMM3) && REPEAT_PH == PH_GEMM3) grid_barrier((unsigned*)ARG(ws), bst);
    if (IN(PH_GEMM3) && REPEAT_PH == PH_GEMM3) { const GemmCtx c = make_ctx(); const int gwave = blockIdx.x * 8 + c.wid, nwaves = gridDim.x * 8; (void)gwave; (void)nwaves;
        phase_gemm3(lds, c, WSP(bf16_t, WS_A1), WSP(bf16_t, WS_A1), WSP(bf16_t, WS_WT) + (size_t)(6144 + 2048) * DM, ARG(k_norm), ARG(q_norm),
                                  WSP(bf16_t, WS_BCX), WSP(bf16_t, WS_BCX) + (size_t)NTOK * DM, WSP(bf16_t, WS_BCX) + (size_t)2 * NTOK * DM, WSP(float, WS_KMEAN)); }
    SEAM(PH_GEMM3)
    if (IN(PH_ATTN)) { const GemmCtx c = make_ctx(); const int gwave = blockIdx.x * 8 + c.wid, nwaves = gridDim.x * 8; (void)gwave; (void)nwaves;
        phase_attn(lds, c, WSP(bf16_t, WS_BCX) + (size_t)2 * NTOK * DM, WSP(bf16_t, WS_BCX), WSP(bf16_t, WS_BCX) + (size_t)NTOK * DM, WSP(float, WS_KMEAN), WSP(bf16_t, WS_Z)); }
    if (IN(PH_ATTN) && REPEAT_PH == PH_ATTN) grid_barrier((unsigned*)ARG(ws), bst);
    if (IN(PH_ATTN) && REPEAT_PH == PH_ATTN) { const GemmCtx c = make_ctx(); const int gwave = blockIdx.x * 8 + c.wid, nwaves = gridDim.x * 8; (void)gwave; (void)nwaves;
        phase_attn(lds, c, WSP(bf16_t, WS_BCX) + (size_t)2 * NTOK * DM, WSP(bf16_t, WS_BCX), WSP(bf16_t, WS_BCX) + (size_t)NTOK * DM, WSP(float, WS_KMEAN), WSP(bf16_t, WS_Z)); }
    SEAM(PH_ATTN)
    if (IN(PH_GEMM4)) { const GemmCtx c = make_ctx(); const int gwave = blockIdx.x * 8 + c.wid, nwaves = gridDim.x * 8; (void)gwave; (void)nwaves;
        phase_gemm_resid<2>(lds, c, WSP(bf16_t, WS_Z), WSP(bf16_t, WS_WT) + (size_t)(6144 + 2048 + 6144) * DM, WSP(bf16_t, WS_A1), WSP(bf16_t, WS_HB), WSP(float, WS_RINV)); }
    if (IN(PH_GEMM4) && REPEAT_PH == PH_GEMM4) grid_barrier((unsigned*)ARG(ws), bst);
    if (IN(PH_GEMM4) && REPEAT_PH == PH_GEMM4) { const GemmCtx c = make_ctx(); const int gwave = blockIdx.x * 8 + c.wid, nwaves = gridDim.x * 8; (void)gwave; (void)nwaves;
        phase_gemm_resid<2>(lds, c, WSP(bf16_t, WS_Z), WSP(bf16_t, WS_WT) + (size_t)(6144 + 2048 + 6144) * DM, WSP(bf16_t, WS_A1), WSP(bf16_t, WS_HB), WSP(float, WS_RINV)); }
    SEAM(PH_GEMM4)
    if (IN(PH_ROUTER1)) { const GemmCtx c = make_ctx(); const int gwave = blockIdx.x * 8 + c.wid, nwaves = gridDim.x * 8; (void)gwave; (void)nwaves;
        phase_router(lds, c, WSP(bf16_t, WS_HB), ARG(ffn_norm) + DM, ARG(router_group) + (size_t)DM * NG, ARG(router_expert) + (size_t)DM * NE, WSP(bf16_t, WS_A1), WSP(int, WS_TOKE) + 2 * NTOK, WSP(float, WS_TOKW) + 2 * NTOK, WSP(float, WS_TOKR) + NTOK); }
    if (IN(PH_ROUTER1) && REPEAT_PH == PH_ROUTER1) grid_barrier((unsigned*)ARG(ws), bst);
    if (IN(PH_ROUTER1) && REPEAT_PH == PH_ROUTER1) { const GemmCtx c = make_ctx(); const int gwave = blockIdx.x * 8 + c.wid, nwaves = gridDim.x * 8; (void)gwave; (void)nwaves;
        phase_router(lds, c, WSP(bf16_t, WS_HB), ARG(ffn_norm) + DM, ARG(router_group) + (size_t)DM * NG, ARG(router_expert) + (size_t)DM * NE, WSP(bf16_t, WS_A1), WSP(int, WS_TOKE) + 2 * NTOK, WSP(float, WS_TOKW) + 2 * NTOK, WSP(float, WS_TOKR) + NTOK); }
    SEAM(PH_ROUTER1)
    if (IN(PH_MOEA1)) { const GemmCtx c = make_ctx(); const int gwave = blockIdx.x * 8 + c.wid, nwaves = gridDim.x * 8; (void)gwave; (void)nwaves;
        phase_moe(lds, c, 1); }
    if (IN(PH_MOEA1) && IN(PH_COMBINE1)) grid_barrier((unsigned*)ARG(ws), bst);
    if (IN(PH_COMBINE1)) { const GemmCtx c = make_ctx(); const int gwave = blockIdx.x * 8 + c.wid, nwaves = gridDim.x * 8; (void)gwave; (void)nwaves;
        combine_rows2(WSP(bf16_t, WS_HB), WSP(bf16_t, WS_Y), nullptr, nullptr, nullptr, nullptr, nullptr, ARG(H), gwave, nwaves, c.lane); }
    if (IN(PH_COMBINE1) && REPEAT_PH == PH_COMBINE1) grid_barrier((unsigned*)ARG(ws), bst);
    if (IN(PH_COMBINE1) && REPEAT_PH == PH_COMBINE1) { const GemmCtx c = make_ctx(); const int gwave = blockIdx.x * 8 + c.wid, nwaves = gridDim.x * 8; (void)gwave; (void)nwaves;
        combine_rows2(WSP(bf16_t, WS_HB), WSP(bf16_t, WS_Y), nullptr, nullptr, nullptr, nullptr, nullptr, ARG(H), gwave, nwaves, c.lane); }
#undef IN
#undef SEAM
}

extern "C" void kernel_launch(void* const* d_in, const int* in_sizes, int n_in, void* d_out, int out_size, void* d_ws, size_t ws_size, hipStream_t stream) {
    const float* x = (const float*)d_in[0];
    const float* mix_norm = (const float*)d_in[1];
    const float* ffn_norm = (const float*)d_in[2];
    const float* conv_w_in = (const float*)d_in[3];
    const float* conv_w = (const float*)d_in[4];
    const float* conv_w_out = (const float*)d_in[5];
    const float* kv_norm = (const float*)d_in[6];
    const float* w_kv = (const float*)d_in[7];
    const float* k_norm = (const float*)d_in[8];
    const float* w_q = (const float*)d_in[9];
    const float* q_norm = (const float*)d_in[10];
    const float* w_o = (const float*)d_in[11];
    const float* router_group = (const float*)d_in[12];
    const float* router_expert = (const float*)d_in[13];
    const float* w_gate = (const float*)d_in[14];
    const float* w_up = (const float*)d_in[15];
    const float* w_down = (const float*)d_in[16];
    float* H = (float*)d_out;
    unsigned char* ws = (unsigned char*)d_ws;
    if (ws_size < WS_END) { fprintf(stderr, "workspace too small: %zu < %zu\n", ws_size, (size_t)WS_END); return; }
    int* cnt = (int*)(ws + WS_CNT);
    bf16_t* A1 = (bf16_t*)(ws + WS_A1); bf16_t* A2 = (bf16_t*)(ws + WS_A2);
    bf16_t* BCX = (bf16_t*)(ws + WS_BCX);
    bf16_t* Kb = (bf16_t*)(ws + WS_BCX); bf16_t* Vb = Kb + (size_t)NTOK * DM; bf16_t* Qb = Vb + (size_t)NTOK * DM;
    bf16_t* Z = (bf16_t*)(ws + WS_Z); bf16_t* ATT = Z;
    bf16_t* ACT = (bf16_t*)(ws + WS_ACT); bf16_t* Y = (bf16_t*)(ws + WS_Y);
    float* KM = (float*)(ws + WS_KMEAN);
    int* list = (int*)(ws + WS_LIST); float* tokw = (float*)(ws + WS_TOKW); int* toke = (int*)(ws + WS_TOKE);
    float* T = (float*)(ws + WS_T);
    const size_t nd = (size_t)NTOK * DM;
    static bool attr = false;
    if (!attr) { (void)hipFuncSetAttribute((const void*)mega, hipFuncAttributeMaxDynamicSharedMemorySize, LDS_BYTES); attr = true; }
    MegaArgs ma{};
    ma.x = x; ma.mix_norm = mix_norm; ma.ffn_norm = ffn_norm; ma.conv_w_in = conv_w_in; ma.conv_w = conv_w; ma.conv_w_out = conv_w_out;
    ma.kv_norm = kv_norm; ma.w_kv = w_kv; ma.k_norm = k_norm; ma.w_q = w_q; ma.q_norm = q_norm; ma.w_o = w_o;
    ma.router_group = router_group; ma.router_expert = router_expert; ma.w_gate = w_gate; ma.w_up = w_up; ma.w_down = w_down;
    ma.H = H; ma.ws = ws;
    static int grid = 0;
    if (!grid) {
        int dev = 0, cus = 0, per_cu = 0;
        (void)hipGetDevice(&dev);
        (void)hipDeviceGetAttribute(&cus, hipDeviceAttributeMultiprocessorCount, dev);
        (void)hipOccupancyMaxActiveBlocksPerMultiprocessor(&per_cu, (const void*)mega, 512, LDS_BYTES);
        if (per_cu < 1) per_cu = 1;
        grid = cus * 1;
        if (grid > 256) grid = 256;
    }
    (void)hipMemsetAsync(ws + WS_CTL, 0, 16384, stream);
    ma.ph_lo = 0; ma.ph_hi = PH_END;
    void* kargs[] = {&ma};
    hipError_t le = hipLaunchCooperativeKernel((const void*)mega, dim3(grid), dim3(512), kargs, LDS_BYTES, stream);
    if (le != hipSuccess) fprintf(stderr, "cooperative launch failed: %s (grid %d)\n", hipGetErrorString(le), grid);
}
```

```cpp
#include <hip/hip_runtime.h>
#include <cstdint>
#include <cstddef>
#include <cstdio>

constexpr int NTOK = 8192, DM = 2048, SEQ = 2048, NBATCH = 4, NH = 16, HD = 128, NBLK = 8, BLK = 256;
constexpr int NE = 32, DE = 512, NG = 4, EPG = 8;
constexpr float EPS = 1e-6f;
constexpr int LDP = DM + 128;

typedef unsigned short bf16_t;
typedef float f32x4 __attribute__((ext_vector_type(4)));

constexpr size_t MB = 1024 * 1024;
constexpr size_t WS_CTL = 0;
constexpr size_t WS_CNT = 64 * 1024;
constexpr size_t WS_A1 = 1 * MB;
constexpr size_t WS_A2 = WS_A1 + 36 * MB;
constexpr size_t WS_BCX = WS_A2 + 36 * MB;
constexpr size_t WS_Z = WS_BCX + 96 * MB;
constexpr size_t WS_ACT = WS_Z + 36 * MB;
constexpr size_t WS_Y = WS_ACT + 16 * MB;
constexpr size_t WS_KMEAN = WS_Y + 64 * MB;
constexpr size_t WS_LIST = WS_KMEAN + 1 * MB;
constexpr size_t WS_TOKW = WS_LIST + 2 * MB;
constexpr size_t WS_TOKE = WS_TOKW + 1 * MB;
constexpr size_t WS_T = WS_TOKE + 1 * MB;
constexpr size_t WS_WT = WS_T;
constexpr size_t WS_HB = WS_T + 96 * MB;
constexpr size_t WS_RINV = WS_TOKW + 640 * 1024;
constexpr size_t WS_TOKR = WS_TOKW + 512 * 1024;
constexpr size_t WS_END = WS_T + 192 * MB;

__device__ __forceinline__ unsigned pk2(float lo, float hi) {
    typedef float f2 __attribute__((ext_vector_type(2)));
    typedef __bf16 b2 __attribute__((ext_vector_type(2)));
    f2 v = {lo, hi}; b2 b = __builtin_convertvector(v, b2); return __builtin_bit_cast(unsigned, b);
}
__device__ __forceinline__ float bflo(unsigned u) { return __uint_as_float(u << 16); }
__device__ __forceinline__ float bfhi(unsigned u) { return __uint_as_float(u & 0xffff0000u); }
__device__ __forceinline__ float bf2f(bf16_t b) { return __uint_as_float((unsigned)b << 16); }
__device__ __forceinline__ float wave_sum(float v) {
#pragma unroll
    for (int o = 1; o < 64; o <<= 1) v += __shfl_xor(v, o);
    return v;
}
__device__ __forceinline__ float wave_max(float v) {
#pragma unroll
    for (int o = 1; o < 64; o <<= 1) v = fmaxf(v, __shfl_xor(v, o));
    return v;
}

__device__ __forceinline__ size_t stg_off(int row, int k) {
    const int r = row & 255;
    return ((size_t)((row >> 8) * 64 + (k >> 5)) * 8192) + (size_t)((r * 64 + (((((k & 31) >> 3)) ^ ((0 - (r >> 2)) & 3)) << 4)) >> 1) + (k & 7);
}
__device__ __forceinline__ void norm_rows(const float* __restrict__ src, const float* g1, bf16_t* o1, const float* g2, bf16_t* o2,
                                          int gwave, int nwaves, int lane) {
    for (int row = gwave; row < NTOK; row += nwaves) {
        const f32x4* p = (const f32x4*)(src + (size_t)row * DM);
        f32x4 v[8]; float ss = 0.f;
#pragma unroll
        for (int i = 0; i < 8; ++i) { v[i] = p[lane + 64 * i]; ss += v[i][0] * v[i][0] + v[i][1] * v[i][1] + v[i][2] * v[i][2] + v[i][3] * v[i][3]; }
        ss = wave_sum(ss);
        const float r = rsqrtf(ss * (1.0f / DM) + EPS);
#pragma unroll
        for (int i = 0; i < 8; ++i) {
            const int c = 4 * (lane + 64 * i);
            const f32x4 g = *(const f32x4*)(g1 + c);
            uint2 o; o.x = pk2(v[i][0] * r * g[0], v[i][1] * r * g[1]); o.y = pk2(v[i][2] * r * g[2], v[i][3] * r * g[3]);
            *(uint2*)(o1 + stg_off(row, c)) = o;
            if (g2) {
                const f32x4 h = *(const f32x4*)(g2 + c);
                uint2 q; q.x = pk2(v[i][0] * r * h[0], v[i][1] * r * h[1]); q.y = pk2(v[i][2] * r * h[2], v[i][3] * r * h[3]);
                *(uint2*)(o2 + stg_off(row, c)) = q;
            }
        }
    }
}

__device__ __forceinline__ void combine_rows(float* H, const bf16_t* __restrict__ Y, const float* g1, bf16_t* o1, const float* g2, bf16_t* o2,
                                             int gwave, int nwaves, int lane) {
    for (int row = gwave; row < NTOK; row += nwaves) {
        f32x4* p = (f32x4*)(H + (size_t)row * DM);
        const uint2* y0 = (const uint2*)(Y + (size_t)(2 * row) * DM);
        const uint2* y1 = (const uint2*)(Y + (size_t)(2 * row + 1) * DM);
        f32x4 v[8]; float ss = 0.f;
#pragma unroll
        for (int i = 0; i < 8; ++i) {
            v[i] = p[lane + 64 * i];
            const uint2 a = y0[lane + 64 * i], b = y1[lane + 64 * i];
            v[i][0] += bflo(a.x) + bflo(b.x); v[i][1] += bfhi(a.x) + bfhi(b.x);
            v[i][2] += bflo(a.y) + bflo(b.y); v[i][3] += bfhi(a.y) + bfhi(b.y);
            p[lane + 64 * i] = v[i];
            ss += v[i][0] * v[i][0] + v[i][1] * v[i][1] + v[i][2] * v[i][2] + v[i][3] * v[i][3];
        }
        if (g1) {
            ss = wave_sum(ss);
            const float r = rsqrtf(ss * (1.0f / DM) + EPS);
#pragma unroll
            for (int i = 0; i < 8; ++i) {
                const int c = 4 * (lane + 64 * i);
                if (g2 == nullptr) {
                    uint2 o; o.x = pk2(v[i][0] * r, v[i][1] * r); o.y = pk2(v[i][2] * r, v[i][3] * r);
                    *(uint2*)(o1 + stg_off(row, c)) = o;
                } else {
                    const f32x4 g = *(const f32x4*)(g1 + c);
                    uint2 o; o.x = pk2(v[i][0] * r * g[0], v[i][1] * r * g[1]); o.y = pk2(v[i][2] * r * g[2], v[i][3] * r * g[3]);
                    *(uint2*)(o1 + stg_off(row, c)) = o;
                    const f32x4 h = *(const f32x4*)(g2 + c);
                    uint2 q; q.x = pk2(v[i][0] * r * h[0], v[i][1] * r * h[1]); q.y = pk2(v[i][2] * r * h[2], v[i][3] * r * h[3]);
                    *(uint2*)(o2 + stg_off(row, c)) = q;
                }
            }
        }
    }
}

__device__ __forceinline__ void combine_rows2(const bf16_t* __restrict__ HBin, const bf16_t* __restrict__ Y, const float* g1, bf16_t* o1, const float* g2, bf16_t* o2,
                                              bf16_t* HBout, float* OUT, int gwave, int nwaves, int lane, float* rs_out = nullptr) {
    for (int row = gwave; row < NTOK; row += nwaves) {
        const uint2* hp = (const uint2*)(HBin + (size_t)row * DM);
        const uint2* y0 = (const uint2*)(Y + (size_t)(2 * row) * DM);
        const uint2* y1 = (const uint2*)(Y + (size_t)(2 * row + 1) * DM);
        f32x4 v[8]; float ss = 0.f;
#pragma unroll
        for (int i = 0; i < 8; ++i) {
            const uint2 h = hp[lane + 64 * i], a = y0[lane + 64 * i], b = y1[lane + 64 * i];
            v[i][0] = bflo(h.x) + (bflo(a.x) + bflo(b.x)); v[i][1] = bfhi(h.x) + (bfhi(a.x) + bfhi(b.x));
            v[i][2] = bflo(h.y) + (bflo(a.y) + bflo(b.y)); v[i][3] = bfhi(h.y) + (bfhi(a.y) + bfhi(b.y));
            if (HBout) { uint2 o; o.x = pk2(v[i][0], v[i][1]); o.y = pk2(v[i][2], v[i][3]); *(uint2*)(HBout + (size_t)row * DM + 4 * (lane + 64 * i)) = o; }
            if (OUT) *(f32x4*)(OUT + (size_t)row * DM + 4 * (lane + 64 * i)) = v[i];
            ss += v[i][0] * v[i][0] + v[i][1] * v[i][1] + v[i][2] * v[i][2] + v[i][3] * v[i][3];
        }
        if (g1) {
            ss = wave_sum(ss);
            const float r = rsqrtf(ss * (1.0f / DM) + EPS);
            if (rs_out && lane == 0) rs_out[row] = sqrtf(ss * (1.0f / DM) + EPS);
#pragma unroll
            for (int i = 0; i < 8; ++i) {
                const int c = 4 * (lane + 64 * i);
                if (g2 == nullptr) {
                    uint2 o; o.x = pk2(v[i][0] * r, v[i][1] * r); o.y = pk2(v[i][2] * r, v[i][3] * r);
                    *(uint2*)(o1 + stg_off(row, c)) = o;
                } else {
                    const f32x4 g = *(const f32x4*)(g1 + c);
                    uint2 o; o.x = pk2(v[i][0] * r * g[0], v[i][1] * r * g[1]); o.y = pk2(v[i][2] * r * g[2], v[i][3] * r * g[3]);
                    *(uint2*)(o1 + stg_off(row, c)) = o;
                    const f32x4 h = *(const f32x4*)(g2 + c);
                    uint2 q; q.x = pk2(v[i][0] * r * h[0], v[i][1] * r * h[1]); q.y = pk2(v[i][2] * r * h[2], v[i][3] * r * h[3]);
                    *(uint2*)(o2 + stg_off(row, c)) = q;
                }
            }
        }
    }
}

__device__ __forceinline__ void conv_phase(const bf16_t* __restrict__ Bb, const bf16_t* __restrict__ U, const float* __restrict__ cw, bf16_t* Z, int gthread, int nthreads) {
    for (int item = gthread; item < (NTOK / 16) * (DM / 8); item += nthreads) {
        const int co = item & 255, trun = item >> 8;
        const int t0 = trun * 16, s0 = t0 & (SEQ - 1);
        const int c0 = co * 8;
        float w0[8], w1[8], w2[8];
#pragma unroll
        for (int e = 0; e < 8; ++e) { w0[e] = cw[c0 + e]; w1[e] = cw[DM + c0 + e]; w2[e] = cw[2 * DM + c0 + e]; }
        float um2[8], um1[8];
#pragma unroll
        for (int e = 0; e < 8; ++e) { um2[e] = 0.f; um1[e] = 0.f; }
        if (s0 >= 2) {
            const uint4 a = *(const uint4*)(U + (size_t)(t0 - 2) * DM + c0), b = *(const uint4*)(U + (size_t)(t0 - 1) * DM + c0);
            const unsigned av[4] = {a.x, a.y, a.z, a.w}, bv[4] = {b.x, b.y, b.z, b.w};
#pragma unroll
            for (int e = 0; e < 4; ++e) { um2[2 * e] = bflo(av[e]); um2[2 * e + 1] = bfhi(av[e]); um1[2 * e] = bflo(bv[e]); um1[2 * e + 1] = bfhi(bv[e]); }
        }
        for (int t = t0; t < t0 + 16; ++t) {
            const uint4 bg = *(const uint4*)(Bb + (size_t)t * DM + c0), uu = *(const uint4*)(U + (size_t)t * DM + c0);
            const unsigned bgv[4] = {bg.x, bg.y, bg.z, bg.w}, uv[4] = {uu.x, uu.y, uu.z, uu.w};
            unsigned ov[4];
#pragma unroll
            for (int e = 0; e < 4; ++e) {
                const float ua = bflo(uv[e]), ub = bfhi(uv[e]);
                const float ca = w0[2 * e] * um2[2 * e] + w1[2 * e] * um1[2 * e] + w2[2 * e] * ua;
                const float cb = w0[2 * e + 1] * um2[2 * e + 1] + w1[2 * e + 1] * um1[2 * e + 1] + w2[2 * e + 1] * ub;
                ov[e] = pk2(bflo(bgv[e]) * ca, bfhi(bgv[e]) * cb);
                um2[2 * e] = um1[2 * e]; um2[2 * e + 1] = um1[2 * e + 1]; um1[2 * e] = ua; um1[2 * e + 1] = ub;
            }
            *(uint4*)(Z + stg_off(t, c0)) = make_uint4(ov[0], ov[1], ov[2], ov[3]);
        }
    }
}

__global__ void __launch_bounds__(512) k_prep(const float* x, const float* g, bf16_t* a1, int* cnt) {
    const int gt = blockIdx.x * 512 + threadIdx.x;
    if (gt < 2 * NE) cnt[gt] = 0;
    norm_rows(x, g, a1, nullptr, nullptr, gt >> 6, (gridDim.x * 512) >> 6, threadIdx.x & 63);
}
__global__ void __launch_bounds__(512) k_conv(const bf16_t* BCX, const float* cw, bf16_t* Z) {
    conv_phase(BCX, BCX + (size_t)NTOK * DM, cw, Z, blockIdx.x * 512 + threadIdx.x, gridDim.x * 512);
}
__global__ void __launch_bounds__(512) k_combine(float* H, const bf16_t* Y, const float* g1, bf16_t* o1, const float* g2, bf16_t* o2) {
    const int gt = blockIdx.x * 512 + threadIdx.x;
    combine_rows(H, Y, g1, o1, g2, o2, gt >> 6, (gridDim.x * 512) >> 6, threadIdx.x & 63);
}

__global__ void __launch_bounds__(512) naive_gemm(const bf16_t* __restrict__ A, const float* __restrict__ W, float* T, int N, int ldt, int coff) {
    __shared__ float sA[4 * DM];
    const int tid = threadIdx.x, n = blockIdx.x * 512 + tid;
    for (int half = 0; half < 2; ++half) {
    const int m0 = blockIdx.y * 8 + half * 4;
    __syncthreads();
    for (int i = tid; i < 4 * DM; i += 512) sA[i] = bf2f(A[(size_t)(m0 + (i >> 11)) * DM + (i & 2047)]);
    __syncthreads();
    float acc[4];
#pragma unroll
    for (int r = 0; r < 4; ++r) acc[r] = 0.f;
    for (int k = 0; k < DM; k += 4) {
        const float w0 = W[(size_t)k * N + n], w1 = W[(size_t)(k + 1) * N + n], w2 = W[(size_t)(k + 2) * N + n], w3 = W[(size_t)(k + 3) * N + n];
#pragma unroll
        for (int r = 0; r < 4; ++r) { const f32x4 a = *(const f32x4*)&sA[r * DM + k]; acc[r] += a[0] * w0 + a[1] * w1 + a[2] * w2 + a[3] * w3; }
    }
#pragma unroll
    for (int r = 0; r < 4; ++r) T[(size_t)(m0 + r) * ldt + coff + n] = acc[r];
    }
}
__global__ void naive_epi_bf16(const float* T, bf16_t* O, size_t n) { size_t i = (size_t)blockIdx.x * blockDim.x + threadIdx.x; if (i < n) O[i] = (bf16_t)(pk2(T[i], 0.f) & 0xffff); }
__global__ void naive_epi_resid(const float* R, const float* T, float* H, size_t n) { size_t i = (size_t)blockIdx.x * blockDim.x + threadIdx.x; if (i < n) H[i] = R[i] + T[i]; }
__global__ void __launch_bounds__(256) naive_epi_kvq(const float* T, const float* kn, const float* qn, bf16_t* Kb, bf16_t* Vb, bf16_t* Qb) {
    const int gw = (blockIdx.x * 256 + threadIdx.x) >> 6, lane = threadIdx.x & 63;
    if (gw >= NTOK * 48) return;
    const int tok = gw / 48, rem = gw % 48, which = rem / 16, h = rem % 16;
    const float* src = T + (size_t)tok * 6144 + which * 2048 + h * 128 + 2 * lane;
    float v0 = src[0], v1 = src[1];
    if (which != 1) {
        const float ss = wave_sum(v0 * v0 + v1 * v1);
        const float r = rsqrtf(ss * (1.0f / HD) + EPS);
        const float* g = (which == 0) ? kn : qn;
        v0 = v0 * r * g[2 * lane]; v1 = v1 * r * g[2 * lane + 1];
    }
    const int b = tok / SEQ, s = tok % SEQ;
    bf16_t* dst = (which == 0 ? Kb : (which == 1 ? Vb : Qb)) + ((size_t)(b * NH + h) * SEQ + s) * HD + 2 * lane;
    *(unsigned*)dst = pk2(v0, v1);
}
__global__ void naive_kmean(const bf16_t* Kb, float* KM) {
    const int i = blockIdx.x * blockDim.x + threadIdx.x;
    if (i >= NBATCH * NH * NBLK * HD) return;
    const int d = i & 127, blk = (i >> 7) & 7, bh = i >> 10;
    float s = 0.f;
    for (int r = 0; r < BLK; ++r) s += bf2f(Kb[((size_t)bh * SEQ + blk * BLK + r) * HD + d]);
    KM[i] = s * (1.0f / BLK);
}

__global__ void __launch_bounds__(256) naive_router(const float* __restrict__ H, const float* g, const float* __restrict__ wrg, const float* __restrict__ wre,
                                                    bf16_t* AF, int* cnt, int* list, float* tokw, int* toke) {
    const int tok = (blockIdx.x * 256 + threadIdx.x) >> 6, lane = threadIdx.x & 63;
    if (tok >= NTOK) return;
    const f32x4* p = (const f32x4*)(H + (size_t)tok * DM);
    f32x4 v[8]; float ss = 0.f;
#pragma unroll
    for (int i = 0; i < 8; ++i) { v[i] = p[lane + 64 * i]; ss += v[i][0] * v[i][0] + v[i][1] * v[i][1] + v[i][2] * v[i][2] + v[i][3] * v[i][3]; }
    ss = wave_sum(ss);
    const float r = rsqrtf(ss * (1.0f / DM) + EPS);
    float acc[36];
#pragma unroll
    for (int c = 0; c < 36; ++c) acc[c] = 0.f;
#pragma unroll
    for (int i = 0; i < 8; ++i) {
        const int c0 = 4 * (lane + 64 * i);
        const f32x4 gg = *(const f32x4*)(g + c0);
        f32x4 y; y[0] = v[i][0] * r * gg[0]; y[1] = v[i][1] * r * gg[1]; y[2] = v[i][2] * r * gg[2]; y[3] = v[i][3] * r * gg[3];
        uint2 o; o.x = pk2(y[0], y[1]); o.y = pk2(y[2], y[3]);
        *(uint2*)(AF + (size_t)tok * DM + c0) = o;
#pragma unroll
        for (int e = 0; e < 4; ++e) {
            const int k = c0 + e;
            const f32x4 wg = *(const f32x4*)(wrg + (size_t)k * 4);
#pragma unroll
            for (int c = 0; c < 4; ++c) acc[c] += y[e] * wg[c];
#pragma unroll
            for (int q = 0; q < 8; ++q) {
                const f32x4 w = *(const f32x4*)(wre + (size_t)k * 32 + 4 * q);
#pragma unroll
                for (int c = 0; c < 4; ++c) acc[4 + 4 * q + c] += y[e] * w[c];
            }
        }
    }
#pragma unroll
    for (int c = 0; c < 36; ++c) acc[c] = wave_sum(acc[c]);
    if (lane == 0) {
        int gs = 0; float gm = acc[0];
#pragma unroll
        for (int c = 1; c < 4; ++c) if (acc[c] > gm) { gm = acc[c]; gs = c; }
        float den = 0.f;
#pragma unroll
        for (int c = 0; c < 4; ++c) den += __expf(acc[c] - gm);
        const float gw = 1.0f / den;
        float el[8];
#pragma unroll
        for (int c = 0; c < 8; ++c) {
            float x = 0.f;
#pragma unroll
            for (int gg = 0; gg < 4; ++gg) x = (gs == gg) ? acc[4 + gg * 8 + c] : x;
            el[c] = x;
        }
        int i0 = 0; float t0 = el[0];
#pragma unroll
        for (int c = 1; c < 8; ++c) if (el[c] > t0) { t0 = el[c]; i0 = c; }
        int i1 = -1; float t1 = -INFINITY;
#pragma unroll
        for (int c = 0; c < 8; ++c) if (c != i0 && el[c] > t1) { t1 = el[c]; i1 = c; }
        const float e1 = __expf(t1 - t0);
        const float w0 = gw / (1.0f + e1), w1 = gw * e1 / (1.0f + e1);
        const int ex0 = gs * 8 + i0, ex1 = gs * 8 + i1;
        tokw[tok * 2] = w0; tokw[tok * 2 + 1] = w1; toke[tok * 2] = ex0; toke[tok * 2 + 1] = ex1;
    }
}

__global__ void __launch_bounds__(512) naive_build_lists(const int* toke, int* cnt, int* list) {
    __shared__ int part[512];
    const int e = blockIdx.x, tid = threadIdx.x;
    int c = 0;
    for (int i = 0; i < 32; ++i) c += (toke[tid * 32 + i] == e);
    part[tid] = c;
    __syncthreads();
    int off = 0;
    for (int j = 0; j < tid; ++j) off += part[j];
    for (int i = 0; i < 32; ++i) if (toke[tid * 32 + i] == e) list[e * NTOK + off++] = tid * 32 + i;
    if (tid == 511) cnt[e] = off;
}
__global__ void __launch_bounds__(512) naive_moe_a(const bf16_t* __restrict__ AF, const float* __restrict__ Wg, const float* __restrict__ Wu,
                                                   const int* cnt, const int* list, bf16_t* ACT) {
    __shared__ float sA[4 * DM];
    __shared__ int srs[8];
    const int e = blockIdx.y, c0 = blockIdx.x * 4, n = cnt[e], tid = threadIdx.x;
    if (c0 >= n) return;
    if (tid < 4) srs[tid] = (c0 + tid < n) ? list[e * NTOK + c0 + tid] : -1;
    __syncthreads();
    for (int i = tid; i < 4 * DM; i += 512) { const int sr = srs[i >> 11]; sA[i] = sr >= 0 ? bf2f(AF[(size_t)(sr >> 1) * DM + (i & 2047)]) : 0.f; }
    __syncthreads();
    float ag[4], au[4];
#pragma unroll
    for (int r = 0; r < 4; ++r) { ag[r] = 0.f; au[r] = 0.f; }
    const float* wg = Wg + (size_t)e * DM * DE + tid; const float* wu = Wu + (size_t)e * DM * DE + tid;
    for (int k = 0; k < DM; k += 4) {
        float g4[4], u4[4];
#pragma unroll
        for (int q = 0; q < 4; ++q) { g4[q] = wg[(size_t)(k + q) * DE]; u4[q] = wu[(size_t)(k + q) * DE]; }
#pragma unroll
        for (int r = 0; r < 4; ++r) { const f32x4 a = *(const f32x4*)&sA[r * DM + k];
            ag[r] += a[0] * g4[0] + a[1] * g4[1] + a[2] * g4[2] + a[3] * g4[3];
            au[r] += a[0] * u4[0] + a[1] * u4[1] + a[2] * u4[2] + a[3] * u4[3]; }
    }
#pragma unroll
    for (int r = 0; r < 4; ++r) { const int sr = srs[r]; if (sr >= 0) { const float gv = ag[r]; const float a = gv / (1.0f + __expf(-gv)) * au[r];
        ACT[(size_t)sr * DE + tid] = (bf16_t)(pk2(a, 0.f) & 0xffff); } }
}
__global__ void __launch_bounds__(512) naive_moe_b(const bf16_t* __restrict__ ACT, const float* __restrict__ Wd, const int* cnt, const int* list,
                                                   const float* tokw, bf16_t* Y) {
    __shared__ float sA[8 * DE];
    __shared__ int srs[8];
    const int e = blockIdx.y, c0 = blockIdx.x * 8, n = cnt[e], tid = threadIdx.x;
    if (c0 >= n) return;
    if (tid < 8) srs[tid] = (c0 + tid < n) ? list[e * NTOK + c0 + tid] : -1;
    __syncthreads();
    for (int i = tid; i < 8 * DE; i += 512) { const int sr = srs[i >> 9]; sA[i] = sr >= 0 ? bf2f(ACT[(size_t)sr * DE + (i & 511)]) : 0.f; }
    __syncthreads();
    float acc[8][4];
#pragma unroll
    for (int r = 0; r < 8; ++r)
#pragma unroll
        for (int q = 0; q < 4; ++q) acc[r][q] = 0.f;
    const float* wd = Wd + (size_t)e * DE * DM + tid;
    for (int k = 0; k < DE; ++k) {
        float w[4];
#pragma unroll
        for (int q = 0; q < 4; ++q) w[q] = wd[(size_t)k * DM + 512 * q];
#pragma unroll
        for (int r = 0; r < 8; ++r) { const float a = sA[r * DE + k];
#pragma unroll
            for (int q = 0; q < 4; ++q) acc[r][q] += a * w[q]; }
    }
#pragma unroll
    for (int r = 0; r < 8; ++r) { const int sr = srs[r]; if (sr >= 0) { const float w = tokw[sr];
#pragma unroll
        for (int q = 0; q < 4; ++q) Y[(size_t)sr * DM + tid + 512 * q] = (bf16_t)(pk2(acc[r][q] * w, 0.f) & 0xffff); } }
}

__global__ void __launch_bounds__(256) naive_attn(const bf16_t* __restrict__ Qb, const bf16_t* __restrict__ Kb, const bf16_t* __restrict__ Vb,
                                                  const float* __restrict__ KM, bf16_t* ATT) {
    const int gw = (blockIdx.x * 256 + threadIdx.x) >> 6, lane = threadIdx.x & 63;
    if (gw >= NBATCH * NH * SEQ) return;
    const int s = gw % SEQ, bh = gw / SEQ, h = bh % NH, b = bh / NH;
    const int i = s / BLK;
    const unsigned qq = *(const unsigned*)(Qb + ((size_t)bh * SEQ + s) * HD + 2 * lane);
    const float q0 = bflo(qq), q1 = bfhi(qq);
    float gate[8];
#pragma unroll
    for (int n = 0; n < 8; ++n) {
        const float* km = KM + ((size_t)bh * NBLK + n) * HD + 2 * lane;
        gate[n] = wave_sum(q0 * km[0] + q1 * km[1]);
    }
    unsigned sel = 0;
#pragma unroll
    for (int n = 0; n < 8; ++n) {
        int rank = 0;
#pragma unroll
        for (int m = 0; m < 8; ++m) if (m < i && m != n && (gate[m] > gate[n] || (gate[m] == gate[n] && m < n))) ++rank;
        if (n < i && rank < 3) sel |= 1u << n;
    }
    const float slope = exp2f(-8.0f * (float)(h + 1) / (float)NH);
    const float scale = 0.08838834764831845f;
    float m = -INFINITY, l = 0.f, o0 = 0.f, o1 = 0.f;
    for (int jj = 0; jj <= i; ++jj) {
        const int j = (jj == 0) ? i : jj - 1;
        if (j != i && !((sel >> j) & 1)) continue;
        for (int c = 0; c < 4; ++c) {
            const int kbase = j * BLK + c * 64;
            if (j == i && kbase > s) break;
            const int kk = kbase + lane;
            const bf16_t* krow = Kb + ((size_t)bh * SEQ + kk) * HD;
            float dot = 0.f;
            for (int d2 = 0; d2 < 64; ++d2) {
                const float qa = __shfl(q0, d2), qb = __shfl(q1, d2);
                const unsigned kv = *(const unsigned*)(krow + 2 * d2);
                dot += qa * bflo(kv) + qb * bfhi(kv);
            }
            const bool valid = (j < i) || (kk <= s);
            const float sc = valid ? dot * scale - slope * (float)(s - kk) : -INFINITY;
            const float mx = wave_max(sc);
            const float mn = fmaxf(m, mx);
            const float p = valid ? __expf(sc - mn) : 0.f;
            const float alpha = __expf(m - mn);
            l = l * alpha + wave_sum(p);
            o0 *= alpha; o1 *= alpha; m = mn;
            for (int t = 0; t < 64; ++t) {
                const float pt = __shfl(p, t);
                const unsigned vv = *(const unsigned*)(Vb + ((size_t)bh * SEQ + kbase + t) * HD + 2 * lane);
                o0 += pt * bflo(vv); o1 += pt * bfhi(vv);
            }
        }
    }
    const float inv = 1.0f / l;
    *(unsigned*)(ATT + ((size_t)(b * SEQ + s)) * DM + h * HD + 2 * lane) = pk2(o0 * inv, o1 * inv);
}


#define LAS __attribute__((address_space(3)))
typedef short bf16x8 __attribute__((ext_vector_type(8)));
typedef unsigned u32x4 __attribute__((ext_vector_type(4)));
constexpr int LDS_GEMM = 131072;
constexpr int LDS_MISC = LDS_GEMM;
constexpr int LDS_BYTES = LDS_GEMM + 8192;

__device__ __forceinline__ int lds_off(int row, int chunk) { return row * 128 + ((chunk ^ (((row >> 1) & 7) ^ ((row >> 4) & 1))) << 4); }

struct GemmCtx { int tid, lane, wid, wr, wc, fr, fq; };
__device__ __forceinline__ GemmCtx make_ctx() {
    GemmCtx c; int t = threadIdx.x; asm volatile("" : "+v"(t));
    c.tid = t; c.lane = c.tid & 63; c.wid = __builtin_amdgcn_readfirstlane(c.tid >> 6);
    c.wr = c.wid >> 1; c.wc = c.wid & 1; c.fr = c.lane & 15; c.fq = c.lane >> 4; return c;
}

__device__ __forceinline__ int a_chunk_off(int tid) { const int r = tid >> 3; return (((tid & 7) ^ (((r >> 1) & 7) ^ ((r >> 4) & 1))) << 3); }
template <int ABL = 0> __device__ __forceinline__ void gemm_tile_f32w(LAS unsigned char* lds, const GemmCtx& c, const bf16_t* Abase, const unsigned (&aoff)[4], const float* Bbase, unsigned boff0,
                                               int brow0, int bkg, int ldw, int nk, f32x4 (&acc)[4][8]) {
#pragma unroll
    for (int mi = 0; mi < 4; ++mi)
#pragma unroll
        for (int ni = 0; ni < 8; ++ni) acc[mi][ni] = (f32x4){0.f, 0.f, 0.f, 0.f};
    LAS unsigned char* bw0 = lds + 65536 + lds_off(brow0, bkg);
    LAS unsigned char* bw2 = lds + 65536 + lds_off(brow0 + 2, bkg);
    typedef const __attribute__((address_space(1))) f32x4* gf4p;
    const __attribute__((address_space(1))) char* Bg = (const __attribute__((address_space(1))) char*)Bbase;
    const __attribute__((address_space(1))) char* Ag = (const __attribute__((address_space(1))) char*)Abase;
    const int x0 = c.fq ^ (c.fr >> 1);
    int foff[2][2];
#pragma unroll
    for (int par = 0; par < 2; ++par)
#pragma unroll
        for (int k32 = 0; k32 < 2; ++k32) foff[par][k32] = c.fr * 128 + ((x0 ^ (k32 * 4 + par)) << 4);
    const int abase = (c.wr * 64) * 128, bbase = 65536 + (c.wc * 128) * 128;
    LAS unsigned char* adst = lds + c.tid * 16;
    const unsigned ldw4 = (unsigned)ldw * 4u;

    f32x4 rb[8];
    auto gload = [&](int kt, int buf) {
#pragma unroll
        for (int i = 0; i < 4; ++i)
            if (ABL != 3) __builtin_amdgcn_global_load_lds((const __attribute__((address_space(1))) unsigned*)(Ag + (size_t)((aoff[i] + (unsigned)kt * 64u) * 2u)), (LAS unsigned*)(adst + buf * 32768 + i * 8192), 16, 0, 0);
        const unsigned vo = boff0 * 4u;
#pragma unroll
        for (int j = 0; j < 8; ++j) { if (ABL != 2) rb[j] = *(gf4p)((Bg + (size_t)((unsigned)(kt * 64 + j) * ldw4)) + (size_t)vo); else rb[j] = (f32x4){1.f, 2.f, 3.f, (float)kt}; }
    };
    auto lstore = [&](int buf) {
#pragma unroll
        for (int i = 0; i < 4; ++i) {
            u32x4 w; w[0] = pk2(rb[0][i], rb[1][i]); w[1] = pk2(rb[2][i], rb[3][i]); w[2] = pk2(rb[4][i], rb[5][i]); w[3] = pk2(rb[6][i], rb[7][i]);
            *(LAS u32x4*)((i < 2 ? bw0 : bw2) + buf * 32768 + (i & 1) * 128) = w;
        }
    };
    gload(0, 0); lstore(0);
    asm volatile("s_waitcnt vmcnt(0)" ::: "memory");
    __syncthreads();
    for (int kt = 0; kt < nk; ++kt) {
        const int cur = kt & 1;
        if (kt + 1 < nk) gload(kt + 1, cur ^ 1);
#pragma unroll
        for (int k32 = 0; k32 < 2; ++k32) {
            bf16x8 af[4];
#pragma unroll
            for (int mi = 0; mi < 4; ++mi) af[mi] = *(const LAS bf16x8*)(lds + cur * 32768 + abase + mi * 2048 + foff[mi & 1][k32]);
#pragma unroll
            for (int ni = 0; ni < 8; ++ni) {
                const bf16x8 bfr = *(const LAS bf16x8*)(lds + cur * 32768 + bbase + ni * 2048 + foff[ni & 1][k32]);
#pragma unroll
                for (int mi = 0; mi < 4; ++mi) { if (ABL != 1) acc[mi][ni] = __builtin_amdgcn_mfma_f32_16x16x32_bf16(bfr, af[mi], acc[mi][ni], 0, 0, 0); else { acc[mi][ni][0] += __builtin_bit_cast(float, (int)bfr[0]) ; acc[mi][ni][1] += __builtin_bit_cast(float, (int)af[mi][0]); } }
            }
        }
        if (kt + 1 < nk) lstore(cur ^ 1);
        asm volatile("s_waitcnt vmcnt(0)" ::: "memory");
        __syncthreads();
    }
}

__device__ __forceinline__ void gemm_tile_bf16(LAS unsigned char* lds, const GemmCtx& c, const bf16_t* Abase, unsigned aoff0, unsigned aoff1, const bf16_t* Bbase, unsigned boff0, unsigned boff1,
                                               int nk, f32x4 (&acc)[4][8], unsigned bstage = 32u, unsigned astage = 32u,
                                               bool pre = false, bool nxt = false, const bf16_t* An = nullptr, unsigned na0 = 0u, unsigned nb0 = 0u) {
#pragma unroll
    for (int mi = 0; mi < 4; ++mi)
#pragma unroll
        for (int ni = 0; ni < 8; ++ni) acc[mi][ni] = (f32x4){0.f, 0.f, 0.f, 0.f};
    typedef const __attribute__((address_space(1))) unsigned* gu32p;
    const __attribute__((address_space(1))) char* Ag = (const __attribute__((address_space(1))) char*)Abase;
    const __attribute__((address_space(1))) char* Bg = (const __attribute__((address_space(1))) char*)Bbase;
    LAS unsigned char* dst = lds + c.tid * 16;
    const int fo = c.fr * 64 + ((c.fq ^ ((0 - (c.fr >> 2)) & 3)) << 4);
    LAS unsigned char* fa = lds + c.wr * 4096 + fo;
    LAS unsigned char* fb = lds + 16384 + c.wc * 8192 + fo;
    auto issue = [&](int kt) {
        const int st = (kt & 3) * 32768;
        const unsigned ko = (unsigned)kt * astage, kb = (unsigned)kt * bstage;
        __builtin_amdgcn_global_load_lds((gu32p)(Ag + (size_t)((aoff0 + ko) * 2u)), (LAS unsigned*)(dst + st), 16, 0, 0);
        __builtin_amdgcn_global_load_lds((gu32p)(Ag + (size_t)((aoff1 + ko) * 2u)), (LAS unsigned*)(dst + st + 8192), 16, 0, 0);
        __builtin_amdgcn_global_load_lds((gu32p)(Bg + (size_t)((boff0 + kb) * 2u)), (LAS unsigned*)(dst + st + 16384), 16, 0, 0);
        __builtin_amdgcn_global_load_lds((gu32p)(Bg + (size_t)((boff1 + kb) * 2u)), (LAS unsigned*)(dst + st + 16384 + 8192), 16, 0, 0);
    };
#define RING_BAR() do { __builtin_amdgcn_sched_barrier(0); __builtin_amdgcn_s_barrier(); __builtin_amdgcn_sched_barrier(0); asm volatile("" ::: "memory"); } while (0)
    const bool g1 = c.wid >= 4;
    if (!pre) { issue(0); issue(1); issue(2); }
    asm volatile("s_waitcnt vmcnt(8)" ::: "memory");
    RING_BAR();
    if (g1) RING_BAR();
    for (int s = 0; s < nk; ++s) {
        const int st = (s & 3) * 32768;
        bf16x8 af[4], bfv[8];
#pragma unroll
        for (int mi = 0; mi < 4; ++mi) af[mi] = *(const LAS bf16x8*)(fa + st + mi * 1024);
#pragma unroll
        for (int ni = 0; ni < 8; ++ni) bfv[ni] = *(const LAS bf16x8*)(fb + st + ni * 1024);
        __builtin_amdgcn_sched_barrier(0);
        if (s + 3 < nk) issue(s + 3);
        if (g1) {
            if (s <= nk - 4) asm volatile("s_waitcnt vmcnt(8)" ::: "memory");
            else if (s == nk - 3) asm volatile("s_waitcnt vmcnt(4)" ::: "memory");
            else if (s == nk - 2) asm volatile("s_waitcnt vmcnt(0)" ::: "memory");
        }
        __builtin_amdgcn_s_waitcnt(0xC07F);
        RING_BAR();
#pragma unroll
        for (int ni = 0; ni < 8; ++ni)
#pragma unroll
            for (int mi = 0; mi < 4; ++mi) acc[mi][ni] = __builtin_amdgcn_mfma_f32_16x16x32_bf16(bfv[ni], af[mi], acc[mi][ni], 0, 0, 0);
        if (!g1) {
            if (s <= nk - 4) asm volatile("s_waitcnt vmcnt(8)" ::: "memory");
            else if (s == nk - 3) asm volatile("s_waitcnt vmcnt(4)" ::: "memory");
            else if (s == nk - 2) asm volatile("s_waitcnt vmcnt(0)" ::: "memory");
        }
        RING_BAR();
    }
    if (!g1) RING_BAR();
    if (nxt) {
        const __attribute__((address_space(1))) char* Ang = (const __attribute__((address_space(1))) char*)An;
#pragma unroll
        for (int kt = 0; kt < 3; ++kt) {
            const int st = kt * 32768;
            const unsigned ko = (unsigned)kt * astage, kb = (unsigned)kt * bstage;
            __builtin_amdgcn_global_load_lds((gu32p)(Ang + (size_t)((na0 + ko) * 2u)), (LAS unsigned*)(dst + st), 16, 0, 0);
            __builtin_amdgcn_global_load_lds((gu32p)(Ang + (size_t)((na0 + 4096u + ko) * 2u)), (LAS unsigned*)(dst + st + 8192), 16, 0, 0);
            __builtin_amdgcn_global_load_lds((gu32p)(Bg + (size_t)((nb0 + kb) * 2u)), (LAS unsigned*)(dst + st + 16384), 16, 0, 0);
            __builtin_amdgcn_global_load_lds((gu32p)(Bg + (size_t)((nb0 + 4096u + kb) * 2u)), (LAS unsigned*)(dst + st + 16384 + 8192), 16, 0, 0);
        }
    }
#undef RING_BAR
}
__device__ __forceinline__ unsigned ring_off(int tid, int row0, int ld) {
    return (unsigned)((row0 + (tid >> 2)) * ld + ((((tid & 3) ^ ((0 - (tid >> 4)) & 3))) << 3));
}

template <bool CONVIN = false> __device__ __forceinline__ void convert_wt(LAS unsigned char* lds, const GemmCtx& c, const float* __restrict__ W, int N, bf16_t* WT, const float* gk = nullptr) {
    LAS float* tile = (LAS float*)lds;
    const int ntn = N / 64, ntiles = (DM / 64) * ntn;
    for (int t = blockIdx.x; t < ntiles; t += gridDim.x) {
        const int kt = t / ntn, nt = t % ntn;
        __syncthreads();
#pragma unroll
        for (int i = 0; i < 2; ++i) {
            const int idx = i * 512 + c.tid, kr = idx >> 4, c4 = (idx & 15) * 4;
            f32x4 v = *(const f32x4*)(W + (size_t)(kt * 64 + kr) * N + nt * 64 + c4);
            if (gk) { const float gg = gk[kt * 64 + kr]; v[0] *= gg; v[1] *= gg; v[2] *= gg; v[3] *= gg; }
            tile[kr * 65 + c4] = v[0]; tile[kr * 65 + c4 + 1] = v[1]; tile[kr * 65 + c4 + 2] = v[2]; tile[kr * 65 + c4 + 3] = v[3];
        }
        __syncthreads();
        {
            const int n = c.tid >> 3, k8 = (c.tid & 7) * 8;
            u32x4 o;
#pragma unroll
            for (int q = 0; q < 4; ++q) o[q] = pk2(tile[(k8 + 2 * q) * 65 + n], tile[(k8 + 2 * q + 1) * 65 + n]);
            {
                int nrow = nt * 64 + n;
                if (CONVIN && nrow >= 2048) {
                    const int which = (nrow - 2048) >> 11, ch = (nrow - 2048) & 2047, hd = ch & 127;
                    nrow = 2048 + (ch >> 7) * 256 + (hd >> 6) * 128 + (2 * ((hd >> 4) & 3) + which) * 16 + (hd & 15);
                }
                const int pn = nrow >> 8, r = nrow & 255, kk = kt * 64 + k8, j = kk >> 5, lc = (kk & 31) >> 3;
                *(u32x4*)(WT + ((size_t)(pn * 64 + j) * 8192) + (r * 64 + ((lc ^ ((0 - (r >> 2)) & 3)) << 4)) / 2) = o;
            }
        }
    }
}

struct MegaArgs {
    const float* x; const float* mix_norm; const float* ffn_norm; const float* conv_w_in; const float* conv_w; const float* conv_w_out;
    const float* kv_norm; const float* w_kv; const float* k_norm; const float* w_q; const float* q_norm; const float* w_o;
    const float* router_group; const float* router_expert; const float* w_gate; const float* w_up; const float* w_down;
    float* H; unsigned char* ws; int ph_lo, ph_hi;
};
enum { PH_PREP = 0, PH_GEMM1 = 1, PH_CONV = 2, PH_GEMM2 = 3, PH_ROUTER0 = 4, PH_MOEA0 = 5, PH_MOEB0 = 6, PH_COMBINE0 = 7, PH_GEMM3 = 8, PH_ATTN = 9, PH_GEMM4 = 10,
       PH_ROUTER1 = 11, PH_MOEA1 = 12, PH_MOEB1 = 13, PH_COMBINE1 = 14, PH_END = 15 };

__device__ __forceinline__ int vblock(LAS unsigned char* lds) {
    volatile LAS unsigned* bst = (volatile LAS unsigned*)(lds + LDS_MISC + 8160);
    const unsigned v = bst[2], ok = bst[3];
    const int b = blockIdx.x;
    return __builtin_amdgcn_readfirstlane((ok && v < 256u) ? (int)v : ((b & 7) * 32 + (b >> 3)));
}
__device__ __forceinline__ bool dense_tile(LAS unsigned char* lds, int it, int ntn, int& pm, int& pn) {
    const int b = blockIdx.x, G = gridDim.x;
    const int t = it * G + b;
    if (G != 256) { if (t >= 32 * ntn) return false; pm = t % 32; pn = t / 32; return true; }
    const int r = it; if (r * 8 >= ntn) return false;
    const int vb = vblock(lds); const int x = vb >> 5, j = vb & 31; pm = 4 * x + (j & 3); pn = 8 * r + (j >> 2); return true;
}

template <int RMODE> __device__ __forceinline__ void phase_gemm_resid(LAS unsigned char* lds, const GemmCtx& c, const bf16_t* A, const bf16_t* WT, const void* R, bf16_t* HB, const float* rsc = nullptr) {
    int pm, pn; bool have = dense_tile(lds, 0, DM / 256, pm, pn), pre = false;
    for (int it = 0; have; ++it) {
        int npm = 0, npn = 0; const bool hn = dense_tile(lds, it + 1, DM / 256, npm, npn);
        f32x4 acc[4][8];
        gemm_tile_bf16(lds, c, A, (unsigned)(pm * 64 * 8192 + c.tid * 8), (unsigned)(pm * 64 * 8192 + 4096 + c.tid * 8), WT, (unsigned)(pn * 64 * 8192 + c.tid * 8), (unsigned)(pn * 64 * 8192 + 4096 + c.tid * 8), DM / 32, acc, 8192u, 8192u,
                       pre, hn, A, (unsigned)(npm * 64 * 8192 + c.tid * 8), (unsigned)(npn * 64 * 8192 + c.tid * 8));
#pragma unroll
        for (int mi = 0; mi < 4; ++mi) {
            const size_t row = (size_t)pm * 256 + c.wr * 64 + mi * 16 + c.fr;
            float sc = 1.f;
            if (RMODE == 2) sc = rsc[row];
#pragma unroll
            for (int ni = 0; ni < 8; ++ni) {
                const size_t idx = row * DM + pn * 256 + c.wc * 128 + ni * 16 + c.fq * 4;
                f32x4 r;
                if (RMODE == 2) { const uint2 h = *(const uint2*)((const bf16_t*)R + stg_off((int)row, pn * 256 + c.wc * 128 + ni * 16 + c.fq * 4)); r[0] = bflo(h.x) * sc; r[1] = bfhi(h.x) * sc; r[2] = bflo(h.y) * sc; r[3] = bfhi(h.y) * sc; }
                else r = *(const f32x4*)((const float*)R + idx);
                r = r + acc[mi][ni];
                uint2 o; o.x = pk2(r[0], r[1]); o.y = pk2(r[2], r[3]);
                *(uint2*)(HB + idx) = o;
            }
        }
        pm = npm; pn = npn; have = hn; pre = hn;
    }
}

__device__ __forceinline__ void phase_gemm1(LAS unsigned char* lds, const GemmCtx& c, const bf16_t* A, const bf16_t* WT, bf16_t* O) {
    int pm, pn; bool have = dense_tile(lds, 0, 6144 / 256, pm, pn), pre = false;
    for (int it = 0; have; ++it) {
        int npm = 0, npn = 0; const bool hn = dense_tile(lds, it + 1, 6144 / 256, npm, npn);
        f32x4 acc[4][8];
        const int lpm = pm, lpn = pn;
        gemm_tile_bf16(lds, c, A, (unsigned)(lpm * 64 * 8192 + c.tid * 8), (unsigned)(lpm * 64 * 8192 + 4096 + c.tid * 8), WT, (unsigned)(lpn * 64 * 8192 + c.tid * 8), (unsigned)(lpn * 64 * 8192 + 4096 + c.tid * 8), DM / 32, acc, 8192u, 8192u,
                       pre, hn, A, (unsigned)(npm * 64 * 8192 + c.tid * 8), (unsigned)(npn * 64 * 8192 + c.tid * 8));
#pragma unroll
        for (int mi = 0; mi < 4; ++mi) {
            const size_t row = (size_t)pm * 256 + c.wr * 64 + mi * 16 + c.fr;
            if (pn < 8) {
#pragma unroll
                for (int ni = 0; ni < 8; ++ni) {
                    uint2 o; o.x = pk2(acc[mi][ni][0], acc[mi][ni][1]); o.y = pk2(acc[mi][ni][2], acc[mi][ni][3]);
                    *(uint2*)(O + row * DM + pn * 256 + c.wc * 128 + ni * 16 + c.fq * 4) = o;
                }
            } else {
                bf16_t* U = O + (size_t)NTOK * DM;
#pragma unroll
                for (int p = 0; p < 4; ++p) {
                    uint2 o; o.x = pk2(acc[mi][2 * p][0] * acc[mi][2 * p + 1][0], acc[mi][2 * p][1] * acc[mi][2 * p + 1][1]);
                    o.y = pk2(acc[mi][2 * p][2] * acc[mi][2 * p + 1][2], acc[mi][2 * p][3] * acc[mi][2 * p + 1][3]);
                    *(uint2*)(U + row * DM + (pn - 8) * 128 + c.wc * 64 + p * 16 + c.fq * 4) = o;
                }
            }
        }
        pm = npm; pn = npn; have = hn; pre = hn;
    }
}

__device__ __forceinline__ void phase_gemm3(LAS unsigned char* lds, const GemmCtx& c, const bf16_t* AKV, const bf16_t* AQ, const bf16_t* WT,
                                            const float* kn, const float* qn, bf16_t* Kb, bf16_t* Vb, bf16_t* Qb, float* KM) {
    int pm, pn; bool have = dense_tile(lds, 0, 24, pm, pn), pre = false;
    for (int it = 0; have; ++it) {
        int npm = 0, npn = 0; const bool hn = dense_tile(lds, it + 1, 24, npm, npn);
        const bool isq = pn >= 16;
        const bf16_t* A = isq ? AQ : AKV;
        f32x4 acc[4][8];
        gemm_tile_bf16(lds, c, A, (unsigned)(pm * 64 * 8192 + c.tid * 8), (unsigned)(pm * 64 * 8192 + 4096 + c.tid * 8), WT, (unsigned)(pn * 64 * 8192 + c.tid * 8), (unsigned)(pn * 64 * 8192 + 4096 + c.tid * 8), DM / 32, acc, 8192u, 8192u,
                       pre, hn, (npn >= 16) ? AQ : AKV, (unsigned)(npm * 64 * 8192 + c.tid * 8), (unsigned)(npn * 64 * 8192 + c.tid * 8));
        const int which = pn >> 3;
        const int head = (pn & 7) * 2 + c.wc;
        bf16_t* dst = which == 0 ? Kb : (which == 1 ? Vb : Qb);
        const float* gn = which == 0 ? kn : qn;
        float colsum[8][4];
#pragma unroll
        for (int ni = 0; ni < 8; ++ni)
#pragma unroll
            for (int e = 0; e < 4; ++e) colsum[ni][e] = 0.f;
#pragma unroll
        for (int mi = 0; mi < 4; ++mi) {
            const int tok = pm * 256 + c.wr * 64 + mi * 16 + c.fr;
            const int b = tok >> 11, sq = tok & 2047;
            float r = 1.f;
            if (which != 1) {
                float ss = 0.f;
#pragma unroll
                for (int ni = 0; ni < 8; ++ni)
#pragma unroll
                    for (int e = 0; e < 4; ++e) ss += acc[mi][ni][e] * acc[mi][ni][e];
                ss += __shfl_xor(ss, 16); ss += __shfl_xor(ss, 32);
                r = rsqrtf(ss * (1.0f / HD) + EPS);
            }
            bf16_t* orow = dst + ((size_t)(b * NH + head) * SEQ + sq) * HD + c.fq * 4;
#pragma unroll
            for (int ni = 0; ni < 8; ++ni) {
                f32x4 v = acc[mi][ni];
                if (which != 1) { const f32x4 g = *(const f32x4*)(gn + ni * 16 + c.fq * 4); v[0] = v[0] * r * g[0]; v[1] = v[1] * r * g[1]; v[2] = v[2] * r * g[2]; v[3] = v[3] * r * g[3]; }
                if (which == 0) {
#pragma unroll
                    for (int e = 0; e < 4; ++e) colsum[ni][e] += v[e];
                }
                uint2 o; o.x = pk2(v[0], v[1]); o.y = pk2(v[2], v[3]);
                *(uint2*)(orow + ni * 16) = o;
            }
        }
        if (which == 0) {
            LAS float* red = (LAS float*)(lds + LDS_MISC);
#pragma unroll
            for (int ni = 0; ni < 8; ++ni)
#pragma unroll
                for (int e = 0; e < 4; ++e) {
                    float v = colsum[ni][e];
                    v += __shfl_xor(v, 1); v += __shfl_xor(v, 2); v += __shfl_xor(v, 4); v += __shfl_xor(v, 8);
                    if (c.fr == 0) red[(c.wr * 2 + c.wc) * 128 + ni * 16 + c.fq * 4 + e] = v;
                }
            __syncthreads();
            if (c.tid < 256) {
                const int wc2 = c.tid >> 7, d = c.tid & 127;
                const float sum = ((red[(0 * 2 + wc2) * 128 + d] + red[(1 * 2 + wc2) * 128 + d]) + red[(2 * 2 + wc2) * 128 + d]) + red[(3 * 2 + wc2) * 128 + d];
                const int hd2 = (pn & 7) * 2 + wc2, b = pm >> 3, blk = pm & 7;
                KM[((size_t)(b * NH + hd2) * NBLK + blk) * HD + d] = sum * (1.0f / BLK);
            }
            __syncthreads();
        }
        pm = npm; pn = npn; have = hn; pre = hn;
    }
}

template <int OFF> __device__ __forceinline__ unsigned long long karg64() {
    unsigned long long v; auto k = __builtin_amdgcn_kernarg_segment_ptr();
    asm volatile("s_load_dwordx2 %0, %1, %2\n\ts_waitcnt lgkmcnt(0)" : "=s"(v) : "s"(k), "i"(OFF) : "memory");
    return v;
}
#define ARG(field) ((decltype(MegaArgs::field))karg64<offsetof(MegaArgs, field)>())
#define WSP(T, off) ((T*)((unsigned char*)ARG(ws) + (off)))

__device__ __forceinline__ void moe_counts(LAS int* misc, const GemmCtx& c, const int* toke) {
    if (c.tid < 32) misc[c.tid] = 0;
    __syncthreads();
    typedef int i32x4 __attribute__((ext_vector_type(4)));
    const i32x4* tp = (const i32x4*)(toke + c.tid * 32);
#pragma unroll
    for (int i = 0; i < 8; ++i) {
        const i32x4 v = tp[i];
        atomicAdd((int*)&misc[v[0]], 1); atomicAdd((int*)&misc[v[1]], 1); atomicAdd((int*)&misc[v[2]], 1); atomicAdd((int*)&misc[v[3]], 1);
    }
    __syncthreads();
    if (c.tid == 0) { int acc = 0; for (int e = 0; e < NE; ++e) { misc[32 + e] = acc; acc += (misc[e] + 255) >> 8; } misc[32 + NE] = acc; }
    __syncthreads();
}
__device__ __forceinline__ void moe_rowlist(LAS int* misc, const GemmCtx& c, const int* toke, int e, int mt) {
    __syncthreads();
    typedef int i32x4 __attribute__((ext_vector_type(4)));
    int tb = c.tid * 32; asm volatile("" : "+v"(tb));
    const i32x4* tp = (const i32x4*)(toke + tb);
    i32x4 ent[8];
#pragma unroll
    for (int i = 0; i < 8; ++i) ent[i] = tp[i];
    int cntm = 0;
#pragma unroll
    for (int i = 0; i < 8; ++i) cntm += (ent[i][0] == e) + (ent[i][1] == e) + (ent[i][2] == e) + (ent[i][3] == e);
    int incl = cntm;
#pragma unroll
    for (int o = 1; o < 64; o <<= 1) { const int t = __shfl_up(incl, o); if (c.lane >= o) incl += t; }
    if (c.lane == 63) misc[128 + c.wid] = incl;
    if (c.tid < 256) misc[1024 + c.tid] = -1;
    __syncthreads();
    int base = 0;
#pragma unroll
    for (int w = 0; w < 8; ++w) base += (w < c.wid) ? misc[128 + w] : 0;
    int pos = base + incl - cntm - mt * 256;
    if (cntm > 0 && pos < 256 && pos + cntm > 0) {
#pragma unroll
        for (int i = 0; i < 8; ++i)
#pragma unroll
            for (int q = 0; q < 4; ++q) if (ent[i][q] == e) { if (pos >= 0 && pos < 256) misc[1024 + pos] = tb + 4 * i + q; ++pos; }
    }
    __syncthreads();
}
__device__ __forceinline__ bool moe_tile(LAS int* misc, int it, int ntn, int& e, int& mt, int& nt) {
    const int b = blockIdx.x, G = gridDim.x;
    const int t = (G == 256) ? it * 256 + (b & 7) * 32 + (b >> 3) : it * G + b;
    const int total = misc[32 + NE] * ntn;
    if (t >= total) return false;
    const int g = t / ntn; nt = t % ntn;
    int ee = 0;
#pragma unroll
    for (int q = 1; q < NE; ++q) ee += (misc[32 + q] <= g);
    e = ee; mt = g - misc[32 + ee]; return true;
}

__device__ __forceinline__ unsigned xb_ld(unsigned* p);
__device__ __forceinline__ unsigned xb_add(unsigned* p, unsigned v);
#define MOE_CNT_WORD(layer, g) (3584 + (layer) * 128 + (g))
__device__ __forceinline__ bool moe_item(LAS int* misc, int g_total, int it, int& isb, int& g, int& nt) {
    const int b = blockIdx.x, G = gridDim.x;
    const int TA = g_total * 4, TB = g_total * 8;
    if (G != 256 || TA > 512 || TA < 256) {
        const int t = it * G + b;
        if (t >= TA + TB) return false;
        if (t < TA) { isb = 0; g = t >> 2; nt = t & 3; } else { isb = 1; g = (t - TA) >> 3; nt = (t - TA) & 7; }
        return true;
    }
    const int vb = vblock((LAS unsigned char*)misc - LDS_MISC);
    const int nA2 = TA - 256, nl = 256 - nA2;
    const bool heavy = vb < nA2;
    if (it == 0) { isb = 0; g = vb >> 2; nt = vb & 3; return true; }
    int slot = it - 1;
    if (heavy) { if (slot == 0) { const int t = 256 + vb; isb = 0; g = t >> 2; nt = t & 3; return true; } slot -= 1; }
    int i;
    if (heavy) i = 2 * nl + slot * 256 + nl + vb;
    else i = (slot < 2) ? slot * nl + (vb - nA2) : 2 * nl + (slot - 2) * 256 + (vb - nA2);
    if (i >= TB) return false;
    isb = 1; g = i >> 3; nt = i & 7; return true;
}
__device__ __forceinline__ void moe_g2emt(LAS int* misc, int g, int& e, int& mt) {
    int ee = 0;
#pragma unroll
    for (int q = 1; q < NE; ++q) ee += (misc[32 + q] <= g);
    e = __builtin_amdgcn_readfirstlane(ee); mt = __builtin_amdgcn_readfirstlane(g - misc[32 + ee]);
}
__device__ __forceinline__ void phase_moe(LAS unsigned char* lds, const GemmCtx& c, int layer) {
    LAS int* misc = (LAS int*)(lds + LDS_MISC);
    moe_counts(misc, c, WSP(int, WS_TOKE) + layer * 2 * NTOK);
    const int g_total = __builtin_amdgcn_readfirstlane(misc[32 + NE]);
    const int total_it = (g_total * 12 + gridDim.x - 1) / gridDim.x + 3;
    for (int it = 0; it < total_it; ++it) {
        int isb, g, nt; if (!moe_item(misc, g_total, it, isb, g, nt)) continue;
        isb = __builtin_amdgcn_readfirstlane(isb); g = __builtin_amdgcn_readfirstlane(g); nt = __builtin_amdgcn_readfirstlane(nt);
        int e, mt; moe_g2emt(misc, g, e, mt);
        moe_rowlist(misc, c, WSP(int, WS_TOKE) + layer * 2 * NTOK, e, mt);
        f32x4 acc[4][8];
        if (!isb) {
            {
                unsigned ao[4];
#pragma unroll
                for (int i = 0; i < 4; ++i) { const int sr = misc[1024 + (c.tid >> 3) + 64 * i]; ao[i] = (unsigned)((sr < 0 ? 0 : (sr >> 1)) * DM + a_chunk_off(c.tid)); }
                const int mat = c.wid & 1, bkg = (c.wid >> 1) * 2 + (c.lane >> 5), cgm = c.lane & 31;
                const int brow0 = (cgm >> 4) * 128 + (2 * ((cgm >> 2) & 3) + mat) * 16 + (cgm & 3) * 4;
                const float* Wb = (mat ? ARG(w_up) : ARG(w_gate)) + (size_t)(layer * NE + e) * DM * DE + nt * 128;
                gemm_tile_f32w(lds, c, WSP(bf16_t, WS_A1), ao, Wb, (unsigned)((bkg * 8) * DE + 4 * cgm), brow0, bkg, DE, DM / 64, acc);
            }
            bf16_t* ACT = WSP(bf16_t, WS_ACT);
            const float* tokr = WSP(float, WS_TOKR) + layer * NTOK;
#pragma unroll
            for (int mi = 0; mi < 4; ++mi) {
                const int sr = misc[1024 + c.wr * 64 + mi * 16 + c.fr];
                if (sr >= 0) {
                    const float rs = tokr[sr >> 1];
                    bf16_t* orow = ACT + (size_t)sr * DE + nt * 128 + c.wc * 64 + c.fq * 4;
#pragma unroll
                    for (int p = 0; p < 4; ++p) {
                        float a[4];
#pragma unroll
                        for (int q = 0; q < 4; ++q) { const float gv = acc[mi][2 * p][q] * rs; a[q] = gv / (1.0f + __expf(-gv)) * (acc[mi][2 * p + 1][q] * rs); }
                        uint2 o; o.x = pk2(a[0], a[1]); o.y = pk2(a[2], a[3]);
                        *(uint2*)(orow + p * 16) = o;
                    }
                }
            }
            asm volatile("s_waitcnt vmcnt(0)" ::: "memory");
            __syncthreads();
            if (c.tid == 0) {
                __builtin_amdgcn_fence(__ATOMIC_RELEASE, "agent");
                asm volatile("s_waitcnt vmcnt(0)" ::: "memory");
                (void)xb_add((unsigned*)ARG(ws) + MOE_CNT_WORD(layer, g), 1u);
            }
        } else {
            if (c.tid == 0) {
                unsigned* cw = (unsigned*)ARG(ws) + MOE_CNT_WORD(layer, g);
                unsigned sp = 0;
                while (xb_ld(cw) < 4u) { __builtin_amdgcn_s_sleep(2); if (++sp > (1u << 22)) break; }
                __builtin_amdgcn_fence(__ATOMIC_ACQUIRE, "agent");
                asm volatile("s_waitcnt vmcnt(0)" ::: "memory");
            }
            __syncthreads();
            {
                unsigned ao[4];
#pragma unroll
                for (int i = 0; i < 4; ++i) { const int sr = misc[1024 + (c.tid >> 3) + 64 * i]; ao[i] = (unsigned)((sr < 0 ? 0 : sr) * DE + a_chunk_off(c.tid)); }
                const float* Wb = ARG(w_down) + (size_t)(layer * NE + e) * DE * DM + nt * 256;
                gemm_tile_f32w(lds, c, WSP(bf16_t, WS_ACT), ao, Wb, (unsigned)((c.wid * 8) * DM + 4 * c.lane), 4 * c.lane, c.wid, DM, DE / 64, acc);
            }
            bf16_t* Y = WSP(bf16_t, WS_Y);
            const float* tokw = WSP(float, WS_TOKW) + layer * 2 * NTOK;
#pragma unroll
            for (int mi = 0; mi < 4; ++mi) {
                const int sr = misc[1024 + c.wr * 64 + mi * 16 + c.fr];
                if (sr >= 0) {
                    const float w = tokw[sr];
                    bf16_t* orow = Y + (size_t)sr * DM + nt * 256 + c.wc * 128 + c.fq * 4;
#pragma unroll
                    for (int ni = 0; ni < 8; ++ni) {
                        uint2 o; o.x = pk2(acc[mi][ni][0] * w, acc[mi][ni][1] * w); o.y = pk2(acc[mi][ni][2] * w, acc[mi][ni][3] * w);
                        *(uint2*)(orow + ni * 16) = o;
                    }
                }
            }
        }
    }
}

typedef float f32x16 __attribute__((ext_vector_type(16)));
__device__ __forceinline__ void phase_router(LAS unsigned char* lds, const GemmCtx& c, const bf16_t* __restrict__ HB, const float* __restrict__ g,
                                             const float* __restrict__ wrg, const float* __restrict__ wre, bf16_t* AF, int* toke, float* tokw, float* tokr) {
    LAS float* RR = (LAS float*)lds;
    LAS float* YCH = RR + 64;
    LAS float* WRE = YCH + 32 * 260;
    LAS float* WRG = WRE + 256 * 32;
    LAS float* PLOG = WRG + 256 * 4;
    LAS float* PG = PLOG + 8 * 32 * 32;
    for (int tg = blockIdx.x; tg < NTOK / 32; tg += gridDim.x) {
        const int tok0 = tg * 32;
        __syncthreads();
        f32x16 accl;
#pragma unroll
        for (int i = 0; i < 16; ++i) accl[i] = 0.f;
        float accg[4] = {0.f, 0.f, 0.f, 0.f};
        const int ltok = c.tid >> 4, lq = c.tid & 15;
        float ss = 0.f;
        uint2 hbr[1][4]; f32x4 ggr[1][4], wer[1][4], wgr[1];
        auto ldchunk = [&](int kc, int sl) {
#pragma unroll
            for (int j = 0; j < 4; ++j) {
                const int k = kc * 256 + lq * 4 + 64 * j;
                hbr[sl][j] = *(const uint2*)(HB + (size_t)(tok0 + ltok) * DM + k);
                ggr[sl][j] = *(const f32x4*)(g + k);
                wer[sl][j] = *(const f32x4*)(wre + (size_t)kc * 256 * 32 + (c.tid + 512 * j) * 4);
            }
            if (c.tid < 256) wgr[sl] = *(const f32x4*)(wrg + (size_t)kc * 256 * 4 + c.tid * 4);
        };
        ldchunk(0, 0);
        auto chunk = [&](int kc, const int sl) {
#pragma unroll
            for (int j = 0; j < 4; ++j) {
                const int kl = lq * 4 + 64 * j, k = kc * 256 + kl;
                const uint2 hb = hbr[sl][j];
                const f32x4 h = (f32x4){bflo(hb.x), bfhi(hb.x), bflo(hb.y), bfhi(hb.y)};
                ss += h[0] * h[0] + h[1] * h[1] + h[2] * h[2] + h[3] * h[3];
                const f32x4 gg = ggr[sl][j];
                f32x4 y; y[0] = h[0] * gg[0]; y[1] = h[1] * gg[1]; y[2] = h[2] * gg[2]; y[3] = h[3] * gg[3];
                uint2 o; o.x = pk2(y[0], y[1]); o.y = pk2(y[2], y[3]);
                *(uint2*)(AF + (size_t)(tok0 + ltok) * DM + k) = o;
                *(LAS f32x4*)(YCH + ltok * 260 + kl) = y;
            }
#pragma unroll
            for (int j = 0; j < 4; ++j) *(LAS f32x4*)(WRE + (c.tid + 512 * j) * 4) = wer[sl][j];
            if (c.tid < 256) *(LAS f32x4*)(WRG + c.tid * 4) = wgr[sl];
            __syncthreads();
            if (kc + 1 < 8) ldchunk(kc + 1, 0);
#pragma unroll
            for (int s2 = 0; s2 < 16; ++s2) {
                const int kk = 32 * c.wid + 2 * s2 + (c.lane >> 5);
                const float av = YCH[(c.lane & 31) * 260 + kk];
                const float bv = WRE[kk * 32 + (c.lane & 31)];
                accl = __builtin_amdgcn_mfma_f32_32x32x2f32(av, bv, accl, 0, 0, 0);
            }
            {
                const int t2 = c.tid & 31, ks = c.tid >> 5;
#pragma unroll
                for (int kk = 0; kk < 16; ++kk) {
                    const float yv = YCH[t2 * 260 + ks * 16 + kk];
                    const f32x4 wv = *(const LAS f32x4*)(WRG + (ks * 16 + kk) * 4);
                    accg[0] += yv * wv[0]; accg[1] += yv * wv[1]; accg[2] += yv * wv[2]; accg[3] += yv * wv[3];
                }
            }
            __syncthreads();
        };
#pragma unroll 1
        for (int kc = 0; kc < 8; ++kc) chunk(kc, 0);
        ss += __shfl_xor(ss, 1); ss += __shfl_xor(ss, 2); ss += __shfl_xor(ss, 4); ss += __shfl_xor(ss, 8);
        if (lq == 0) { const float r = rsqrtf(ss * (1.0f / DM) + EPS); RR[ltok] = r; tokr[tok0 + ltok] = r; }
#pragma unroll
        for (int r = 0; r < 16; ++r) PLOG[(c.wid * 32 + ((r & 3) + 8 * (r >> 2) + 4 * (c.lane >> 5))) * 32 + (c.lane & 31)] = accl[r];
        {
            const int t2 = c.tid & 31, ks = c.tid >> 5;
            *(LAS f32x4*)(PG + (ks * 32 + t2) * 4) = (f32x4){accg[0], accg[1], accg[2], accg[3]};
        }
        __syncthreads();
        if (c.tid < 32) {
            const int t2 = c.tid;
            const float rr = RR[t2];
            float gl[4] = {0.f, 0.f, 0.f, 0.f};
#pragma unroll
            for (int ks = 0; ks < 16; ++ks) { const f32x4 v = *(const LAS f32x4*)(PG + (ks * 32 + t2) * 4); gl[0] += v[0]; gl[1] += v[1]; gl[2] += v[2]; gl[3] += v[3]; }
#pragma unroll
            for (int q = 0; q < 4; ++q) gl[q] *= rr;
            int gs = 0; float gm = gl[0];
#pragma unroll
            for (int q = 1; q < 4; ++q) if (gl[q] > gm) { gm = gl[q]; gs = q; }
            float den = 0.f;
#pragma unroll
            for (int q = 0; q < 4; ++q) den += __expf(gl[q] - gm);
            const float gw = 1.0f / den;
            float el[8];
#pragma unroll
            for (int q = 0; q < 8; ++q) {
                float v = 0.f;
#pragma unroll
                for (int w = 0; w < 8; ++w) v += PLOG[(w * 32 + t2) * 32 + gs * 8 + q];
                el[q] = v * rr;
            }
            int i0 = 0; float t0 = el[0];
#pragma unroll
            for (int q = 1; q < 8; ++q) if (el[q] > t0) { t0 = el[q]; i0 = q; }
            int i1 = -1; float t1 = -INFINITY;
#pragma unroll
            for (int q = 0; q < 8; ++q) if (q != i0 && el[q] > t1) { t1 = el[q]; i1 = q; }
            const float e1 = __expf(t1 - t0);
            const int tok = tok0 + t2;
            tokw[tok * 2] = gw / (1.0f + e1); tokw[tok * 2 + 1] = gw * e1 / (1.0f + e1);
            toke[tok * 2] = gs * 8 + i0; toke[tok * 2 + 1] = gs * 8 + i1;
        }
    }
}

typedef short v4i16_t __attribute__((ext_vector_type(4)));
__device__ __forceinline__ float bfs2f(short v) { return __uint_as_float(((unsigned)(unsigned short)v) << 16); }
__device__ __forceinline__ void attn_unit(LAS unsigned char* lds, const GemmCtx& c, int bh, int qb, const bf16_t* __restrict__ Qb, const bf16_t* __restrict__ Kb,
                                          const bf16_t* __restrict__ Vb, const float* __restrict__ KM, bf16_t* ATT) {
    const int lane = c.lane, w = c.wid, r32 = lane & 31, hh = lane >> 5;
    const int head = bh & 15, b = bh >> 4;
    const float LOG2E = 1.4426950408889634f;
    const float slope2 = exp2f(-8.0f * (float)(head + 1) / (float)NH) * LOG2E;
    const float cs = 0.08838834764831845f * LOG2E;
    const int qrow = qb * 256 + w * 32 + r32;
    bf16x8 qf[8];
    {
        const bf16_t* qp = Qb + ((size_t)bh * SEQ + qrow) * HD + 8 * hh;
#pragma unroll
        for (int ds = 0; ds < 8; ++ds) qf[ds] = *(const bf16x8*)(qp + 16 * ds);
    }
    unsigned sel = 0;
    if (qb > 0) {
        float gate[7];
#pragma unroll
        for (int n = 0; n < 7; ++n) {
            float part = 0.f;
            if (n < qb) {
                const float* km = KM + ((size_t)bh * NBLK + n) * HD + 8 * hh;
#pragma unroll
                for (int ds = 0; ds < 8; ++ds) {
                    const f32x4 k0 = *(const f32x4*)(km + 16 * ds), k1 = *(const f32x4*)(km + 16 * ds + 4);
                    part += bfs2f(qf[ds][0]) * k0[0] + bfs2f(qf[ds][1]) * k0[1] + bfs2f(qf[ds][2]) * k0[2] + bfs2f(qf[ds][3]) * k0[3]
                          + bfs2f(qf[ds][4]) * k1[0] + bfs2f(qf[ds][5]) * k1[1] + bfs2f(qf[ds][6]) * k1[2] + bfs2f(qf[ds][7]) * k1[3];
                }
                part += __shfl_xor(part, 32);
                asm volatile("" : "+v"(part) :: "memory");
            }
            gate[n] = part;
        }
#pragma unroll
        for (int n = 0; n < 7; ++n) {
            int rank = 0;
#pragma unroll
            for (int m2 = 0; m2 < 7; ++m2) if (m2 != n && m2 < qb && (gate[m2] > gate[n] || (gate[m2] == gate[n] && m2 < n))) ++rank;
            if (n < qb && rank < 3) sel |= 1u << n;
        }
    }
    const float hb = slope2 * (float)(4 * hh);
    f32x16 o[4];
#pragma unroll
    for (int db = 0; db < 4; ++db)
#pragma unroll
        for (int r = 0; r < 16; ++r) o[db][r] = 0.f;
    float m = -INFINITY, l = 0.f;
    const int kq = r32 & 15;
    int koff[2];
    koff[0] = r32 * 256; koff[1] = (r32 + 32) * 256;
    const int vq = (lane & 15) >> 2, vp = lane & 3, dhalf = (lane >> 4) & 1;
    int voff[4];
#pragma unroll
    for (int db = 0; db < 4; ++db) voff[db] = 16384 + (4 * hh + vq) * 256 + (((((db ^ vq) << 2) | (dhalf * 2 + (vp >> 1))) << 4)) + (vp & 1) * 8;
    const bf16_t* kbase_g = Kb + (size_t)bh * SEQ * HD;
    const bf16_t* vbase_g = Vb + (size_t)bh * SEQ * HD;
    int ksrc[2], vsrc[2];
#pragma unroll
    for (int i = 0; i < 2; ++i) {
        const int pos = i * 512 + c.tid, row = pos >> 4, pc = pos & 15;
        ksrc[i] = row * HD + ((pc ^ (row & 15)) << 3);
        vsrc[i] = row * HD + ((pc ^ ((row & 3) << 2)) << 3);
    }
    const int ntiles = (qb + 1) * 4;
    auto issue = [&](int t) {
        const int blk = (t < 4) ? qb : (t >> 2) - 1, tt = t & 3, buf = t & 1;
        const size_t g0 = (size_t)(blk * 256 + tt * 64) * HD;
#pragma unroll
        for (int i = 0; i < 2; ++i) {
            __builtin_amdgcn_global_load_lds((const unsigned*)(kbase_g + g0 + ksrc[i]), (LAS unsigned*)(lds + buf * 32768 + (i * 512 + c.tid) * 16), 16, 0, 0);
            __builtin_amdgcn_global_load_lds((const unsigned*)(vbase_g + g0 + vsrc[i]), (LAS unsigned*)(lds + buf * 32768 + 16384 + (i * 512 + c.tid) * 16), 16, 0, 0);
        }
    };
    __syncthreads();
    issue(0);
    asm volatile("s_waitcnt vmcnt(0)" ::: "memory");
    __syncthreads();
    for (int t = 0; t < ntiles; ++t) {
        if (t + 1 < ntiles) issue(t + 1);
        const int blk = (t < 4) ? qb : (t >> 2) - 1, tt = t & 3;
        const int kb0 = blk * 256 + tt * 64;
        const bool own = (t < 4);
        const bool lsel = own || ((sel >> blk) & 1u);
        const bool active = own ? (kb0 <= qb * 256 + w * 32 + 31) : (__ballot(lsel) != 0ull);
        if (active) {
            LAS unsigned char* kl = lds + (t & 1) * 32768;
            const float lb = lsel ? hb : -INFINITY;
            const bool diag = own && (kb0 + 63 > qb * 256 + w * 32);
#pragma unroll
            for (int h32 = 0; h32 < 2; ++h32) {
                f32x16 p0;
                const float lbq = lb * (1.0f / cs), s2q = slope2 * (1.0f / cs);
#pragma unroll
                for (int r = 0; r < 16; ++r) p0[r] = fmaf(s2q, (float)((r & 3) + 8 * (r >> 2)), lbq);
#pragma unroll
                for (int ds = 0; ds < 8; ++ds) {
                    const int ch = ((2 * ds + hh) ^ kq) << 4;
                    const bf16x8 k0 = *(const LAS bf16x8*)(kl + koff[h32] + ch);
                    p0 = __builtin_amdgcn_mfma_f32_32x32x16_bf16(k0, qf[ds], p0, 0, 0, 0);
                }
                float mx0 = -INFINITY;
                const int dq = qrow - kb0 - 32 * h32 - 4 * hh;
#pragma unroll
                for (int r = 0; r < 16; ++r) {
                    if (diag) { if ((r & 3) + 8 * (r >> 2) > dq) p0[r] = -INFINITY; }
                    mx0 = fmaxf(mx0, p0[r]);
                }
                const float tc = slope2 * (float)(kb0 + 32 * h32);
                float tmax = fmaf(mx0, cs, tc);
                tmax = fmaxf(tmax, __shfl_xor(tmax, 32));
                const float mn = fmaxf(m, tmax);
                if (__ballot(mn > m) != 0ull) {
                    const float alpha = __builtin_amdgcn_exp2f(m - mn);
                    l *= alpha;
#pragma unroll
                    for (int db = 0; db < 4; ++db)
#pragma unroll
                        for (int r = 0; r < 16; ++r) o[db][r] *= alpha;
                    m = mn;
                }
                const float c0 = tc - m;
                float ls = 0.f;
#pragma unroll
                for (int r = 0; r < 16; ++r) { const float e0 = __builtin_amdgcn_exp2f(fmaf(p0[r], cs, c0)); p0[r] = e0; ls += e0; }
                l += ls;
                bf16x8 pb[2];
#pragma unroll
                for (int s2 = 0; s2 < 2; ++s2) {
                    u32x4 w0;
#pragma unroll
                    for (int q = 0; q < 4; ++q) w0[q] = pk2(p0[8 * s2 + 2 * q], p0[8 * s2 + 2 * q + 1]);
                    pb[s2] = __builtin_bit_cast(bf16x8, w0);
                }
#pragma unroll
                for (int db = 0; db < 4; ++db) {
#pragma unroll
                    for (int s2 = 0; s2 < 2; ++s2) {
                        const int ks = 2 * h32 + s2;
                        const v4i16_t lo = __builtin_amdgcn_ds_read_tr16_b64_v4i16((LAS v4i16_t*)(kl + voff[db] + (16 * ks) * 256));
                        const v4i16_t hi = __builtin_amdgcn_ds_read_tr16_b64_v4i16((LAS v4i16_t*)(kl + voff[db] + (16 * ks + 8) * 256));
                        bf16x8 vf; vf[0] = lo[0]; vf[1] = lo[1]; vf[2] = lo[2]; vf[3] = lo[3]; vf[4] = hi[0]; vf[5] = hi[1]; vf[6] = hi[2]; vf[7] = hi[3];
                        o[db] = __builtin_amdgcn_mfma_f32_32x32x16_bf16(vf, pb[s2], o[db], 0, 0, 0);
                    }
                }
            }
        }
        asm volatile("s_waitcnt vmcnt(0)" ::: "memory");
        __syncthreads();
    }
    l += __shfl_xor(l, 32);
    const float inv = 1.0f / l;
    const int orow_tok = b * SEQ + qrow, ocol0 = head * HD + 4 * hh;
#pragma unroll
    for (int db = 0; db < 4; ++db)
#pragma unroll
        for (int rq = 0; rq < 4; ++rq) {
            uint2 ov; ov.x = pk2(o[db][4 * rq] * inv, o[db][4 * rq + 1] * inv); ov.y = pk2(o[db][4 * rq + 2] * inv, o[db][4 * rq + 3] * inv);
            *(uint2*)(ATT + stg_off(orow_tok, ocol0 + db * 32 + 8 * rq)) = ov;
        }
}
__device__ __forceinline__ void phase_attn(LAS unsigned char* lds, const GemmCtx& c, const bf16_t* Qb, const bf16_t* Kb, const bf16_t* Vb, const float* KM, bf16_t* ATT) {
    for (int it = blockIdx.x; it < 256; it += gridDim.x) {
        const int p = (gridDim.x == 256) ? vblock(lds) : it;
        const int bh = p >> 2, j = p & 3;
#pragma unroll 1
        for (int u = 0; u < 2; ++u) attn_unit(lds, c, bh, u ? j : 7 - j, Qb, Kb, Vb, KM, ATT);
    }
}

#define XB_TMO      128
#define XB_XCNT(j)  (256  + 64 * (j))
#define XB_XSUB(j)  (1280 + 64 * (j))
#define XB_XGEN(j)  (2304 + 64 * (j))
#define XB_TOP      3328
#define XB_TOPGEN   3392
#define XCD_BAR_WORDS 3456
#define XB_SPIN_CAP (1u << 22)
__device__ __forceinline__ unsigned xb_ld(unsigned* p)              { return __hip_atomic_load(p, __ATOMIC_RELAXED, __HIP_MEMORY_SCOPE_AGENT); }
__device__ __forceinline__ unsigned xb_add(unsigned* p, unsigned v) { return __hip_atomic_fetch_add(p, v, __ATOMIC_RELAXED, __HIP_MEMORY_SCOPE_AGENT); }
__device__ __forceinline__ unsigned xb_xcc_id() { return (unsigned)__builtin_amdgcn_s_getreg((3 << 11) | 20) & 0xFu; }
#define XB_SPIN(cond, bar) do { unsigned _sp = 0; while (cond) { __builtin_amdgcn_s_sleep(1); \
    if ((++_sp & 255u) == 0u) { if (xb_ld(&(bar)[XB_TMO])) break; if (_sp > XB_SPIN_CAP) { atomicAdd(&(bar)[XB_TMO], 1u); break; } } } } while (0)
__device__ __forceinline__ void xcd_barrier_complete(unsigned* bar, unsigned x, unsigned& nloc, unsigned& nx) {
    const unsigned G = gridDim.x;
    unsigned sum, cnt, mine, sp = 0u;
    for (;;) {
        sum = 0u; cnt = 0u; mine = 0u;
#pragma unroll
        for (unsigned j = 0; j < 16; ++j) { const unsigned cc = xb_ld(&bar[XB_XCNT(j)]); sum += cc; cnt += (cc > 0u) ? 1u : 0u; mine = (j == x) ? cc : mine; }
        if (sum == G) break;
        __builtin_amdgcn_s_sleep(1);
        if ((++sp & 255u) == 0u) { if (xb_ld(&bar[XB_TMO])) break; if (sp > XB_SPIN_CAP) { atomicAdd(&bar[XB_TMO], 1u); break; } }
    }
    nloc = mine > 0u ? mine : 1u; nx = cnt > 0u ? cnt : 1u;
}
__device__ __forceinline__ void grid_barrier(unsigned* bar, volatile LAS unsigned* st) {
    asm volatile("s_waitcnt vmcnt(0)" ::: "memory");
    __syncthreads();
    if (threadIdx.x == 0) {
        __builtin_amdgcn_s_waitcnt(0);
        const unsigned x = xb_xcc_id();
        unsigned nloc = st[0], nx = st[1];
        if (nloc == 0u) {
            xcd_barrier_complete(bar, x, nloc, nx); st[0] = nloc; st[1] = nx;
            unsigned ok = 1u;
#pragma unroll
            for (unsigned j = 0; j < 16; ++j) { const unsigned cc = xb_ld(&bar[XB_XCNT(j)]); ok &= (j < 8u) ? (cc == 32u ? 1u : 0u) : (cc == 0u ? 1u : 0u); }
            st[3] = ok;
        }
        const unsigned old = xb_add(&bar[XB_XSUB(x)], 1u);
        const unsigned gen = old / nloc;
        if (old + 1u == (gen + 1u) * nloc) {
            __builtin_amdgcn_fence(__ATOMIC_RELEASE, "agent");
            asm volatile("s_waitcnt vmcnt(0)" ::: "memory");
            const unsigned og = xb_add(&bar[XB_TOP], 1u);
            const unsigned tg = og / nx;
            if (og + 1u == (tg + 1u) * nx) xb_add(&bar[XB_TOPGEN], 1u);
            else XB_SPIN(xb_ld(&bar[XB_TOPGEN]) == tg, bar);
            __builtin_amdgcn_fence(__ATOMIC_ACQUIRE, "agent");
            xb_add(&bar[XB_XGEN(x)], 1u);
            asm volatile("s_waitcnt vmcnt(0)" ::: "memory");
        } else {
            XB_SPIN(xb_ld(&bar[XB_XGEN(x)]) == gen, bar);
            __builtin_amdgcn_fence(__ATOMIC_ACQUIRE, "agent");
            asm volatile("s_waitcnt vmcnt(0)" ::: "memory");
        }
    }
    __syncthreads();
}

__global__ void __launch_bounds__(512, 2) mega(MegaArgs a) {
    extern __shared__ __attribute__((aligned(16))) unsigned char lds_raw[];
    LAS unsigned char* lds = (LAS unsigned char*)lds_raw;
    const int ph_lo = a.ph_lo, ph_hi = a.ph_hi;
    volatile LAS unsigned* bst = (volatile LAS unsigned*)(lds + LDS_MISC + 8160);
    if (threadIdx.x == 0) { bst[0] = 0u; bst[1] = 0u; bst[2] = 0xffffu; bst[3] = 0u; }
    if (ph_hi - ph_lo > 1 && threadIdx.x == 0) {
        const unsigned x = xb_xcc_id(); const unsigned rank = xb_add(&((unsigned*)ARG(ws))[XB_XCNT(x)], 1u);
        bst[2] = (x < 8u && rank < 32u) ? x * 32u + rank : 0xffffu;
    }
    __syncthreads();
#ifndef REPEAT_PH
#define REPEAT_PH -1
#endif
#ifndef ABLATE
#define ABLATE 0
#endif
#define IN(k) (ph_lo <= (k) && (k) < ph_hi)
#define SEAM(k) if (IN(k) && IN((k) + 1)) grid_barrier((unsigned*)ARG(ws), bst);
    if (IN(PH_PREP)) { const GemmCtx c = make_ctx(); const int gwave = blockIdx.x * 8 + c.wid, nwaves = gridDim.x * 8; (void)gwave; (void)nwaves;
        norm_rows(ARG(x), ARG(mix_norm), WSP(bf16_t, WS_A1), nullptr, nullptr, gwave, nwaves, c.lane);
        convert_wt<true>(lds, c, ARG(conv_w_in), 6144, WSP(bf16_t, WS_WT));
        convert_wt(lds, c, ARG(conv_w_out), 2048, WSP(bf16_t, WS_WT) + (size_t)6144 * DM);
        convert_wt(lds, c, ARG(w_kv), 4096, WSP(bf16_t, WS_WT) + (size_t)(6144 + 2048) * DM, ARG(kv_norm));
        convert_wt(lds, c, ARG(w_q), 2048, WSP(bf16_t, WS_WT) + (size_t)(6144 + 2048 + 4096) * DM, ARG(mix_norm) + DM);
        convert_wt(lds, c, ARG(w_o), 2048, WSP(bf16_t, WS_WT) + (size_t)(6144 + 2048 + 6144) * DM); }
    if (IN(PH_PREP) && REPEAT_PH == PH_PREP) grid_barrier((unsigned*)ARG(ws), bst);
    if (IN(PH_PREP) && REPEAT_PH == PH_PREP) { const GemmCtx c = make_ctx(); const int gwave = blockIdx.x * 8 + c.wid, nwaves = gridDim.x * 8; (void)gwave; (void)nwaves;
        norm_rows(ARG(x), ARG(mix_norm), WSP(bf16_t, WS_A1), nullptr, nullptr, gwave, nwaves, c.lane);
        convert_wt<true>(lds, c, ARG(conv_w_in), 6144, WSP(bf16_t, WS_WT));
        convert_wt(lds, c, ARG(conv_w_out), 2048, WSP(bf16_t, WS_WT) + (size_t)6144 * DM);
        convert_wt(lds, c, ARG(w_kv), 4096, WSP(bf16_t, WS_WT) + (size_t)(6144 + 2048) * DM, ARG(kv_norm));
        convert_wt(lds, c, ARG(w_q), 2048, WSP(bf16_t, WS_WT) + (size_t)(6144 + 2048 + 4096) * DM, ARG(mix_norm) + DM);
        convert_wt(lds, c, ARG(w_o), 2048, WSP(bf16_t, WS_WT) + (size_t)(6144 + 2048 + 6144) * DM); }
    SEAM(PH_PREP)
    if (IN(PH_GEMM1)) { const GemmCtx c = make_ctx(); const int gwave = blockIdx.x * 8 + c.wid, nwaves = gridDim.x * 8; (void)gwave; (void)nwaves;
        phase_gemm1(lds, c, WSP(bf16_t, WS_A1), WSP(bf16_t, WS_WT), WSP(bf16_t, WS_BCX)); }
    if (IN(PH_GEMM1) && REPEAT_PH == PH_GEMM1) grid_barrier((unsigned*)ARG(ws), bst);
    if (IN(PH_GEMM1) && REPEAT_PH == PH_GEMM1) { const GemmCtx c = make_ctx(); const int gwave = blockIdx.x * 8 + c.wid, nwaves = gridDim.x * 8; (void)gwave; (void)nwaves;
        phase_gemm1(lds, c, WSP(bf16_t, WS_A1), WSP(bf16_t, WS_WT), WSP(bf16_t, WS_BCX)); }
    SEAM(PH_GEMM1)
    if (IN(PH_CONV)) { const GemmCtx c = make_ctx(); const int gwave = blockIdx.x * 8 + c.wid, nwaves = gridDim.x * 8; (void)gwave; (void)nwaves;
        conv_phase(WSP(bf16_t, WS_BCX), WSP(bf16_t, WS_BCX) + (size_t)NTOK * DM, ARG(conv_w), WSP(bf16_t, WS_Z), blockIdx.x * 512 + c.tid, gridDim.x * 512); }
    if (IN(PH_CONV) && REPEAT_PH == PH_CONV) grid_barrier((unsigned*)ARG(ws), bst);
    if (IN(PH_CONV) && REPEAT_PH == PH_CONV) { const GemmCtx c = make_ctx(); const int gwave = blockIdx.x * 8 + c.wid, nwaves = gridDim.x * 8; (void)gwave; (void)nwaves;
        conv_phase(WSP(bf16_t, WS_BCX), WSP(bf16_t, WS_BCX) + (size_t)NTOK * DM, ARG(conv_w), WSP(bf16_t, WS_Z), blockIdx.x * 512 + c.tid, gridDim.x * 512); }
    SEAM(PH_CONV)
    if (IN(PH_GEMM2)) { const GemmCtx c = make_ctx(); const int gwave = blockIdx.x * 8 + c.wid, nwaves = gridDim.x * 8; (void)gwave; (void)nwaves;
        phase_gemm_resid<0>(lds, c, WSP(bf16_t, WS_Z), WSP(bf16_t, WS_WT) + (size_t)6144 * DM, ARG(x), WSP(bf16_t, WS_HB)); }
    if (IN(PH_GEMM2) && REPEAT_PH == PH_GEMM2) grid_barrier((unsigned*)ARG(ws), bst);
    if (IN(PH_GEMM2) && REPEAT_PH == PH_GEMM2) { const GemmCtx c = make_ctx(); const int gwave = blockIdx.x * 8 + c.wid, nwaves = gridDim.x * 8; (void)gwave; (void)nwaves;
        phase_gemm_resid<0>(lds, c, WSP(bf16_t, WS_Z), WSP(bf16_t, WS_WT) + (size_t)6144 * DM, ARG(x), WSP(bf16_t, WS_HB)); }
    SEAM(PH_GEMM2)
    if (IN(PH_ROUTER0)) { const GemmCtx c = make_ctx(); const int gwave = blockIdx.x * 8 + c.wid, nwaves = gridDim.x * 8; (void)gwave; (void)nwaves;
        phase_router(lds, c, WSP(bf16_t, WS_HB), ARG(ffn_norm), ARG(router_group), ARG(router_expert), WSP(bf16_t, WS_A1), WSP(int, WS_TOKE), WSP(float, WS_TOKW), WSP(float, WS_TOKR)); }
    if (IN(PH_ROUTER0) && REPEAT_PH == PH_ROUTER0) grid_barrier((unsigned*)ARG(ws), bst);
    if (IN(PH_ROUTER0) && REPEAT_PH == PH_ROUTER0) { const GemmCtx c = make_ctx(); const int gwave = blockIdx.x * 8 + c.wid, nwaves = gridDim.x * 8; (void)gwave; (void)nwaves;
        phase_router(lds, c, WSP(bf16_t, WS_HB), ARG(ffn_norm), ARG(router_group), ARG(router_expert), WSP(bf16_t, WS_A1), WSP(int, WS_TOKE), WSP(float, WS_TOKW), WSP(float, WS_TOKR)); }
    SEAM(PH_ROUTER0)
    if (IN(PH_MOEA0)) { const GemmCtx c = make_ctx(); const int gwave = blockIdx.x * 8 + c.wid, nwaves = gridDim.x * 8; (void)gwave; (void)nwaves;
        phase_moe(lds, c, 0); }
    if (IN(PH_MOEA0) && IN(PH_COMBINE0)) grid_barrier((unsigned*)ARG(ws), bst);
    if (IN(PH_COMBINE0)) { const GemmCtx c = make_ctx(); const int gwave = blockIdx.x * 8 + c.wid, nwaves = gridDim.x * 8; (void)gwave; (void)nwaves;
        combine_rows2(WSP(bf16_t, WS_HB), WSP(bf16_t, WS_Y), ARG(kv_norm), WSP(bf16_t, WS_A1), nullptr, nullptr, nullptr, nullptr, gwave, nwaves, c.lane, WSP(float, WS_RINV)); }
    if (IN(PH_COMBINE0) && REPEAT_PH == PH_COMBINE0) grid_barrier((unsigned*)ARG(ws), bst);
    if (IN(PH_COMBINE0) && REPEAT_PH == PH_COMBINE0) { const GemmCtx c = make_ctx(); const int gwave = blockIdx.x * 8 + c.wid, nwaves = gridDim.x * 8; (void)gwave; (void)nwaves;
        combine_rows2(WSP(bf16_t, WS_HB), WSP(bf16_t, WS_Y), ARG(kv_norm), WSP(bf16_t, WS_A1), nullptr, nullptr, nullptr, nullptr, gwave, nwaves, c.lane, WSP(float, WS_RINV)); }
    SEAM(PH_COMBINE0)
    if (IN(PH_GEMM3)) { const GemmCtx c = make_ctx(); const int gwave = blockIdx.x * 8 + c.wid, nwaves = gridDim.x * 8; (void)gwave; (void)nwaves;
        phase_gemm3(lds, c, WSP(bf16_t, WS_A1), WSP(bf16_t, WS_A1), WSP(bf16_t, WS_WT) + (size_t)(6144 + 2048) * DM, ARG(k_norm), ARG(q_norm),
                                  WSP(bf16_t, WS_BCX), WSP(bf16_t, WS_BCX) + (size_t)NTOK * DM, WSP(bf16_t, WS_BCX) + (size_t)2 * NTOK * DM, WSP(float, WS_KMEAN)); }
    if (IN(PH_GEMM3) && REPEAT_PH == PH_GEMM3) grid_barrier((unsigned*)ARG(ws), bst);
    if (IN(PH_GEMM3) && REPEAT_PH == PH_GEMM3) { const GemmCtx c = make_ctx(); const int gwave = blockIdx.x * 8 + c.wid, nwaves = gridDim.x * 8; (void)gwave; (void)nwaves;
        phase_gemm3(lds, c, WSP(bf16_t, WS_A1), WSP(bf16_t, WS_A1), WSP(bf16_t, WS_WT) + (size_t)(6144 + 2048) * DM, ARG(k_norm), ARG(q_norm),
                                  WSP(bf16_t, WS_BCX), WSP(bf16_t, WS_BCX) + (size_t)NTOK * DM, WSP(bf16_t, WS_BCX) + (size_t)2 * NTOK * DM, WSP(float, WS_KMEAN)); }
    SEAM(PH_GEMM3)
    if (IN(PH_ATTN)) { const GemmCtx c = make_ctx(); const int gwave = blockIdx.x * 8 + c.wid, nwaves = gridDim.x * 8; (void)gwave; (void)nwaves;
        phase_attn(lds, c, WSP(bf16_t, WS_BCX) + (size_t)2 * NTOK * DM, WSP(bf16_t, WS_BCX), WSP(bf16_t, WS_BCX) + (size_t)NTOK * DM, WSP(float, WS_KMEAN), WSP(bf16_t, WS_Z)); }
    if (IN(PH_ATTN) && REPEAT_PH == PH_ATTN) grid_barrier((unsigned*)ARG(ws), bst);
    if (IN(PH_ATTN) && REPEAT_PH == PH_ATTN) { const GemmCtx c = make_ctx(); const int gwave = blockIdx.x * 8 + c.wid, nwaves = gridDim.x * 8; (void)gwave; (void)nwaves;
        phase_attn(lds, c, WSP(bf16_t, WS_BCX) + (size_t)2 * NTOK * DM, WSP(bf16_t, WS_BCX), WSP(bf16_t, WS_BCX) + (size_t)NTOK * DM, WSP(float, WS_KMEAN), WSP(bf16_t, WS_Z)); }
    SEAM(PH_ATTN)
    if (IN(PH_GEMM4)) { const GemmCtx c = make_ctx(); const int gwave = blockIdx.x * 8 + c.wid, nwaves = gridDim.x * 8; (void)gwave; (void)nwaves;
        phase_gemm_resid<2>(lds, c, WSP(bf16_t, WS_Z), WSP(bf16_t, WS_WT) + (size_t)(6144 + 2048 + 6144) * DM, WSP(bf16_t, WS_A1), WSP(bf16_t, WS_HB), WSP(float, WS_RINV)); }
    if (IN(PH_GEMM4) && REPEAT_PH == PH_GEMM4) grid_barrier((unsigned*)ARG(ws), bst);
    if (IN(PH_GEMM4) && REPEAT_PH == PH_GEMM4) { const GemmCtx c = make_ctx(); const int gwave = blockIdx.x * 8 + c.wid, nwaves = gridDim.x * 8; (void)gwave; (void)nwaves;
        phase_gemm_resid<2>(lds, c, WSP(bf16_t, WS_Z), WSP(bf16_t, WS_WT) + (size_t)(6144 + 2048 + 6144) * DM, WSP(bf16_t, WS_A1), WSP(bf16_t, WS_HB), WSP(float, WS_RINV)); }
    SEAM(PH_GEMM4)
    if (IN(PH_ROUTER1)) { const GemmCtx c = make_ctx(); const int gwave = blockIdx.x * 8 + c.wid, nwaves = gridDim.x * 8; (void)gwave; (void)nwaves;
        phase_router(lds, c, WSP(bf16_t, WS_HB), ARG(ffn_norm) + DM, ARG(router_group) + (size_t)DM * NG, ARG(router_expert) + (size_t)DM * NE, WSP(bf16_t, WS_A1), WSP(int, WS_TOKE) + 2 * NTOK, WSP(float, WS_TOKW) + 2 * NTOK, WSP(float, WS_TOKR) + NTOK); }
    if (IN(PH_ROUTER1) && REPEAT_PH == PH_ROUTER1) grid_barrier((unsigned*)ARG(ws), bst);
    if (IN(PH_ROUTER1) && REPEAT_PH == PH_ROUTER1) { const GemmCtx c = make_ctx(); const int gwave = blockIdx.x * 8 + c.wid, nwaves = gridDim.x * 8; (void)gwave; (void)nwaves;
        phase_router(lds, c, WSP(bf16_t, WS_HB), ARG(ffn_norm) + DM, ARG(router_group) + (size_t)DM * NG, ARG(router_expert) + (size_t)DM * NE, WSP(bf16_t, WS_A1), WSP(int, WS_TOKE) + 2 * NTOK, WSP(float, WS_TOKW) + 2 * NTOK, WSP(float, WS_TOKR) + NTOK); }
    SEAM(PH_ROUTER1)
    if (IN(PH_MOEA1)) { const GemmCtx c = make_ctx(); const int gwave = blockIdx.x * 8 + c.wid, nwaves = gridDim.x * 8; (void)gwave; (void)nwaves;
        phase_moe(lds, c, 1); }
    if (IN(PH_MOEA1) && IN(PH_COMBINE1)) grid_barrier((unsigned*)ARG(ws), bst);
    if (IN(PH_COMBINE1)) { const GemmCtx c = make_ctx(); const int gwave = blockIdx.x * 8 + c.wid, nwaves = gridDim.x * 8; (void)gwave; (void)nwaves;
        combine_rows2(WSP(bf16_t, WS_HB), WSP(bf16_t, WS_Y), nullptr, nullptr, nullptr, nullptr, nullptr, ARG(H), gwave, nwaves, c.lane); }
    if (IN(PH_COMBINE1) && REPEAT_PH == PH_COMBINE1) grid_barrier((unsigned*)ARG(ws), bst);
    if (IN(PH_COMBINE1) && REPEAT_PH == PH_COMBINE1) { const GemmCtx c = make_ctx(); const int gwave = blockIdx.x * 8 + c.wid, nwaves = gridDim.x * 8; (void)gwave; (void)nwaves;
        combine_rows2(WSP(bf16_t, WS_HB), WSP(bf16_t, WS_Y), nullptr, nullptr, nullptr, nullptr, nullptr, ARG(H), gwave, nwaves, c.lane); }
#undef IN
#undef SEAM
}

extern "C" void kernel_launch(void* const* d_in, const int* in_sizes, int n_in, void* d_out, int out_size, void* d_ws, size_t ws_size, hipStream_t stream) {
    const float* x = (const float*)d_in[0];
    const float* mix_norm = (const float*)d_in[1];
    const float* ffn_norm = (const float*)d_in[2];
    const float* conv_w_in = (const float*)d_in[3];
    const float* conv_w = (const float*)d_in[4];
    const float* conv_w_out = (const float*)d_in[5];
    const float* kv_norm = (const float*)d_in[6];
    const float* w_kv = (const float*)d_in[7];
    const float* k_norm = (const float*)d_in[8];
    const float* w_q = (const float*)d_in[9];
    const float* q_norm = (const float*)d_in[10];
    const float* w_o = (const float*)d_in[11];
    const float* router_group = (const float*)d_in[12];
    const float* router_expert = (const float*)d_in[13];
    const float* w_gate = (const float*)d_in[14];
    const float* w_up = (const float*)d_in[15];
    const float* w_down = (const float*)d_in[16];
    float* H = (float*)d_out;
    unsigned char* ws = (unsigned char*)d_ws;
    if (ws_size < WS_END) { fprintf(stderr, "workspace too small: %zu < %zu\n", ws_size, (size_t)WS_END); return; }
    int* cnt = (int*)(ws + WS_CNT);
    bf16_t* A1 = (bf16_t*)(ws + WS_A1); bf16_t* A2 = (bf16_t*)(ws + WS_A2);
    bf16_t* BCX = (bf16_t*)(ws + WS_BCX);
    bf16_t* Kb = (bf16_t*)(ws + WS_BCX); bf16_t* Vb = Kb + (size_t)NTOK * DM; bf16_t* Qb = Vb + (size_t)NTOK * DM;
    bf16_t* Z = (bf16_t*)(ws + WS_Z); bf16_t* ATT = Z;
    bf16_t* ACT = (bf16_t*)(ws + WS_ACT); bf16_t* Y = (bf16_t*)(ws + WS_Y);
    float* KM = (float*)(ws + WS_KMEAN);
    int* list = (int*)(ws + WS_LIST); float* tokw = (float*)(ws + WS_TOKW); int* toke = (int*)(ws + WS_TOKE);
    float* T = (float*)(ws + WS_T);
    const size_t nd = (size_t)NTOK * DM;
    static bool attr = false;
    if (!attr) { (void)hipFuncSetAttribute((const void*)mega, hipFuncAttributeMaxDynamicSharedMemorySize, LDS_BYTES); attr = true; }
    MegaArgs ma{};
    ma.x = x; ma.mix_norm = mix_norm; ma.ffn_norm = ffn_norm; ma.conv_w_in = conv_w_in; ma.conv_w = conv_w; ma.conv_w_out = conv_w_out;
    ma.kv_norm = kv_norm; ma.w_kv = w_kv; ma.k_norm = k_norm; ma.w_q = w_q; ma.q_norm = q_norm; ma.w_o = w_o;
    ma.router_group = router_group; ma.router_expert = router_expert; ma.w_gate = w_gate; ma.w_up = w_up; ma.w_down = w_down;
    ma.H = H; ma.ws = ws;
    static int grid = 0;
    if (!grid) {
        int dev = 0, cus = 0, per_cu = 0;
        (void)hipGetDevice(&dev);
        (void)hipDeviceGetAttribute(&cus, hipDeviceAttributeMultiprocessorCount, dev);
        (void)hipOccupancyMaxActiveBlocksPerMultiprocessor(&per_cu, (const void*)mega, 512, LDS_BYTES);
        if (per_cu < 1) per_cu = 1;
        grid = cus * 1;
        if (grid > 256) grid = 256;
    }
    (void)hipMemsetAsync(ws + WS_CTL, 0, 16384, stream);
    ma.ph_lo = 0; ma.ph_hi = PH_END;
    void* kargs[] = {&ma};
    hipError_t le = hipLaunchCooperativeKernel((const void*)mega, dim3(grid), dim3(512), kargs, LDS_BYTES, stream);
    if (le != hipSuccess) fprintf(stderr, "cooperative launch failed: %s (grid %d)\n", hipGetErrorString(le), grid);
}
```

```cpp
#include <hip/hip_runtime.h>
#include <cstdint>
#include <cstddef>
#include <cstdio>

constexpr int NTOK = 8192, DM = 2048, SEQ = 2048, NBATCH = 4, NH = 16, HD = 128, NBLK = 8, BLK = 256;
constexpr int NE = 32, DE = 512, NG = 4, EPG = 8;
constexpr float EPS = 1e-6f;
constexpr int LDP = DM + 128;

typedef unsigned short bf16_t;
typedef float f32x4 __attribute__((ext_vector_type(4)));

constexpr size_t MB = 1024 * 1024;
constexpr size_t WS_CTL = 0;
constexpr size_t WS_CNT = 64 * 1024;
constexpr size_t WS_A1 = 1 * MB;
constexpr size_t WS_A2 = WS_A1 + 36 * MB;
constexpr size_t WS_BCX = WS_A2 + 36 * MB;
constexpr size_t WS_Z = WS_BCX + 96 * MB;
constexpr size_t WS_ACT = WS_Z + 36 * MB;
constexpr size_t WS_Y = WS_ACT + 16 * MB;
constexpr size_t WS_KMEAN = WS_Y + 64 * MB;
constexpr size_t WS_LIST = WS_KMEAN + 1 * MB;
constexpr size_t WS_TOKW = WS_LIST + 2 * MB;
constexpr size_t WS_TOKE = WS_TOKW + 1 * MB;
constexpr size_t WS_T = WS_TOKE + 1 * MB;
constexpr size_t WS_WT = WS_T;
constexpr size_t WS_HB = WS_T + 96 * MB;
constexpr size_t WS_RINV = WS_TOKW + 640 * 1024;
constexpr size_t WS_TOKR = WS_TOKW + 512 * 1024;
constexpr size_t WS_END = WS_T + 192 * MB;

__device__ __forceinline__ unsigned pk2(float lo, float hi) {
    typedef float f2 __attribute__((ext_vector_type(2)));
    typedef __bf16 b2 __attribute__((ext_vector_type(2)));
    f2 v = {lo, hi}; b2 b = __builtin_convertvector(v, b2); return __builtin_bit_cast(unsigned, b);
}
__device__ __forceinline__ float bflo(unsigned u) { return __uint_as_float(u << 16); }
__device__ __forceinline__ float bfhi(unsigned u) { return __uint_as_float(u & 0xffff0000u); }
__device__ __forceinline__ float bf2f(bf16_t b) { return __uint_as_float((unsigned)b << 16); }
__device__ __forceinline__ float wave_sum(float v) {
#pragma unroll
    for (int o = 1; o < 64; o <<= 1) v += __shfl_xor(v, o);
    return v;
}
__device__ __forceinline__ float wave_max(float v) {
#pragma unroll
    for (int o = 1; o < 64; o <<= 1) v = fmaxf(v, __shfl_xor(v, o));
    return v;
}

__device__ __forceinline__ size_t stg_off(int row, int k) {
    const int r = row & 255;
    return ((size_t)((row >> 8) * 64 + (k >> 5)) * 8192) + (size_t)((r * 64 + (((((k & 31) >> 3)) ^ ((0 - (r >> 2)) & 3)) << 4)) >> 1) + (k & 7);
}
__device__ __forceinline__ void norm_rows(const float* __restrict__ src, const float* g1, bf16_t* o1, const float* g2, bf16_t* o2,
                                          int gwave, int nwaves, int lane) {
    for (int row = gwave; row < NTOK; row += nwaves) {
        const f32x4* p = (const f32x4*)(src + (size_t)row * DM);
        f32x4 v[8]; float ss = 0.f;
#pragma unroll
        for (int i = 0; i < 8; ++i) { v[i] = p[lane + 64 * i]; ss += v[i][0] * v[i][0] + v[i][1] * v[i][1] + v[i][2] * v[i][2] + v[i][3] * v[i][3]; }
        ss = wave_sum(ss);
        const float r = rsqrtf(ss * (1.0f / DM) + EPS);
#pragma unroll
        for (int i = 0; i < 8; ++i) {
            const int c = 4 * (lane + 64 * i);
            const f32x4 g = *(const f32x4*)(g1 + c);
            uint2 o; o.x = pk2(v[i][0] * r * g[0], v[i][1] * r * g[1]); o.y = pk2(v[i][2] * r * g[2], v[i][3] * r * g[3]);
            *(uint2*)(o1 + stg_off(row, c)) = o;
            if (g2) {
                const f32x4 h = *(const f32x4*)(g2 + c);
                uint2 q; q.x = pk2(v[i][0] * r * h[0], v[i][1] * r * h[1]); q.y = pk2(v[i][2] * r * h[2], v[i][3] * r * h[3]);
                *(uint2*)(o2 + stg_off(row, c)) = q;
            }
        }
    }
}

__device__ __forceinline__ void combine_rows(float* H, const bf16_t* __restrict__ Y, const float* g1, bf16_t* o1, const float* g2, bf16_t* o2,
                                             int gwave, int nwaves, int lane) {
    for (int row = gwave; row < NTOK; row += nwaves) {
        f32x4* p = (f32x4*)(H + (size_t)row * DM);
        const uint2* y0 = (const uint2*)(Y + (size_t)(2 * row) * DM);
        const uint2* y1 = (const uint2*)(Y + (size_t)(2 * row + 1) * DM);
        f32x4 v[8]; float ss = 0.f;
#pragma unroll
        for (int i = 0; i < 8; ++i) {
            v[i] = p[lane + 64 * i];
            const uint2 a = y0[lane + 64 * i], b = y1[lane + 64 * i];
            v[i][0] += bflo(a.x) + bflo(b.x); v[i][1] += bfhi(a.x) + bfhi(b.x);
            v[i][2] += bflo(a.y) + bflo(b.y); v[i][3] += bfhi(a.y) + bfhi(b.y);
            p[lane + 64 * i] = v[i];
            ss += v[i][0] * v[i][0] + v[i][1] * v[i][1] + v[i][2] * v[i][2] + v[i][3] * v[i][3];
        }
        if (g1) {
            ss = wave_sum(ss);
            const float r = rsqrtf(ss * (1.0f / DM) + EPS);
#pragma unroll
            for (int i = 0; i < 8; ++i) {
                const int c = 4 * (lane + 64 * i);
                if (g2 == nullptr) {
                    uint2 o; o.x = pk2(v[i][0] * r, v[i][1] * r); o.y = pk2(v[i][2] * r, v[i][3] * r);
                    *(uint2*)(o1 + stg_off(row, c)) = o;
                } else {
                    const f32x4 g = *(const f32x4*)(g1 + c);
                    uint2 o; o.x = pk2(v[i][0] * r * g[0], v[i][1] * r * g[1]); o.y = pk2(v[i][2] * r * g[2], v[i][3] * r * g[3]);
                    *(uint2*)(o1 + stg_off(row, c)) = o;
                    const f32x4 h = *(const f32x4*)(g2 + c);
                    uint2 q; q.x = pk2(v[i][0] * r * h[0], v[i][1] * r * h[1]); q.y = pk2(v[i][2] * r * h[2], v[i][3] * r * h[3]);
                    *(uint2*)(o2 + stg_off(row, c)) = q;
                }
            }
        }
    }
}

__device__ __forceinline__ void combine_rows2(const bf16_t* __restrict__ HBin, const bf16_t* __restrict__ Y, const float* g1, bf16_t* o1, const float* g2, bf16_t* o2,
                                              bf16_t* HBout, float* OUT, int gwave, int nwaves, int lane, float* rs_out = nullptr) {
    for (int row = gwave; row < NTOK; row += nwaves) {
        const uint2* hp = (const uint2*)(HBin + (size_t)row * DM);
        const uint2* y0 = (const uint2*)(Y + (size_t)(2 * row) * DM);
        const uint2* y1 = (const uint2*)(Y + (size_t)(2 * row + 1) * DM);
        f32x4 v[8]; float ss = 0.f;
#pragma unroll
        for (int i = 0; i < 8; ++i) {
            const uint2 h = hp[lane + 64 * i], a = y0[lane + 64 * i], b = y1[lane + 64 * i];
            v[i][0] = bflo(h.x) + (bflo(a.x) + bflo(b.x)); v[i][1] = bfhi(h.x) + (bfhi(a.x) + bfhi(b.x));
            v[i][2] = bflo(h.y) + (bflo(a.y) + bflo(b.y)); v[i][3] = bfhi(h.y) + (bfhi(a.y) + bfhi(b.y));
            if (HBout) { uint2 o; o.x = pk2(v[i][0], v[i][1]); o.y = pk2(v[i][2], v[i][3]); *(uint2*)(HBout + (size_t)row * DM + 4 * (lane + 64 * i)) = o; }
            if (OUT) *(f32x4*)(OUT + (size_t)row * DM + 4 * (lane + 64 * i)) = v[i];
            ss += v[i][0] * v[i][0] + v[i][1] * v[i][1] + v[i][2] * v[i][2] + v[i][3] * v[i][3];
        }
        if (g1) {
            ss = wave_sum(ss);
            const float r = rsqrtf(ss * (1.0f / DM) + EPS);
            if (rs_out && lane == 0) rs_out[row] = sqrtf(ss * (1.0f / DM) + EPS);
#pragma unroll
            for (int i = 0; i < 8; ++i) {
                const int c = 4 * (lane + 64 * i);
                if (g2 == nullptr) {
                    uint2 o; o.x = pk2(v[i][0] * r, v[i][1] * r); o.y = pk2(v[i][2] * r, v[i][3] * r);
                    *(uint2*)(o1 + stg_off(row, c)) = o;
                } else {
                    const f32x4 g = *(const f32x4*)(g1 + c);
                    uint2 o; o.x = pk2(v[i][0] * r * g[0], v[i][1] * r * g[1]); o.y = pk2(v[i][2] * r * g[2], v[i][3] * r * g[3]);
                    *(uint2*)(o1 + stg_off(row, c)) = o;
                    const f32x4 h = *(const f32x4*)(g2 + c);
                    uint2 q; q.x = pk2(v[i][0] * r * h[0], v[i][1] * r * h[1]); q.y = pk2(v[i][2] * r * h[2], v[i][3] * r * h[3]);
                    *(uint2*)(o2 + stg_off(row, c)) = q;
                }
            }
        }
    }
}

__device__ __forceinline__ void conv_phase(const bf16_t* __restrict__ Bb, const bf16_t* __restrict__ U, const float* __restrict__ cw, bf16_t* Z, int gthread, int nthreads) {
    for (int item = gthread; item < (NTOK / 16) * (DM / 8); item += nthreads) {
        const int co = item & 255, trun = item >> 8;
        const int t0 = trun * 16, s0 = t0 & (SEQ - 1);
        const int c0 = co * 8;
        float w0[8], w1[8], w2[8];
#pragma unroll
        for (int e = 0; e < 8; ++e) { w0[e] = cw[c0 + e]; w1[e] = cw[DM + c0 + e]; w2[e] = cw[2 * DM + c0 + e]; }
        float um2[8], um1[8];
#pragma unroll
        for (int e = 0; e < 8; ++e) { um2[e] = 0.f; um1[e] = 0.f; }
        if (s0 >= 2) {
            const uint4 a = *(const uint4*)(U + (size_t)(t0 - 2) * DM + c0), b = *(const uint4*)(U + (size_t)(t0 - 1) * DM + c0);
            const unsigned av[4] = {a.x, a.y, a.z, a.w}, bv[4] = {b.x, b.y, b.z, b.w};
#pragma unroll
            for (int e = 0; e < 4; ++e) { um2[2 * e] = bflo(av[e]); um2[2 * e + 1] = bfhi(av[e]); um1[2 * e] = bflo(bv[e]); um1[2 * e + 1] = bfhi(bv[e]); }
        }
        for (int t = t0; t < t0 + 16; ++t) {
            const uint4 bg = *(const uint4*)(Bb + (size_t)t * DM + c0), uu = *(const uint4*)(U + (size_t)t * DM + c0);
            const unsigned bgv[4] = {bg.x, bg.y, bg.z, bg.w}, uv[4] = {uu.x, uu.y, uu.z, uu.w};
            unsigned ov[4];
#pragma unroll
            for (int e = 0; e < 4; ++e) {
                const float ua = bflo(uv[e]), ub = bfhi(uv[e]);
                const float ca = w0[2 * e] * um2[2 * e] + w1[2 * e] * um1[2 * e] + w2[2 * e] * ua;
                const float cb = w0[2 * e + 1] * um2[2 * e + 1] + w1[2 * e + 1] * um1[2 * e + 1] + w2[2 * e + 1] * ub;
                ov[e] = pk2(bflo(bgv[e]) * ca, bfhi(bgv[e]) * cb);
                um2[2 * e] = um1[2 * e]; um2[2 * e + 1] = um1[2 * e + 1]; um1[2 * e] = ua; um1[2 * e + 1] = ub;
            }
            *(uint4*)(Z + stg_off(t, c0)) = make_uint4(ov[0], ov[1], ov[2], ov[3]);
        }
    }
}

__global__ void __launch_bounds__(512) k_prep(const float* x, const float* g, bf16_t* a1, int* cnt) {
    const int gt = blockIdx.x * 512 + threadIdx.x;
    if (gt < 2 * NE) cnt[gt] = 0;
    norm_rows(x, g, a1, nullptr, nullptr, gt >> 6, (gridDim.x * 512) >> 6, threadIdx.x & 63);
}
__global__ void __launch_bounds__(512) k_conv(const bf16_t* BCX, const float* cw, bf16_t* Z) {
    conv_phase(BCX, BCX + (size_t)NTOK * DM, cw, Z, blockIdx.x * 512 + threadIdx.x, gridDim.x * 512);
}
__global__ void __launch_bounds__(512) k_combine(float* H, const bf16_t* Y, const float* g1, bf16_t* o1, const float* g2, bf16_t* o2) {
    const int gt = blockIdx.x * 512 + threadIdx.x;
    combine_rows(H, Y, g1, o1, g2, o2, gt >> 6, (gridDim.x * 512) >> 6, threadIdx.x & 63);
}

__global__ void __launch_bounds__(512) naive_gemm(const bf16_t* __restrict__ A, const float* __restrict__ W, float* T, int N, int ldt, int coff) {
    __shared__ float sA[4 * DM];
    const int tid = threadIdx.x, n = blockIdx.x * 512 + tid;
    for (int half = 0; half < 2; ++half) {
    const int m0 = blockIdx.y * 8 + half * 4;
    __syncthreads();
    for (int i = tid; i < 4 * DM; i += 512) sA[i] = bf2f(A[(size_t)(m0 + (i >> 11)) * DM + (i & 2047)]);
    __syncthreads();
    float acc[4];
#pragma unroll
    for (int r = 0; r < 4; ++r) acc[r] = 0.f;
    for (int k = 0; k < DM; k += 4) {
        const float w0 = W[(size_t)k * N + n], w1 = W[(size_t)(k + 1) * N + n], w2 = W[(size_t)(k + 2) * N + n], w3 = W[(size_t)(k + 3) * N + n];
#pragma unroll
        for (int r = 0; r < 4; ++r) { const f32x4 a = *(const f32x4*)&sA[r * DM + k]; acc[r] += a[0] * w0 + a[1] * w1 + a[2] * w2 + a[3] * w3; }
    }
#pragma unroll
    for (int r = 0; r < 4; ++r) T[(size_t)(m0 + r) * ldt + coff + n] = acc[r];
    }
}
__global__ void naive_epi_bf16(const float* T, bf16_t* O, size_t n) { size_t i = (size_t)blockIdx.x * blockDim.x + threadIdx.x; if (i < n) O[i] = (bf16_t)(pk2(T[i], 0.f) & 0xffff); }
__global__ void naive_epi_resid(const float* R, const float* T, float* H, size_t n) { size_t i = (size_t)blockIdx.x * blockDim.x + threadIdx.x; if (i < n) H[i] = R[i] + T[i]; }
__global__ void __launch_bounds__(256) naive_epi_kvq(const float* T, const float* kn, const float* qn, bf16_t* Kb, bf16_t* Vb, bf16_t* Qb) {
    const int gw = (blockIdx.x * 256 + threadIdx.x) >> 6, lane = threadIdx.x & 63;
    if (gw >= NTOK * 48) return;
    const int tok = gw / 48, rem = gw % 48, which = rem / 16, h = rem % 16;
    const float* src = T + (size_t)tok * 6144 + which * 2048 + h * 128 + 2 * lane;
    float v0 = src[0], v1 = src[1];
    if (which != 1) {
        const float ss = wave_sum(v0 * v0 + v1 * v1);
        const float r = rsqrtf(ss * (1.0f / HD) + EPS);
        const float* g = (which == 0) ? kn : qn;
        v0 = v0 * r * g[2 * lane]; v1 = v1 * r * g[2 * lane + 1];
    }
    const int b = tok / SEQ, s = tok % SEQ;
    bf16_t* dst = (which == 0 ? Kb : (which == 1 ? Vb : Qb)) + ((size_t)(b * NH + h) * SEQ + s) * HD + 2 * lane;
    *(unsigned*)dst = pk2(v0, v1);
}
__global__ void naive_kmean(const bf16_t* Kb, float* KM) {
    const int i = blockIdx.x * blockDim.x + threadIdx.x;
    if (i >= NBATCH * NH * NBLK * HD) return;
    const int d = i & 127, blk = (i >> 7) & 7, bh = i >> 10;
    float s = 0.f;
    for (int r = 0; r < BLK; ++r) s += bf2f(Kb[((size_t)bh * SEQ + blk * BLK + r) * HD + d]);
    KM[i] = s * (1.0f / BLK);
}

__global__ void __launch_bounds__(256) naive_router(const float* __restrict__ H, const float* g, const float* __restrict__ wrg, const float* __restrict__ wre,
                                                    bf16_t* AF, int* cnt, int* list, float* tokw, int* toke) {
    const int tok = (blockIdx.x * 256 + threadIdx.x) >> 6, lane = threadIdx.x & 63;
    if (tok >= NTOK) return;
    const f32x4* p = (const f32x4*)(H + (size_t)tok * DM);
    f32x4 v[8]; float ss = 0.f;
#pragma unroll
    for (int i = 0; i < 8; ++i) { v[i] = p[lane + 64 * i]; ss += v[i][0] * v[i][0] + v[i][1] * v[i][1] + v[i][2] * v[i][2] + v[i][3] * v[i][3]; }
    ss = wave_sum(ss);
    const float r = rsqrtf(ss * (1.0f / DM) + EPS);
    float acc[36];
#pragma unroll
    for (int c = 0; c < 36; ++c) acc[c] = 0.f;
#pragma unroll
    for (int i = 0; i < 8; ++i) {
        const int c0 = 4 * (lane + 64 * i);
        const f32x4 gg = *(const f32x4*)(g + c0);
        f32x4 y; y[0] = v[i][0] * r * gg[0]; y[1] = v[i][1] * r * gg[1]; y[2] = v[i][2] * r * gg[2]; y[3] = v[i][3] * r * gg[3];
        uint2 o; o.x = pk2(y[0], y[1]); o.y = pk2(y[2], y[3]);
        *(uint2*)(AF + (size_t)tok * DM + c0) = o;
#pragma unroll
        for (int e = 0; e < 4; ++e) {
            const int k = c0 + e;
            const f32x4 wg = *(const f32x4*)(wrg + (size_t)k * 4);
#pragma unroll
            for (int c = 0; c < 4; ++c) acc[c] += y[e] * wg[c];
#pragma unroll
            for (int q = 0; q < 8; ++q) {
                const f32x4 w = *(const f32x4*)(wre + (size_t)k * 32 + 4 * q);
#pragma unroll
                for (int c = 0; c < 4; ++c) acc[4 + 4 * q + c] += y[e] * w[c];
            }
        }
    }
#pragma unroll
    for (int c = 0; c < 36; ++c) acc[c] = wave_sum(acc[c]);
    if (lane == 0) {
        int gs = 0; float gm = acc[0];
#pragma unroll
        for (int c = 1; c < 4; ++c) if (acc[c] > gm) { gm = acc[c]; gs = c; }
        float den = 0.f;
#pragma unroll
        for (int c = 0; c < 4; ++c) den += __expf(acc[c] - gm);
        const float gw = 1.0f / den;
        float el[8];
#pragma unroll
        for (int c = 0; c < 8; ++c) {
            float x = 0.f;
#pragma unroll
            for (int gg = 0; gg < 4; ++gg) x = (gs == gg) ? acc[4 + gg * 8 + c] : x;
            el[c] = x;
        }
        int i0 = 0; float t0 = el[0];
#pragma unroll
        for (int c = 1; c < 8; ++c) if (el[c] > t0) { t0 = el[c]; i0 = c; }
        int i1 = -1; float t1 = -INFINITY;
#pragma unroll
        for (int c = 0; c < 8; ++c) if (c != i0 && el[c] > t1) { t1 = el[c]; i1 = c; }
        const float e1 = __expf(t1 - t0);
        const float w0 = gw / (1.0f + e1), w1 = gw * e1 / (1.0f + e1);
        const int ex0 = gs * 8 + i0, ex1 = gs * 8 + i1;
        tokw[tok * 2] = w0; tokw[tok * 2 + 1] = w1; toke[tok * 2] = ex0; toke[tok * 2 + 1] = ex1;
    }
}

__global__ void __launch_bounds__(512) naive_build_lists(const int* toke, int* cnt, int* list) {
    __shared__ int part[512];
    const int e = blockIdx.x, tid = threadIdx.x;
    int c = 0;
    for (int i = 0; i < 32; ++i) c += (toke[tid * 32 + i] == e);
    part[tid] = c;
    __syncthreads();
    int off = 0;
    for (int j = 0; j < tid; ++j) off += part[j];
    for (int i = 0; i < 32; ++i) if (toke[tid * 32 + i] == e) list[e * NTOK + off++] = tid * 32 + i;
    if (tid == 511) cnt[e] = off;
}
__global__ void __launch_bounds__(512) naive_moe_a(const bf16_t* __restrict__ AF, const float* __restrict__ Wg, const float* __restrict__ Wu,
                                                   const int* cnt, const int* list, bf16_t* ACT) {
    __shared__ float sA[4 * DM];
    __shared__ int srs[8];
    const int e = blockIdx.y, c0 = blockIdx.x * 4, n = cnt[e], tid = threadIdx.x;
    if (c0 >= n) return;
    if (tid < 4) srs[tid] = (c0 + tid < n) ? list[e * NTOK + c0 + tid] : -1;
    __syncthreads();
    for (int i = tid; i < 4 * DM; i += 512) { const int sr = srs[i >> 11]; sA[i] = sr >= 0 ? bf2f(AF[(size_t)(sr >> 1) * DM + (i & 2047)]) : 0.f; }
    __syncthreads();
    float ag[4], au[4];
#pragma unroll
    for (int r = 0; r < 4; ++r) { ag[r] = 0.f; au[r] = 0.f; }
    const float* wg = Wg + (size_t)e * DM * DE + tid; const float* wu = Wu + (size_t)e * DM * DE + tid;
    for (int k = 0; k < DM; k += 4) {
        float g4[4], u4[4];
#pragma unroll
        for (int q = 0; q < 4; ++q) { g4[q] = wg[(size_t)(k + q) * DE]; u4[q] = wu[(size_t)(k + q) * DE]; }
#pragma unroll
        for (int r = 0; r < 4; ++r) { const f32x4 a = *(const f32x4*)&sA[r * DM + k];
            ag[r] += a[0] * g4[0] + a[1] * g4[1] + a[2] * g4[2] + a[3] * g4[3];
            au[r] += a[0] * u4[0] + a[1] * u4[1] + a[2] * u4[2] + a[3] * u4[3]; }
    }
#pragma unroll
    for (int r = 0; r < 4; ++r) { const int sr = srs[r]; if (sr >= 0) { const float gv = ag[r]; const float a = gv / (1.0f + __expf(-gv)) * au[r];
        ACT[(size_t)sr * DE + tid] = (bf16_t)(pk2(a, 0.f) & 0xffff); } }
}
__global__ void __launch_bounds__(512) naive_moe_b(const bf16_t* __restrict__ ACT, const float* __restrict__ Wd, const int* cnt, const int* list,
                                                   const float* tokw, bf16_t* Y) {
    __shared__ float sA[8 * DE];
    __shared__ int srs[8];
    const int e = blockIdx.y, c0 = blockIdx.x * 8, n = cnt[e], tid = threadIdx.x;
    if (c0 >= n) return;
    if (tid < 8) srs[tid] = (c0 + tid < n) ? list[e * NTOK + c0 + tid] : -1;
    __syncthreads();
    for (int i = tid; i < 8 * DE; i += 512) { const int sr = srs[i >> 9]; sA[i] = sr >= 0 ? bf2f(ACT[(size_t)sr * DE + (i & 511)]) : 0.f; }
    __syncthreads();
    float acc[8][4];
#pragma unroll
    for (int r = 0; r < 8; ++r)
#pragma unroll
        for (int q = 0; q < 4; ++q) acc[r][q] = 0.f;
    const float* wd = Wd + (size_t)e * DE * DM + tid;
    for (int k = 0; k < DE; ++k) {
        float w[4];
#pragma unroll
        for (int q = 0; q < 4; ++q) w[q] = wd[(size_t)k * DM + 512 * q];
#pragma unroll
        for (int r = 0; r < 8; ++r) { const float a = sA[r * DE + k];
#pragma unroll
            for (int q = 0; q < 4; ++q) acc[r][q] += a * w[q]; }
    }
#pragma unroll
    for (int r = 0; r < 8; ++r) { const int sr = srs[r]; if (sr >= 0) { const float w = tokw[sr];
#pragma unroll
        for (int q = 0; q < 4; ++q) Y[(size_t)sr * DM + tid + 512 * q] = (bf16_t)(pk2(acc[r][q] * w, 0.f) & 0xffff); } }
}

__global__ void __launch_bounds__(256) naive_attn(const bf16_t* __restrict__ Qb, const bf16_t* __restrict__ Kb, const bf16_t* __restrict__ Vb,
                                                  const float* __restrict__ KM, bf16_t* ATT) {
    const int gw = (blockIdx.x * 256 + threadIdx.x) >> 6, lane = threadIdx.x & 63;
    if (gw >= NBATCH * NH * SEQ) return;
    const int s = gw % SEQ, bh = gw / SEQ, h = bh % NH, b = bh / NH;
    const int i = s / BLK;
    const unsigned qq = *(const unsigned*)(Qb + ((size_t)bh * SEQ + s) * HD + 2 * lane);
    const float q0 = bflo(qq), q1 = bfhi(qq);
    float gate[8];
#pragma unroll
    for (int n = 0; n < 8; ++n) {
        const float* km = KM + ((size_t)bh * NBLK + n) * HD + 2 * lane;
        gate[n] = wave_sum(q0 * km[0] + q1 * km[1]);
    }
    unsigned sel = 0;
#pragma unroll
    for (int n = 0; n < 8; ++n) {
        int rank = 0;
#pragma unroll
        for (int m = 0; m < 8; ++m) if (m < i && m != n && (gate[m] > gate[n] || (gate[m] == gate[n] && m < n))) ++rank;
        if (n < i && rank < 3) sel |= 1u << n;
    }
    const float slope = exp2f(-8.0f * (float)(h + 1) / (float)NH);
    const float scale = 0.08838834764831845f;
    float m = -INFINITY, l = 0.f, o0 = 0.f, o1 = 0.f;
    for (int jj = 0; jj <= i; ++jj) {
        const int j = (jj == 0) ? i : jj - 1;
        if (j != i && !((sel >> j) & 1)) continue;
        for (int c = 0; c < 4; ++c) {
            const int kbase = j * BLK + c * 64;
            if (j == i && kbase > s) break;
            const int kk = kbase + lane;
            const bf16_t* krow = Kb + ((size_t)bh * SEQ + kk) * HD;
            float dot = 0.f;
            for (int d2 = 0; d2 < 64; ++d2) {
                const float qa = __shfl(q0, d2), qb = __shfl(q1, d2);
                const unsigned kv = *(const unsigned*)(krow + 2 * d2);
                dot += qa * bflo(kv) + qb * bfhi(kv);
            }
            const bool valid = (j < i) || (kk <= s);
            const float sc = valid ? dot * scale - slope * (float)(s - kk) : -INFINITY;
            const float mx = wave_max(sc);
            const float mn = fmaxf(m, mx);
            const float p = valid ? __expf(sc - mn) : 0.f;
            const float alpha = __expf(m - mn);
            l = l * alpha + wave_sum(p);
            o0 *= alpha; o1 *= alpha; m = mn;
            for (int t = 0; t < 64; ++t) {
                const float pt = __shfl(p, t);
                const unsigned vv = *(const unsigned*)(Vb + ((size_t)bh * SEQ + kbase + t) * HD + 2 * lane);
                o0 += pt * bflo(vv); o1 += pt * bfhi(vv);
            }
        }
    }
    const float inv = 1.0f / l;
    *(unsigned*)(ATT + ((size_t)(b * SEQ + s)) * DM + h * HD + 2 * lane) = pk2(o0 * inv, o1 * inv);
}


#define LAS __attribute__((address_space(3)))
typedef short bf16x8 __attribute__((ext_vector_type(8)));
typedef unsigned u32x4 __attribute__((ext_vector_type(4)));
constexpr int LDS_GEMM = 131072;
constexpr int LDS_MISC = LDS_GEMM;
constexpr int LDS_BYTES = LDS_GEMM + 8192;

__device__ __forceinline__ int lds_off(int row, int chunk) { return row * 128 + ((chunk ^ (((row >> 1) & 7) ^ ((row >> 4) & 1))) << 4); }

struct GemmCtx { int tid, lane, wid, wr, wc, fr, fq; };
__device__ __forceinline__ GemmCtx make_ctx() {
    GemmCtx c; int t = threadIdx.x; asm volatile("" : "+v"(t));
    c.tid = t; c.lane = c.tid & 63; c.wid = __builtin_amdgcn_readfirstlane(c.tid >> 6);
    c.wr = c.wid >> 1; c.wc = c.wid & 1; c.fr = c.lane & 15; c.fq = c.lane >> 4; return c;
}

__device__ __forceinline__ int a_chunk_off(int tid) { const int r = tid >> 3; return (((tid & 7) ^ (((r >> 1) & 7) ^ ((r >> 4) & 1))) << 3); }
template <int ABL = 0> __device__ __forceinline__ void gemm_tile_f32w(LAS unsigned char* lds, const GemmCtx& c, const bf16_t* Abase, const unsigned (&aoff)[4], const float* Bbase, unsigned boff0,
                                               int brow0, int bkg, int ldw, int nk, f32x4 (&acc)[4][8]) {
#pragma unroll
    for (int mi = 0; mi < 4; ++mi)
#pragma unroll
        for (int ni = 0; ni < 8; ++ni) acc[mi][ni] = (f32x4){0.f, 0.f, 0.f, 0.f};
    LAS unsigned char* bw0 = lds + 65536 + lds_off(brow0, bkg);
    LAS unsigned char* bw2 = lds + 65536 + lds_off(brow0 + 2, bkg);
    typedef const __attribute__((address_space(1))) f32x4* gf4p;
    const __attribute__((address_space(1))) char* Bg = (const __attribute__((address_space(1))) char*)Bbase;
    const __attribute__((address_space(1))) char* Ag = (const __attribute__((address_space(1))) char*)Abase;
    const int x0 = c.fq ^ (c.fr >> 1);
    int foff[2][2];
#pragma unroll
    for (int par = 0; par < 2; ++par)
#pragma unroll
        for (int k32 = 0; k32 < 2; ++k32) foff[par][k32] = c.fr * 128 + ((x0 ^ (k32 * 4 + par)) << 4);
    const int abase = (c.wr * 64) * 128, bbase = 65536 + (c.wc * 128) * 128;
    LAS unsigned char* adst = lds + c.tid * 16;
    const unsigned ldw4 = (unsigned)ldw * 4u;

    f32x4 rb[8];
    auto gload = [&](int kt, int buf) {
#pragma unroll
        for (int i = 0; i < 4; ++i)
            if (ABL != 3) __builtin_amdgcn_global_load_lds((const __attribute__((address_space(1))) unsigned*)(Ag + (size_t)((aoff[i] + (unsigned)kt * 64u) * 2u)), (LAS unsigned*)(adst + buf * 32768 + i * 8192), 16, 0, 0);
        const unsigned vo = boff0 * 4u;
#pragma unroll
        for (int j = 0; j < 8; ++j) { if (ABL != 2) rb[j] = *(gf4p)((Bg + (size_t)((unsigned)(kt * 64 + j) * ldw4)) + (size_t)vo); else rb[j] = (f32x4){1.f, 2.f, 3.f, (float)kt}; }
    };
    auto lstore = [&](int buf) {
#pragma unroll
        for (int i = 0; i < 4; ++i) {
            u32x4 w; w[0] = pk2(rb[0][i], rb[1][i]); w[1] = pk2(rb[2][i], rb[3][i]); w[2] = pk2(rb[4][i], rb[5][i]); w[3] = pk2(rb[6][i], rb[7][i]);
            *(LAS u32x4*)((i < 2 ? bw0 : bw2) + buf * 32768 + (i & 1) * 128) = w;
        }
    };
    gload(0, 0); lstore(0);
    asm volatile("s_waitcnt vmcnt(0)" ::: "memory");
    __syncthreads();
    for (int kt = 0; kt < nk; ++kt) {
        const int cur = kt & 1;
        if (kt + 1 < nk) gload(kt + 1, cur ^ 1);
#pragma unroll
        for (int k32 = 0; k32 < 2; ++k32) {
            bf16x8 af[4];
#pragma unroll
            for (int mi = 0; mi < 4; ++mi) af[mi] = *(const LAS bf16x8*)(lds + cur * 32768 + abase + mi * 2048 + foff[mi & 1][k32]);
#pragma unroll
            for (int ni = 0; ni < 8; ++ni) {
                const bf16x8 bfr = *(const LAS bf16x8*)(lds + cur * 32768 + bbase + ni * 2048 + foff[ni & 1][k32]);
#pragma unroll
                for (int mi = 0; mi < 4; ++mi) { if (ABL != 1) acc[mi][ni] = __builtin_amdgcn_mfma_f32_16x16x32_bf16(bfr, af[mi], acc[mi][ni], 0, 0, 0); else { acc[mi][ni][0] += __builtin_bit_cast(float, (int)bfr[0]) ; acc[mi][ni][1] += __builtin_bit_cast(float, (int)af[mi][0]); } }
            }
        }
        if (kt + 1 < nk) lstore(cur ^ 1);
        asm volatile("s_waitcnt vmcnt(0)" ::: "memory");
        __syncthreads();
    }
}

__device__ __forceinline__ void gemm_tile_bf16(LAS unsigned char* lds, const GemmCtx& c, const bf16_t* Abase, unsigned aoff0, unsigned aoff1, const bf16_t* Bbase, unsigned boff0, unsigned boff1,
                                               int nk, f32x4 (&acc)[4][8], unsigned bstage = 32u, unsigned astage = 32u,
                                               bool pre = false, bool nxt = false, const bf16_t* An = nullptr, unsigned na0 = 0u, unsigned nb0 = 0u) {
#pragma unroll
    for (int mi = 0; mi < 4; ++mi)
#pragma unroll
        for (int ni = 0; ni < 8; ++ni) acc[mi][ni] = (f32x4){0.f, 0.f, 0.f, 0.f};
    typedef const __attribute__((address_space(1))) unsigned* gu32p;
    const __attribute__((address_space(1))) char* Ag = (const __attribute__((address_space(1))) char*)Abase;
    const __attribute__((address_space(1))) char* Bg = (const __attribute__((address_space(1))) char*)Bbase;
    LAS unsigned char* dst = lds + c.tid * 16;
    const int fo = c.fr * 64 + ((c.fq ^ ((0 - (c.fr >> 2)) & 3)) << 4);
    LAS unsigned char* fa = lds + c.wr * 4096 + fo;
    LAS unsigned char* fb = lds + 16384 + c.wc * 8192 + fo;
    auto issue = [&](int kt) {
        const int st = (kt & 3) * 32768;
        const unsigned ko = (unsigned)kt * astage, kb = (unsigned)kt * bstage;
        __builtin_amdgcn_global_load_lds((gu32p)(Ag + (size_t)((aoff0 + ko) * 2u)), (LAS unsigned*)(dst + st), 16, 0, 0);
        __builtin_amdgcn_global_load_lds((gu32p)(Ag + (size_t)((aoff1 + ko) * 2u)), (LAS unsigned*)(dst + st + 8192), 16, 0, 0);
        __builtin_amdgcn_global_load_lds((gu32p)(Bg + (size_t)((boff0 + kb) * 2u)), (LAS unsigned*)(dst + st + 16384), 16, 0, 0);
        __builtin_amdgcn_global_load_lds((gu32p)(Bg + (size_t)((boff1 + kb) * 2u)), (LAS unsigned*)(dst + st + 16384 + 8192), 16, 0, 0);
    };
#define RING_BAR() do { __builtin_amdgcn_sched_barrier(0); __builtin_amdgcn_s_barrier(); __builtin_amdgcn_sched_barrier(0); asm volatile("" ::: "memory"); } while (0)
    const bool g1 = c.wid >= 4;
    if (!pre) { issue(0); issue(1); issue(2); }
    asm volatile("s_waitcnt vmcnt(8)" ::: "memory");
    RING_BAR();
    if (g1) RING_BAR();
    for (int s = 0; s < nk; ++s) {
        const int st = (s & 3) * 32768;
        bf16x8 af[4], bfv[8];
#pragma unroll
        for (int mi = 0; mi < 4; ++mi) af[mi] = *(const LAS bf16x8*)(fa + st + mi * 1024);
#pragma unroll
        for (int ni = 0; ni < 8; ++ni) bfv[ni] = *(const LAS bf16x8*)(fb + st + ni * 1024);
        __builtin_amdgcn_sched_barrier(0);
        if (s + 3 < nk) issue(s + 3);
        if (g1) {
            if (s <= nk - 4) asm volatile("s_waitcnt vmcnt(8)" ::: "memory");
            else if (s == nk - 3) asm volatile("s_waitcnt vmcnt(4)" ::: "memory");
            else if (s == nk - 2) asm volatile("s_waitcnt vmcnt(0)" ::: "memory");
        }
        __builtin_amdgcn_s_waitcnt(0xC07F);
        RING_BAR();
#pragma unroll
        for (int ni = 0; ni < 8; ++ni)
#pragma unroll
            for (int mi = 0; mi < 4; ++mi) acc[mi][ni] = __builtin_amdgcn_mfma_f32_16x16x32_bf16(bfv[ni], af[mi], acc[mi][ni], 0, 0, 0);
        if (!g1) {
            if (s <= nk - 4) asm volatile("s_waitcnt vmcnt(8)" ::: "memory");
            else if (s == nk - 3) asm volatile("s_waitcnt vmcnt(4)" ::: "memory");
            else if (s == nk - 2) asm volatile("s_waitcnt vmcnt(0)" ::: "memory");
        }
        RING_BAR();
    }
    if (!g1) RING_BAR();
    if (nxt) {
        const __attribute__((address_space(1))) char* Ang = (const __attribute__((address_space(1))) char*)An;
#pragma unroll
        for (int kt = 0; kt < 3; ++kt) {
            const int st = kt * 32768;
            const unsigned ko = (unsigned)kt * astage, kb = (unsigned)kt * bstage;
            __builtin_amdgcn_global_load_lds((gu32p)(Ang + (size_t)((na0 + ko) * 2u)), (LAS unsigned*)(dst + st), 16, 0, 0);
            __builtin_amdgcn_global_load_lds((gu32p)(Ang + (size_t)((na0 + 4096u + ko) * 2u)), (LAS unsigned*)(dst + st + 8192), 16, 0, 0);
            __builtin_amdgcn_global_load_lds((gu32p)(Bg + (size_t)((nb0 + kb) * 2u)), (LAS unsigned*)(dst + st + 16384), 16, 0, 0);
            __builtin_amdgcn_global_load_lds((gu32p)(Bg + (size_t)((nb0 + 4096u + kb) * 2u)), (LAS unsigned*)(dst + st + 16384 + 8192), 16, 0, 0);
        }
    }
#undef RING_BAR
}
__device__ __forceinline__ unsigned ring_off(int tid, int row0, int ld) {
    return (unsigned)((row0 + (tid >> 2)) * ld + ((((tid & 3) ^ ((0 - (tid >> 4)) & 3))) << 3));
}

template <bool CONVIN = false> __device__ __forceinline__ void convert_wt(LAS unsigned char* lds, const GemmCtx& c, const float* __restrict__ W, int N, bf16_t* WT, const float* gk = nullptr) {
    LAS float* tile = (LAS float*)lds;
    const int ntn = N / 64, ntiles = (DM / 64) * ntn;
    for (int t = blockIdx.x; t < ntiles; t += gridDim.x) {
        const int kt = t / ntn, nt = t % ntn;
        __syncthreads();
#pragma unroll
        for (int i = 0; i < 2; ++i) {
            const int idx = i * 512 + c.tid, kr = idx >> 4, c4 = (idx & 15) * 4;
            f32x4 v = *(const f32x4*)(W + (size_t)(kt * 64 + kr) * N + nt * 64 + c4);
            if (gk) { const float gg = gk[kt * 64 + kr]; v[0] *= gg; v[1] *= gg; v[2] *= gg; v[3] *= gg; }
            tile[kr * 65 + c4] = v[0]; tile[kr * 65 + c4 + 1] = v[1]; tile[kr * 65 + c4 + 2] = v[2]; tile[kr * 65 + c4 + 3] = v[3];
        }
        __syncthreads();
        {
            const int n = c.tid >> 3, k8 = (c.tid & 7) * 8;
            u32x4 o;
#pragma unroll
            for (int q = 0; q < 4; ++q) o[q] = pk2(tile[(k8 + 2 * q) * 65 + n], tile[(k8 + 2 * q + 1) * 65 + n]);
            {
                int nrow = nt * 64 + n;
                if (CONVIN && nrow >= 2048) {
                    const int which = (nrow - 2048) >> 11, ch = (nrow - 2048) & 2047, hd = ch & 127;
                    nrow = 2048 + (ch >> 7) * 256 + (hd >> 6) * 128 + (2 * ((hd >> 4) & 3) + which) * 16 + (hd & 15);
                }
                const int pn = nrow >> 8, r = nrow & 255, kk = kt * 64 + k8, j = kk >> 5, lc = (kk & 31) >> 3;
                *(u32x4*)(WT + ((size_t)(pn * 64 + j) * 8192) + (r * 64 + ((lc ^ ((0 - (r >> 2)) & 3)) << 4)) / 2) = o;
            }
        }
    }
}

struct MegaArgs {
    const float* x; const float* mix_norm; const float* ffn_norm; const float* conv_w_in; const float* conv_w; const float* conv_w_out;
    const float* kv_norm; const float* w_kv; const float* k_norm; const float* w_q; const float* q_norm; const float* w_o;
    const float* router_group; const float* router_expert; const float* w_gate; const float* w_up; const float* w_down;
    float* H; unsigned char* ws; int ph_lo, ph_hi;
};
enum { PH_PREP = 0, PH_GEMM1 = 1, PH_CONV = 2, PH_GEMM2 = 3, PH_ROUTER0 = 4, PH_MOEA0 = 5, PH_MOEB0 = 6, PH_COMBINE0 = 7, PH_GEMM3 = 8, PH_ATTN = 9, PH_GEMM4 = 10,
       PH_ROUTER1 = 11, PH_MOEA1 = 12, PH_MOEB1 = 13, PH_COMBINE1 = 14, PH_END = 15 };

__device__ __forceinline__ int vblock(LAS unsigned char* lds) {
    volatile LAS unsigned* bst = (volatile LAS unsigned*)(lds + LDS_MISC + 8160);
    const unsigned v = bst[2], ok = bst[3];
    const int b = blockIdx.x;
    return __builtin_amdgcn_readfirstlane((ok && v < 256u) ? (int)v : ((b & 7) * 32 + (b >> 3)));
}
__device__ __forceinline__ bool dense_tile(LAS unsigned char* lds, int it, int ntn, int& pm, int& pn) {
    const int b = blockIdx.x, G = gridDim.x;
    const int t = it * G + b;
    if (G != 256) { if (t >= 32 * ntn) return false; pm = t % 32; pn = t / 32; return true; }
    const int r = it; if (r * 8 >= ntn) return false;
    const int vb = vblock(lds); const int x = vb >> 5, j = vb & 31; pm = 4 * x + (j & 3); pn = 8 * r + (j >> 2); return true;
}

template <int RMODE> __device__ __forceinline__ void phase_gemm_resid(LAS unsigned char* lds, const GemmCtx& c, const bf16_t* A, const bf16_t* WT, const void* R, bf16_t* HB, const float* rsc = nullptr) {
    int pm, pn; bool have = dense_tile(lds, 0, DM / 256, pm, pn), pre = false;
    for (int it = 0; have; ++it) {
        int npm = 0, npn = 0; const bool hn = dense_tile(lds, it + 1, DM / 256, npm, npn);
        f32x4 acc[4][8];
        gemm_tile_bf16(lds, c, A, (unsigned)(pm * 64 * 8192 + c.tid * 8), (unsigned)(pm * 64 * 8192 + 4096 + c.tid * 8), WT, (unsigned)(pn * 64 * 8192 + c.tid * 8), (unsigned)(pn * 64 * 8192 + 4096 + c.tid * 8), DM / 32, acc, 8192u, 8192u,
                       pre, hn, A, (unsigned)(npm * 64 * 8192 + c.tid * 8), (unsigned)(npn * 64 * 8192 + c.tid * 8));
#pragma unroll
        for (int mi = 0; mi < 4; ++mi) {
            const size_t row = (size_t)pm * 256 + c.wr * 64 + mi * 16 + c.fr;
            float sc = 1.f;
            if (RMODE == 2) sc = rsc[row];
#pragma unroll
            for (int ni = 0; ni < 8; ++ni) {
                const size_t idx = row * DM + pn * 256 + c.wc * 128 + ni * 16 + c.fq * 4;
                f32x4 r;
                if (RMODE == 2) { const uint2 h = *(const uint2*)((const bf16_t*)R + stg_off((int)row, pn * 256 + c.wc * 128 + ni * 16 + c.fq * 4)); r[0] = bflo(h.x) * sc; r[1] = bfhi(h.x) * sc; r[2] = bflo(h.y) * sc; r[3] = bfhi(h.y) * sc; }
                else r = *(const f32x4*)((const float*)R + idx);
                r = r + acc[mi][ni];
                uint2 o; o.x = pk2(r[0], r[1]); o.y = pk2(r[2], r[3]);
                *(uint2*)(HB + idx) = o;
            }
        }
        pm = npm; pn = npn; have = hn; pre = hn;
    }
}

__device__ __forceinline__ void phase_gemm1(LAS unsigned char* lds, const GemmCtx& c, const bf16_t* A, const bf16_t* WT, bf16_t* O) {
    int pm, pn; bool have = dense_tile(lds, 0, 6144 / 256, pm, pn), pre = false;
    for (int it = 0; have; ++it) {
        int npm = 0, npn = 0; const bool hn = dense_tile(lds, it + 1, 6144 / 256, npm, npn);
        f32x4 acc[4][8];
        const int lpm = pm, lpn = pn;
        gemm_tile_bf16(lds, c, A, (unsigned)(lpm * 64 * 8192 + c.tid * 8), (unsigned)(lpm * 64 * 8192 + 4096 + c.tid * 8), WT, (unsigned)(lpn * 64 * 8192 + c.tid * 8), (unsigned)(lpn * 64 * 8192 + 4096 + c.tid * 8), DM / 32, acc, 8192u, 8192u,
                       pre, hn, A, (unsigned)(npm * 64 * 8192 + c.tid * 8), (unsigned)(npn * 64 * 8192 + c.tid * 8));
#pragma unroll
        for (int mi = 0; mi < 4; ++mi) {
            const size_t row = (size_t)pm * 256 + c.wr * 64 + mi * 16 + c.fr;
            if (pn < 8) {
#pragma unroll
                for (int ni = 0; ni < 8; ++ni) {
                    uint2 o; o.x = pk2(acc[mi][ni][0], acc[mi][ni][1]); o.y = pk2(acc[mi][ni][2], acc[mi][ni][3]);
                    *(uint2*)(O + row * DM + pn * 256 + c.wc * 128 + ni * 16 + c.fq * 4) = o;
                }
            } else {
                bf16_t* U = O + (size_t)NTOK * DM;
#pragma unroll
                for (int p = 0; p < 4; ++p) {
                    uint2 o; o.x = pk2(acc[mi][2 * p][0] * acc[mi][2 * p + 1][0], acc[mi][2 * p][1] * acc[mi][2 * p + 1][1]);
                    o.y = pk2(acc[mi][2 * p][2] * acc[mi][2 * p + 1][2], acc[mi][2 * p][3] * acc[mi][2 * p + 1][3]);
                    *(uint2*)(U + row * DM + (pn - 8) * 128 + c.wc * 64 + p * 16 + c.fq * 4) = o;
                }
            }
        }
        pm = npm; pn = npn; have = hn; pre = hn;
    }
}

__device__ __forceinline__ void phase_gemm3(LAS unsigned char* lds, const GemmCtx& c, const bf16_t* AKV, const bf16_t* AQ, const bf16_t* WT,
                                            const float* kn, const float* qn, bf16_t* Kb, bf16_t* Vb, bf16_t* Qb, float* KM) {
    int pm, pn; bool have = dense_tile(lds, 0, 24, pm, pn), pre = false;
    for (int it = 0; have; ++it) {
        int npm = 0, npn = 0; const bool hn = dense_tile(lds, it + 1, 24, npm, npn);
        const bool isq = pn >= 16;
        const bf16_t* A = isq ? AQ : AKV;
        f32x4 acc[4][8];
        gemm_tile_bf16(lds, c, A, (unsigned)(pm * 64 * 8192 + c.tid * 8), (unsigned)(pm * 64 * 8192 + 4096 + c.tid * 8), WT, (unsigned)(pn * 64 * 8192 + c.tid * 8), (unsigned)(pn * 64 * 8192 + 4096 + c.tid * 8), DM / 32, acc, 8192u, 8192u,
                       pre, hn, (npn >= 16) ? AQ : AKV, (unsigned)(npm * 64 * 8192 + c.tid * 8), (unsigned)(npn * 64 * 8192 + c.tid * 8));
        const int which = pn >> 3;
        const int head = (pn & 7) * 2 + c.wc;
        bf16_t* dst = which == 0 ? Kb : (which == 1 ? Vb : Qb);
        const float* gn = which == 0 ? kn : qn;
        float colsum[8][4];
#pragma unroll
        for (int ni = 0; ni < 8; ++ni)
#pragma unroll
            for (int e = 0; e < 4; ++e) colsum[ni][e] = 0.f;
#pragma unroll
        for (int mi = 0; mi < 4; ++mi) {
            const int tok = pm * 256 + c.wr * 64 + mi * 16 + c.fr;
            const int b = tok >> 11, sq = tok & 2047;
            float r = 1.f;
            if (which != 1) {
                float ss = 0.f;
#pragma unroll
                for (int ni = 0; ni < 8; ++ni)
#pragma unroll
                    for (int e = 0; e < 4; ++e) ss += acc[mi][ni][e] * acc[mi][ni][e];
                ss += __shfl_xor(ss, 16); ss += __shfl_xor(ss, 32);
                r = rsqrtf(ss * (1.0f / HD) + EPS);
            }
            bf16_t* orow = dst + ((size_t)(b * NH + head) * SEQ + sq) * HD + c.fq * 4;
#pragma unroll
            for (int ni = 0; ni < 8; ++ni) {
                f32x4 v = acc[mi][ni];
                if (which != 1) { const f32x4 g = *(const f32x4*)(gn + ni * 16 + c.fq * 4); v[0] = v[0] * r * g[0]; v[1] = v[1] * r * g[1]; v[2] = v[2] * r * g[2]; v[3] = v[3] * r * g[3]; }
                if (which == 0) {
#pragma unroll
                    for (int e = 0; e < 4; ++e) colsum[ni][e] += v[e];
                }
                uint2 o; o.x = pk2(v[0], v[1]); o.y = pk2(v[2], v[3]);
                *(uint2*)(orow + ni * 16) = o;
            }
        }
        if (which == 0) {
            LAS float* red = (LAS float*)(lds + LDS_MISC);
#pragma unroll
            for (int ni = 0; ni < 8; ++ni)
#pragma unroll
                for (int e = 0; e < 4; ++e) {
                    float v = colsum[ni][e];
                    v += __shfl_xor(v, 1); v += __shfl_xor(v, 2); v += __shfl_xor(v, 4); v += __shfl_xor(v, 8);
                    if (c.fr == 0) red[(c.wr * 2 + c.wc) * 128 + ni * 16 + c.fq * 4 + e] = v;
                }
            __syncthreads();
            if (c.tid < 256) {
                const int wc2 = c.tid >> 7, d = c.tid & 127;
                const float sum = ((red[(0 * 2 + wc2) * 128 + d] + red[(1 * 2 + wc2) * 128 + d]) + red[(2 * 2 + wc2) * 128 + d]) + red[(3 * 2 + wc2) * 128 + d];
                const int hd2 = (pn & 7) * 2 + wc2, b = pm >> 3, blk = pm & 7;
                KM[((size_t)(b * NH + hd2) * NBLK + blk) * HD + d] = sum * (1.0f / BLK);
            }
            __syncthreads();
        }
        pm = npm; pn = npn; have = hn; pre = hn;
    }
}

template <int OFF> __device__ __forceinline__ unsigned long long karg64() {
    unsigned long long v; auto k = __builtin_amdgcn_kernarg_segment_ptr();
    asm volatile("s_load_dwordx2 %0, %1, %2\n\ts_waitcnt lgkmcnt(0)" : "=s"(v) : "s"(k), "i"(OFF) : "memory");
    return v;
}
#define ARG(field) ((decltype(MegaArgs::field))karg64<offsetof(MegaArgs, field)>())
#define WSP(T, off) ((T*)((unsigned char*)ARG(ws) + (off)))

__device__ __forceinline__ void moe_counts(LAS int* misc, const GemmCtx& c, const int* toke) {
    if (c.tid < 32) misc[c.tid] = 0;
    __syncthreads();
    typedef int i32x4 __attribute__((ext_vector_type(4)));
    const i32x4* tp = (const i32x4*)(toke + c.tid * 32);
#pragma unroll
    for (int i = 0; i < 8; ++i) {
        const i32x4 v = tp[i];
        atomicAdd((int*)&misc[v[0]], 1); atomicAdd((int*)&misc[v[1]], 1); atomicAdd((int*)&misc[v[2]], 1); atomicAdd((int*)&misc[v[3]], 1);
    }
    __syncthreads();
    if (c.tid == 0) { int acc = 0; for (int e = 0; e < NE; ++e) { misc[32 + e] = acc; acc += (misc[e] + 255) >> 8; } misc[32 + NE] = acc; }
    __syncthreads();
}
__device__ __forceinline__ void moe_rowlist(LAS int* misc, const GemmCtx& c, const int* toke, int e, int mt) {
    __syncthreads();
    typedef int i32x4 __attribute__((ext_vector_type(4)));
    int tb = c.tid * 32; asm volatile("" : "+v"(tb));
    const i32x4* tp = (const i32x4*)(toke + tb);
    i32x4 ent[8];
#pragma unroll
    for (int i = 0; i < 8; ++i) ent[i] = tp[i];
    int cntm = 0;
#pragma unroll
    for (int i = 0; i < 8; ++i) cntm += (ent[i][0] == e) + (ent[i][1] == e) + (ent[i][2] == e) + (ent[i][3] == e);
    int incl = cntm;
#pragma unroll
    for (int o = 1; o < 64; o <<= 1) { const int t = __shfl_up(incl, o); if (c.lane >= o) incl += t; }
    if (c.lane == 63) misc[128 + c.wid] = incl;
    if (c.tid < 256) misc[1024 + c.tid] = -1;
    __syncthreads();
    int base = 0;
#pragma unroll
    for (int w = 0; w < 8; ++w) base += (w < c.wid) ? misc[128 + w] : 0;
    int pos = base + incl - cntm - mt * 256;
    if (cntm > 0 && pos < 256 && pos + cntm > 0) {
#pragma unroll
        for (int i = 0; i < 8; ++i)
#pragma unroll
            for (int q = 0; q < 4; ++q) if (ent[i][q] == e) { if (pos >= 0 && pos < 256) misc[1024 + pos] = tb + 4 * i + q; ++pos; }
    }
    __syncthreads();
}
__device__ __forceinline__ bool moe_tile(LAS int* misc, int it, int ntn, int& e, int& mt, int& nt) {
    const int b = blockIdx.x, G = gridDim.x;
    const int t = (G == 256) ? it * 256 + (b & 7) * 32 + (b >> 3) : it * G + b;
    const int total = misc[32 + NE] * ntn;
    if (t >= total) return false;
    const int g = t / ntn; nt = t % ntn;
    int ee = 0;
#pragma unroll
    for (int q = 1; q < NE; ++q) ee += (misc[32 + q] <= g);
    e = ee; mt = g - misc[32 + ee]; return true;
}

__device__ __forceinline__ unsigned xb_ld(unsigned* p);
__device__ __forceinline__ unsigned xb_add(unsigned* p, unsigned v);
#define MOE_CNT_WORD(layer, g) (3584 + (layer) * 128 + (g))
__device__ __forceinline__ bool moe_item(LAS int* misc, int g_total, int it, int& isb, int& g, int& nt) {
    const int b = blockIdx.x, G = gridDim.x;
    const int TA = g_total * 4, TB = g_total * 8;
    if (G != 256 || TA > 512 || TA < 256) {
        const int t = it * G + b;
        if (t >= TA + TB) return false;
        if (t < TA) { isb = 0; g = t >> 2; nt = t & 3; } else { isb = 1; g = (t - TA) >> 3; nt = (t - TA) & 7; }
        return true;
    }
    const int vb = vblock((LAS unsigned char*)misc - LDS_MISC);
    const int nA2 = TA - 256, nl = 256 - nA2;
    const bool heavy = vb < nA2;
    if (it == 0) { isb = 0; g = vb >> 2; nt = vb & 3; return true; }
    int slot = it - 1;
    if (heavy) { if (slot == 0) { const int t = 256 + vb; isb = 0; g = t >> 2; nt = t & 3; return true; } slot -= 1; }
    int i;
    if (heavy) i = 2 * nl + slot * 256 + nl + vb;
    else i = (slot < 2) ? slot * nl + (vb - nA2) : 2 * nl + (slot - 2) * 256 + (vb - nA2);
    if (i >= TB) return false;
    isb = 1; g = i >> 3; nt = i & 7; return true;
}
__device__ __forceinline__ void moe_g2emt(LAS int* misc, int g, int& e, int& mt) {
    int ee = 0;
#pragma unroll
    for (int q = 1; q < NE; ++q) ee += (misc[32 + q] <= g);
    e = __builtin_amdgcn_readfirstlane(ee); mt = __builtin_amdgcn_readfirstlane(g - misc[32 + ee]);
}
__device__ __forceinline__ void phase_moe(LAS unsigned char* lds, const GemmCtx& c, int layer) {
    LAS int* misc = (LAS int*)(lds + LDS_MISC);
    moe_counts(misc, c, WSP(int, WS_TOKE) + layer * 2 * NTOK);
    const int g_total = __builtin_amdgcn_readfirstlane(misc[32 + NE]);
    const int total_it = (g_total * 12 + gridDim.x - 1) / gridDim.x + 3;
    for (int it = 0; it < total_it; ++it) {
        int isb, g, nt; if (!moe_item(misc, g_total, it, isb, g, nt)) continue;
        isb = __builtin_amdgcn_readfirstlane(isb); g = __builtin_amdgcn_readfirstlane(g); nt = __builtin_amdgcn_readfirstlane(nt);
        int e, mt; moe_g2emt(misc, g, e, mt);
        moe_rowlist(misc, c, WSP(int, WS_TOKE) + layer * 2 * NTOK, e, mt);
        f32x4 acc[4][8];
        if (!isb) {
            {
                unsigned ao[4];
#pragma unroll
                for (int i = 0; i < 4; ++i) { const int sr = misc[1024 + (c.tid >> 3) + 64 * i]; ao[i] = (unsigned)((sr < 0 ? 0 : (sr >> 1)) * DM + a_chunk_off(c.tid)); }
                const int mat = c.wid & 1, bkg = (c.wid >> 1) * 2 + (c.lane >> 5), cgm = c.lane & 31;
                const int brow0 = (cgm >> 4) * 128 + (2 * ((cgm >> 2) & 3) + mat) * 16 + (cgm & 3) * 4;
                const float* Wb = (mat ? ARG(w_up) : ARG(w_gate)) + (size_t)(layer * NE + e) * DM * DE + nt * 128;
                gemm_tile_f32w(lds, c, WSP(bf16_t, WS_A1), ao, Wb, (unsigned)((bkg * 8) * DE + 4 * cgm), brow0, bkg, DE, DM / 64, acc);
            }
            bf16_t* ACT = WSP(bf16_t, WS_ACT);
            const float* tokr = WSP(float, WS_TOKR) + layer * NTOK;
#pragma unroll
            for (int mi = 0; mi < 4; ++mi) {
                const int sr = misc[1024 + c.wr * 64 + mi * 16 + c.fr];
                if (sr >= 0) {
                    const float rs = tokr[sr >> 1];
                    bf16_t* orow = ACT + (size_t)sr * DE + nt * 128 + c.wc * 64 + c.fq * 4;
#pragma unroll
                    for (int p = 0; p < 4; ++p) {
                        float a[4];
#pragma unroll
                        for (int q = 0; q < 4; ++q) { const float gv = acc[mi][2 * p][q] * rs; a[q] = gv / (1.0f + __expf(-gv)) * (acc[mi][2 * p + 1][q] * rs); }
                        uint2 o; o.x = pk2(a[0], a[1]); o.y = pk2(a[2], a[3]);
                        *(uint2*)(orow + p * 16) = o;
                    }
                }
            }
            asm volatile("s_waitcnt vmcnt(0)" ::: "memory");
            __syncthreads();
            if (c.tid == 0) {
                __builtin_amdgcn_fence(__ATOMIC_RELEASE, "agent");
                asm volatile("s_waitcnt vmcnt(0)" ::: "memory");
                (void)xb_add((unsigned*)ARG(ws) + MOE_CNT_WORD(layer, g), 1u);
            }
        } else {
            if (c.tid == 0) {
                unsigned* cw = (unsigned*)ARG(ws) + MOE_CNT_WORD(layer, g);
                unsigned sp = 0;
                while (xb_ld(cw) < 4u) { __builtin_amdgcn_s_sleep(2); if (++sp > (1u << 22)) break; }
                __builtin_amdgcn_fence(__ATOMIC_ACQUIRE, "agent");
                asm volatile("s_waitcnt vmcnt(0)" ::: "memory");
            }
            __syncthreads();
            {
                unsigned ao[4];
#pragma unroll
                for (int i = 0; i < 4; ++i) { const int sr = misc[1024 + (c.tid >> 3) + 64 * i]; ao[i] = (unsigned)((sr < 0 ? 0 : sr) * DE + a_chunk_off(c.tid)); }
                const float* Wb = ARG(w_down) + (size_t)(layer * NE + e) * DE * DM + nt * 256;
                gemm_tile_f32w(lds, c, WSP(bf16_t, WS_ACT), ao, Wb, (unsigned)((c.wid * 8) * DM + 4 * c.lane), 4 * c.lane, c.wid, DM, DE / 64, acc);
            }
            bf16_t* Y = WSP(bf16_t, WS_Y);
            const float* tokw = WSP(float, WS_TOKW) + layer * 2 * NTOK;
#pragma unroll
            for (int mi = 0; mi < 4; ++mi) {
                const int sr = misc[1024 + c.wr * 64 + mi * 16 + c.fr];
                if (sr >= 0) {
                    const float w = tokw[sr];
                    bf16_t* orow = Y + (size_t)sr * DM + nt * 256 + c.wc * 128 + c.fq * 4;
#pragma unroll
                    for (int ni = 0; ni < 8; ++ni) {
                        uint2 o; o.x = pk2(acc[mi][ni][0] * w, acc[mi][ni][1] * w); o.y = pk2(acc[mi][ni][2] * w, acc[mi][ni][3] * w);
                        *(uint2*)(orow + ni * 16) = o;
                    }
                }
            }
        }
    }
}

typedef float f32x16 __attribute__((ext_vector_type(16)));
__device__ __forceinline__ void phase_router(LAS unsigned char* lds, const GemmCtx& c, const bf16_t* __restrict__ HB, const float* __restrict__ g,
                                             const float* __restrict__ wrg, const float* __restrict__ wre, bf16_t* AF, int* toke, float* tokw, float* tokr) {
    LAS float* RR = (LAS float*)lds;
    LAS float* YCH = RR + 64;
    LAS float* WRE = YCH + 32 * 260;
    LAS float* WRG = WRE + 256 * 32;
    LAS float* PLOG = WRG + 256 * 4;
    LAS float* PG = PLOG + 8 * 32 * 32;
    for (int tg = blockIdx.x; tg < NTOK / 32; tg += gridDim.x) {
        const int tok0 = tg * 32;
        __syncthreads();
        f32x16 accl;
#pragma unroll
        for (int i = 0; i < 16; ++i) accl[i] = 0.f;
        float accg[4] = {0.f, 0.f, 0.f, 0.f};
        const int ltok = c.tid >> 4, lq = c.tid & 15;
        float ss = 0.f;
        uint2 hbr[1][4]; f32x4 ggr[1][4], wer[1][4], wgr[1];
        auto ldchunk = [&](int kc, int sl) {
#pragma unroll
            for (int j = 0; j < 4; ++j) {
                const int k = kc * 256 + lq * 4 + 64 * j;
                hbr[sl][j] = *(const uint2*)(HB + (size_t)(tok0 + ltok) * DM + k);
                ggr[sl][j] = *(const f32x4*)(g + k);
                wer[sl][j] = *(const f32x4*)(wre + (size_t)kc * 256 * 32 + (c.tid + 512 * j) * 4);
            }
            if (c.tid < 256) wgr[sl] = *(const f32x4*)(wrg + (size_t)kc * 256 * 4 + c.tid * 4);
        };
        ldchunk(0, 0);
        auto chunk = [&](int kc, const int sl) {
#pragma unroll
            for (int j = 0; j < 4; ++j) {
                const int kl = lq * 4 + 64 * j, k = kc * 256 + kl;
                const uint2 hb = hbr[sl][j];
                const f32x4 h = (f32x4){bflo(hb.x), bfhi(hb.x), bflo(hb.y), bfhi(hb.y)};
                ss += h[0] * h[0] + h[1] * h[1] + h[2] * h[2] + h[3] * h[3];
                const f32x4 gg = ggr[sl][j];
                f32x4 y; y[0] = h[0] * gg[0]; y[1] = h[1] * gg[1]; y[2] = h[2] * gg[2]; y[3] = h[3] * gg[3];
                uint2 o; o.x = pk2(y[0], y[1]); o.y = pk2(y[2], y[3]);
                *(uint2*)(AF + (size_t)(tok0 + ltok) * DM + k) = o;
                *(LAS f32x4*)(YCH + ltok * 260 + kl) = y;
            }
#pragma unroll
            for (int j = 0; j < 4; ++j) *(LAS f32x4*)(WRE + (c.tid + 512 * j) * 4) = wer[sl][j];
            if (c.tid < 256) *(LAS f32x4*)(WRG + c.tid * 4) = wgr[sl];
            __syncthreads();
            if (kc + 1 < 8) ldchunk(kc + 1, 0);
#pragma unroll
            for (int s2 = 0; s2 < 16; ++s2) {
                const int kk = 32 * c.wid + 2 * s2 + (c.lane >> 5);
                const float av = YCH[(c.lane & 31) * 260 + kk];
                const float bv = WRE[kk * 32 + (c.lane & 31)];
                accl = __builtin_amdgcn_mfma_f32_32x32x2f32(av, bv, accl, 0, 0, 0);
            }
            {
                const int t2 = c.tid & 31, ks = c.tid >> 5;
#pragma unroll
                for (int kk = 0; kk < 16; ++kk) {
                    const float yv = YCH[t2 * 260 + ks * 16 + kk];
                    const f32x4 wv = *(const LAS f32x4*)(WRG + (ks * 16 + kk) * 4);
                    accg[0] += yv * wv[0]; accg[1] += yv * wv[1]; accg[2] += yv * wv[2]; accg[3] += yv * wv[3];
                }
            }
            __syncthreads();
        };
#pragma unroll 1
        for (int kc = 0; kc < 8; ++kc) chunk(kc, 0);
        ss += __shfl_xor(ss, 1); ss += __shfl_xor(ss, 2); ss += __shfl_xor(ss, 4); ss += __shfl_xor(ss, 8);
        if (lq == 0) { const float r = rsqrtf(ss * (1.0f / DM) + EPS); RR[ltok] = r; tokr[tok0 + ltok] = r; }
#pragma unroll
        for (int r = 0; r < 16; ++r) PLOG[(c.wid * 32 + ((r & 3) + 8 * (r >> 2) + 4 * (c.lane >> 5))) * 32 + (c.lane & 31)] = accl[r];
        {
            const int t2 = c.tid & 31, ks = c.tid >> 5;
            *(LAS f32x4*)(PG + (ks * 32 + t2) * 4) = (f32x4){accg[0], accg[1], accg[2], accg[3]};
        }
        __syncthreads();
        if (c.tid < 32) {
            const int t2 = c.tid;
            const float rr = RR[t2];
            float gl[4] = {0.f, 0.f, 0.f, 0.f};
#pragma unroll
            for (int ks = 0; ks < 16; ++ks) { const f32x4 v = *(const LAS f32x4*)(PG + (ks * 32 + t2) * 4); gl[0] += v[0]; gl[1] += v[1]; gl[2] += v[2]; gl[3] += v[3]; }
#pragma unroll
            for (int q = 0; q < 4; ++q) gl[q] *= rr;
            int gs = 0; float gm = gl[0];
#pragma unroll
            for (int q = 1; q < 4; ++q) if (gl[q] > gm) { gm = gl[q]; gs = q; }
            float den = 0.f;
#pragma unroll
            for (int q = 0; q < 4; ++q) den += __expf(gl[q] - gm);
            const float gw = 1.0f / den;
            float el[8];
#pragma unroll
            for (int q = 0; q < 8; ++q) {
                float v = 0.f;
#pragma unroll
                for (int w = 0; w < 8; ++w) v += PLOG[(w * 32 + t2) * 32 + gs * 8 + q];
                el[q] = v * rr;
            }
            int i0 = 0; float t0 = el[0];
#pragma unroll
            for (int q = 1; q < 8; ++q) if (el[q] > t0) { t0 = el[q]; i0 = q; }
            int i1 = -1; float t1 = -INFINITY;
#pragma unroll
            for (int q = 0; q < 8; ++q) if (q != i0 && el[q] > t1) { t1 = el[q]; i1 = q; }
            const float e1 = __expf(t1 - t0);
            const int tok = tok0 + t2;
            tokw[tok * 2] = gw / (1.0f + e1); tokw[tok * 2 + 1] = gw * e1 / (1.0f + e1);
            toke[tok * 2] = gs * 8 + i0; toke[tok * 2 + 1] = gs * 8 + i1;
        }
    }
}

typedef short v4i16_t __attribute__((ext_vector_type(4)));
__device__ __forceinline__ float bfs2f(short v) { return __uint_as_float(((unsigned)(unsigned short)v) << 16); }
__device__ __forceinline__ void attn_unit(LAS unsigned char* lds, const GemmCtx& c, int bh, int qb, const bf16_t* __restrict__ Qb, const bf16_t* __restrict__ Kb,
                                          const bf16_t* __restrict__ Vb, const float* __restrict__ KM, bf16_t* ATT) {
    const int lane = c.lane, w = c.wid, r32 = lane & 31, hh = lane >> 5;
    const int head = bh & 15, b = bh >> 4;
    const float LOG2E = 1.4426950408889634f;
    const float slope2 = exp2f(-8.0f * (float)(head + 1) / (float)NH) * LOG2E;
    const float cs = 0.08838834764831845f * LOG2E;
    const int qrow = qb * 256 + w * 32 + r32;
    bf16x8 qf[8];
    {
        const bf16_t* qp = Qb + ((size_t)bh * SEQ + qrow) * HD + 8 * hh;
#pragma unroll
        for (int ds = 0; ds < 8; ++ds) qf[ds] = *(const bf16x8*)(qp + 16 * ds);
    }
    unsigned sel = 0;
    if (qb > 0) {
        float gate[7];
#pragma unroll
        for (int n = 0; n < 7; ++n) {
            float part = 0.f;
            if (n < qb) {
                const float* km = KM + ((size_t)bh * NBLK + n) * HD + 8 * hh;
#pragma unroll
                for (int ds = 0; ds < 8; ++ds) {
                    const f32x4 k0 = *(const f32x4*)(km + 16 * ds), k1 = *(const f32x4*)(km + 16 * ds + 4);
                    part += bfs2f(qf[ds][0]) * k0[0] + bfs2f(qf[ds][1]) * k0[1] + bfs2f(qf[ds][2]) * k0[2] + bfs2f(qf[ds][3]) * k0[3]
                          + bfs2f(qf[ds][4]) * k1[0] + bfs2f(qf[ds][5]) * k1[1] + bfs2f(qf[ds][6]) * k1[2] + bfs2f(qf[ds][7]) * k1[3];
                }
                part += __shfl_xor(part, 32);
                asm volatile("" : "+v"(part) :: "memory");
            }
            gate[n] = part;
        }
#pragma unroll
        for (int n = 0; n < 7; ++n) {
            int rank = 0;
#pragma unroll
            for (int m2 = 0; m2 < 7; ++m2) if (m2 != n && m2 < qb && (gate[m2] > gate[n] || (gate[m2] == gate[n] && m2 < n))) ++rank;
            if (n < qb && rank < 3) sel |= 1u << n;
        }
    }
    const float hb = slope2 * (float)(4 * hh);
    f32x16 o[4];
#pragma unroll
    for (int db = 0; db < 4; ++db)
#pragma unroll
        for (int r = 0; r < 16; ++r) o[db][r] = 0.f;
    float m = -INFINITY, l = 0.f;
    const int kq = r32 & 15;
    int koff[2];
    koff[0] = r32 * 256; koff[1] = (r32 + 32) * 256;
    const int vq = (lane & 15) >> 2, vp = lane & 3, dhalf = (lane >> 4) & 1;
    int voff[4];
#pragma unroll
    for (int db = 0; db < 4; ++db) voff[db] = 16384 + (4 * hh + vq) * 256 + (((((db ^ vq) << 2) | (dhalf * 2 + (vp >> 1))) << 4)) + (vp & 1) * 8;
    const bf16_t* kbase_g = Kb + (size_t)bh * SEQ * HD;
    const bf16_t* vbase_g = Vb + (size_t)bh * SEQ * HD;
    int ksrc[2], vsrc[2];
#pragma unroll
    for (int i = 0; i < 2; ++i) {
        const int pos = i * 512 + c.tid, row = pos >> 4, pc = pos & 15;
        ksrc[i] = row * HD + ((pc ^ (row & 15)) << 3);
        vsrc[i] = row * HD + ((pc ^ ((row & 3) << 2)) << 3);
    }
    const int ntiles = (qb + 1) * 4;
    auto issue = [&](int t) {
        const int blk = (t < 4) ? qb : (t >> 2) - 1, tt = t & 3, buf = t & 1;
        const size_t g0 = (size_t)(blk * 256 + tt * 64) * HD;
#pragma unroll
        for (int i = 0; i < 2; ++i) {
            __builtin_amdgcn_global_load_lds((const unsigned*)(kbase_g + g0 + ksrc[i]), (LAS unsigned*)(lds + buf * 32768 + (i * 512 + c.tid) * 16), 16, 0, 0);
            __builtin_amdgcn_global_load_lds((const unsigned*)(vbase_g + g0 + vsrc[i]), (LAS unsigned*)(lds + buf * 32768 + 16384 + (i * 512 + c.tid) * 16), 16, 0, 0);
        }
    };
    __syncthreads();
    issue(0);
    asm volatile("s_waitcnt vmcnt(0)" ::: "memory");
    __syncthreads();
    for (int t = 0; t < ntiles; ++t) {
        if (t + 1 < ntiles) issue(t + 1);
        const int blk = (t < 4) ? qb : (t >> 2) - 1, tt = t & 3;
        const int kb0 = blk * 256 + tt * 64;
        const bool own = (t < 4);
        const bool lsel = own || ((sel >> blk) & 1u);
        const bool active = own ? (kb0 <= qb * 256 + w * 32 + 31) : (__ballot(lsel) != 0ull);
        if (active) {
            LAS unsigned char* kl = lds + (t & 1) * 32768;
            const float lb = lsel ? hb : -INFINITY;
            const bool diag = own && (kb0 + 63 > qb * 256 + w * 32);
#pragma unroll
            for (int h32 = 0; h32 < 2; ++h32) {
                f32x16 p0;
                const float lbq = lb * (1.0f / cs), s2q = slope2 * (1.0f / cs);
#pragma unroll
                for (int r = 0; r < 16; ++r) p0[r] = fmaf(s2q, (float)((r & 3) + 8 * (r >> 2)), lbq);
#pragma unroll
                for (int ds = 0; ds < 8; ++ds) {
                    const int ch = ((2 * ds + hh) ^ kq) << 4;
                    const bf16x8 k0 = *(const LAS bf16x8*)(kl + koff[h32] + ch);
                    p0 = __builtin_amdgcn_mfma_f32_32x32x16_bf16(k0, qf[ds], p0, 0, 0, 0);
                }
                float mx0 = -INFINITY;
                const int dq = qrow - kb0 - 32 * h32 - 4 * hh;
#pragma unroll
                for (int r = 0; r < 16; ++r) {
                    if (diag) { if ((r & 3) + 8 * (r >> 2) > dq) p0[r] = -INFINITY; }
                    mx0 = fmaxf(mx0, p0[r]);
                }
                const float tc = slope2 * (float)(kb0 + 32 * h32);
                float tmax = fmaf(mx0, cs, tc);
                {
                    const auto sw = __builtin_amdgcn_permlane32_swap(__builtin_bit_cast(unsigned, tmax), __builtin_bit_cast(unsigned, tmax), false, false);
                    tmax = fmaxf(__builtin_bit_cast(float, sw[0]), __builtin_bit_cast(float, sw[1]));
                }
                const float mn = fmaxf(m, tmax);
                if (__ballot(mn > m + 8.0f) != 0ull) {
                    const float alpha = __builtin_amdgcn_exp2f(m - mn);
                    l *= alpha;
#pragma unroll
                    for (int db = 0; db < 4; ++db)
#pragma unroll
                        for (int r = 0; r < 16; ++r) o[db][r] *= alpha;
                    m = mn;
                }
                const float c0 = tc - m;
                float ls = 0.f;
#pragma unroll
                for (int r = 0; r < 16; ++r) { const float e0 = __builtin_amdgcn_exp2f(fmaf(p0[r], cs, c0)); p0[r] = e0; ls += e0; }
                l += ls;
                bf16x8 pb[2];
#pragma unroll
                for (int s2 = 0; s2 < 2; ++s2) {
                    u32x4 w0;
#pragma unroll
                    for (int q = 0; q < 4; ++q) w0[q] = pk2(p0[8 * s2 + 2 * q], p0[8 * s2 + 2 * q + 1]);
                    pb[s2] = __builtin_bit_cast(bf16x8, w0);
                }
#pragma unroll
                for (int db = 0; db < 4; ++db) {
#pragma unroll
                    for (int s2 = 0; s2 < 2; ++s2) {
                        const int ks = 2 * h32 + s2;
                        const v4i16_t lo = __builtin_amdgcn_ds_read_tr16_b64_v4i16((LAS v4i16_t*)(kl + voff[db] + (16 * ks) * 256));
                        const v4i16_t hi = __builtin_amdgcn_ds_read_tr16_b64_v4i16((LAS v4i16_t*)(kl + voff[db] + (16 * ks + 8) * 256));
                        bf16x8 vf; vf[0] = lo[0]; vf[1] = lo[1]; vf[2] = lo[2]; vf[3] = lo[3]; vf[4] = hi[0]; vf[5] = hi[1]; vf[6] = hi[2]; vf[7] = hi[3];
                        o[db] = __builtin_amdgcn_mfma_f32_32x32x16_bf16(vf, pb[s2], o[db], 0, 0, 0);
                    }
                }
            }
        }
        asm volatile("s_waitcnt vmcnt(0)" ::: "memory");
        __syncthreads();
    }
    l += __shfl_xor(l, 32);
    const float inv = 1.0f / l;
    const int orow_tok = b * SEQ + qrow, ocol0 = head * HD + 4 * hh;
#pragma unroll
    for (int db = 0; db < 4; ++db)
#pragma unroll
        for (int rq = 0; rq < 4; ++rq) {
            uint2 ov; ov.x = pk2(o[db][4 * rq] * inv, o[db][4 * rq + 1] * inv); ov.y = pk2(o[db][4 * rq + 2] * inv, o[db][4 * rq + 3] * inv);
            *(uint2*)(ATT + stg_off(orow_tok, ocol0 + db * 32 + 8 * rq)) = ov;
        }
}
__device__ __forceinline__ void phase_attn(LAS unsigned char* lds, const GemmCtx& c, const bf16_t* Qb, const bf16_t* Kb, const bf16_t* Vb, const float* KM, bf16_t* ATT) {
    for (int it = blockIdx.x; it < 256; it += gridDim.x) {
        const int p = (gridDim.x == 256) ? vblock(lds) : it;
        const int bh = p >> 2, j = p & 3;
#pragma unroll 1
        for (int u = 0; u < 2; ++u) attn_unit(lds, c, bh, u ? j : 7 - j, Qb, Kb, Vb, KM, ATT);
    }
}

#define XB_TMO      128
#define XB_XCNT(j)  (256  + 64 * (j))
#define XB_XSUB(j)  (1280 + 64 * (j))
#define XB_XGEN(j)  (2304 + 64 * (j))
#define XB_TOP      3328
#define XB_TOPGEN   3392
#define XCD_BAR_WORDS 3456
#define XB_SPIN_CAP (1u << 22)
__device__ __forceinline__ unsigned xb_ld(unsigned* p)              { return __hip_atomic_load(p, __ATOMIC_RELAXED, __HIP_MEMORY_SCOPE_AGENT); }
__device__ __forceinline__ unsigned xb_add(unsigned* p, unsigned v) { return __hip_atomic_fetch_add(p, v, __ATOMIC_RELAXED, __HIP_MEMORY_SCOPE_AGENT); }
__device__ __forceinline__ unsigned xb_xcc_id() { return (unsigned)__builtin_amdgcn_s_getreg((3 << 11) | 20) & 0xFu; }
#define XB_SPIN(cond, bar) do { unsigned _sp = 0; while (cond) { __builtin_amdgcn_s_sleep(1); \
    if ((++_sp & 255u) == 0u) { if (xb_ld(&(bar)[XB_TMO])) break; if (_sp > XB_SPIN_CAP) { atomicAdd(&(bar)[XB_TMO], 1u); break; } } } } while (0)
__device__ __forceinline__ void xcd_barrier_complete(unsigned* bar, unsigned x, unsigned& nloc, unsigned& nx) {
    const unsigned G = gridDim.x;
    unsigned sum, cnt, mine, sp = 0u;
    for (;;) {
        sum = 0u; cnt = 0u; mine = 0u;
#pragma unroll
        for (unsigned j = 0; j < 16; ++j) { const unsigned cc = xb_ld(&bar[XB_XCNT(j)]); sum += cc; cnt += (cc > 0u) ? 1u : 0u; mine = (j == x) ? cc : mine; }
        if (sum == G) break;
        __builtin_amdgcn_s_sleep(1);
        if ((++sp & 255u) == 0u) { if (xb_ld(&bar[XB_TMO])) break; if (sp > XB_SPIN_CAP) { atomicAdd(&bar[XB_TMO], 1u); break; } }
    }
    nloc = mine > 0u ? mine : 1u; nx = cnt > 0u ? cnt : 1u;
}
__device__ __forceinline__ void grid_barrier(unsigned* bar, volatile LAS unsigned* st) {
    asm volatile("s_waitcnt vmcnt(0)" ::: "memory");
    __syncthreads();
    if (threadIdx.x == 0) {
        __builtin_amdgcn_s_waitcnt(0);
        const unsigned x = xb_xcc_id();
        unsigned nloc = st[0], nx = st[1];
        if (nloc == 0u) {
            xcd_barrier_complete(bar, x, nloc, nx); st[0] = nloc; st[1] = nx;
            unsigned ok = 1u;
#pragma unroll
            for (unsigned j = 0; j < 16; ++j) { const unsigned cc = xb_ld(&bar[XB_XCNT(j)]); ok &= (j < 8u) ? (cc == 32u ? 1u : 0u) : (cc == 0u ? 1u : 0u); }
            st[3] = ok;
        }
        const unsigned old = xb_add(&bar[XB_XSUB(x)], 1u);
        const unsigned gen = old / nloc;
        if (old + 1u == (gen + 1u) * nloc) {
            __builtin_amdgcn_fence(__ATOMIC_RELEASE, "agent");
            asm volatile("s_waitcnt vmcnt(0)" ::: "memory");
            const unsigned og = xb_add(&bar[XB_TOP], 1u);
            const unsigned tg = og / nx;
            if (og + 1u == (tg + 1u) * nx) xb_add(&bar[XB_TOPGEN], 1u);
            else XB_SPIN(xb_ld(&bar[XB_TOPGEN]) == tg, bar);
            __builtin_amdgcn_fence(__ATOMIC_ACQUIRE, "agent");
            xb_add(&bar[XB_XGEN(x)], 1u);
            asm volatile("s_waitcnt vmcnt(0)" ::: "memory");
        } else {
            XB_SPIN(xb_ld(&bar[XB_XGEN(x)]) == gen, bar);
            __builtin_amdgcn_fence(__ATOMIC_ACQUIRE, "agent");
            asm volatile("s_waitcnt vmcnt(0)" ::: "memory");
        }
    }
    __syncthreads();
}

__global__ void __launch_bounds__(512, 2) mega(MegaArgs a) {
    extern __shared__ __attribute__((aligned(16))) unsigned char lds_raw[];
    LAS unsigned char* lds = (LAS unsigned char*)lds_raw;
    const int ph_lo = a.ph_lo, ph_hi = a.ph_hi;
    volatile LAS unsigned* bst = (volatile LAS unsigned*)(lds + LDS_MISC + 8160);
    if (threadIdx.x == 0) { bst[0] = 0u; bst[1] = 0u; bst[2] = 0xffffu; bst[3] = 0u; }
    if (ph_hi - ph_lo > 1 && threadIdx.x == 0) {
        const unsigned x = xb_xcc_id(); const unsigned rank = xb_add(&((unsigned*)ARG(ws))[XB_XCNT(x)], 1u);
        bst[2] = (x < 8u && rank < 32u) ? x * 32u + rank : 0xffffu;
    }
    __syncthreads();
#ifndef REPEAT_PH
#define REPEAT_PH -1
#endif
#ifndef ABLATE
#define ABLATE 0
#endif
#define IN(k) (ph_lo <= (k) && (k) < ph_hi)
#define SEAM(k) if (IN(k) && IN((k) + 1)) grid_barrier((unsigned*)ARG(ws), bst);
    if (IN(PH_PREP)) { const GemmCtx c = make_ctx(); const int gwave = blockIdx.x * 8 + c.wid, nwaves = gridDim.x * 8; (void)gwave; (void)nwaves;
        norm_rows(ARG(x), ARG(mix_norm), WSP(bf16_t, WS_A1), nullptr, nullptr, gwave, nwaves, c.lane);
        convert_wt<true>(lds, c, ARG(conv_w_in), 6144, WSP(bf16_t, WS_WT));
        convert_wt(lds, c, ARG(conv_w_out), 2048, WSP(bf16_t, WS_WT) + (size_t)6144 * DM);
        convert_wt(lds, c, ARG(w_kv), 4096, WSP(bf16_t, WS_WT) + (size_t)(6144 + 2048) * DM, ARG(kv_norm));
        convert_wt(lds, c, ARG(w_q), 2048, WSP(bf16_t, WS_WT) + (size_t)(6144 + 2048 + 4096) * DM, ARG(mix_norm) + DM);
        convert_wt(lds, c, ARG(w_o), 2048, WSP(bf16_t, WS_WT) + (size_t)(6144 + 2048 + 6144) * DM); }
    if (IN(PH_PREP) && REPEAT_PH == PH_PREP) grid_barrier((unsigned*)ARG(ws), bst);
    if (IN(PH_PREP) && REPEAT_PH == PH_PREP) { const GemmCtx c = make_ctx(); const int gwave = blockIdx.x * 8 + c.wid, nwaves = gridDim.x * 8; (void)gwave; (void)nwaves;
        norm_rows(ARG(x), ARG(mix_norm), WSP(bf16_t, WS_A1), nullptr, nullptr, gwave, nwaves, c.lane);
        convert_wt<true>(lds, c, ARG(conv_w_in), 6144, WSP(bf16_t, WS_WT));
        convert_wt(lds, c, ARG(conv_w_out), 2048, WSP(bf16_t, WS_WT) + (size_t)6144 * DM);
        convert_wt(lds, c, ARG(w_kv), 4096, WSP(bf16_t, WS_WT) + (size_t)(6144 + 2048) * DM, ARG(kv_norm));
        convert_wt(lds, c, ARG(w_q), 2048, WSP(bf16_t, WS_WT) + (size_t)(6144 + 2048 + 4096) * DM, ARG(mix_norm) + DM);
        convert_wt(lds, c, ARG(w_o), 2048, WSP(bf16_t, WS_WT) + (size_t)(6144 + 2048 + 6144) * DM); }
    SEAM(PH_PREP)
    if (IN(PH_GEMM1)) { const GemmCtx c = make_ctx(); const int gwave = blockIdx.x * 8 + c.wid, nwaves = gridDim.x * 8; (void)gwave; (void)nwaves;
        phase_gemm1(lds, c, WSP(bf16_t, WS_A1), WSP(bf16_t, WS_WT), WSP(bf16_t, WS_BCX)); }
    if (IN(PH_GEMM1) && REPEAT_PH == PH_GEMM1) grid_barrier((unsigned*)ARG(ws), bst);
    if (IN(PH_GEMM1) && REPEAT_PH == PH_GEMM1) { const GemmCtx c = make_ctx(); const int gwave = blockIdx.x * 8 + c.wid, nwaves = gridDim.x * 8; (void)gwave; (void)nwaves;
        phase_gemm1(lds, c, WSP(bf16_t, WS_A1), WSP(bf16_t, WS_WT), WSP(bf16_t, WS_BCX)); }
    SEAM(PH_GEMM1)
    if (IN(PH_CONV)) { const GemmCtx c = make_ctx(); const int gwave = blockIdx.x * 8 + c.wid, nwaves = gridDim.x * 8; (void)gwave; (void)nwaves;
        conv_phase(WSP(bf16_t, WS_BCX), WSP(bf16_t, WS_BCX) + (size_t)NTOK * DM, ARG(conv_w), WSP(bf16_t, WS_Z), blockIdx.x * 512 + c.tid, gridDim.x * 512); }
    if (IN(PH_CONV) && REPEAT_PH == PH_CONV) grid_barrier((unsigned*)ARG(ws), bst);
    if (IN(PH_CONV) && REPEAT_PH == PH_CONV) { const GemmCtx c = make_ctx(); const int gwave = blockIdx.x * 8 + c.wid, nwaves = gridDim.x * 8; (void)gwave; (void)nwaves;
        conv_phase(WSP(bf16_t, WS_BCX), WSP(bf16_t, WS_BCX) + (size_t)NTOK * DM, ARG(conv_w), WSP(bf16_t, WS_Z), blockIdx.x * 512 + c.tid, gridDim.x * 512); }
    SEAM(PH_CONV)
    if (IN(PH_GEMM2)) { const GemmCtx c = make_ctx(); const int gwave = blockIdx.x * 8 + c.wid, nwaves = gridDim.x * 8; (void)gwave; (void)nwaves;
        phase_gemm_resid<0>(lds, c, WSP(bf16_t, WS_Z), WSP(bf16_t, WS_WT) + (size_t)6144 * DM, ARG(x), WSP(bf16_t, WS_HB)); }
    if (IN(PH_GEMM2) && REPEAT_PH == PH_GEMM2) grid_barrier((unsigned*)ARG(ws), bst);
    if (IN(PH_GEMM2) && REPEAT_PH == PH_GEMM2) { const GemmCtx c = make_ctx(); const int gwave = blockIdx.x * 8 + c.wid, nwaves = gridDim.x * 8; (void)gwave; (void)nwaves;
        phase_gemm_resid<0>(lds, c, WSP(bf16_t, WS_Z), WSP(bf16_t, WS_WT) + (size_t)6144 * DM, ARG(x), WSP(bf16_t, WS_HB)); }
    SEAM(PH_GEMM2)
    if (IN(PH_ROUTER0)) { const GemmCtx c = make_ctx(); const int gwave = blockIdx.x * 8 + c.wid, nwaves = gridDim.x * 8; (void)gwave; (void)nwaves;
        phase_router(lds, c, WSP(bf16_t, WS_HB), ARG(ffn_norm), ARG(router_group), ARG(router_expert), WSP(bf16_t, WS_A1), WSP(int, WS_TOKE), WSP(float, WS_TOKW), WSP(float, WS_TOKR)); }
    if (IN(PH_ROUTER0) && REPEAT_PH == PH_ROUTER0) grid_barrier((unsigned*)ARG(ws), bst);
    if (IN(PH_ROUTER0) && REPEAT_PH == PH_ROUTER0) { const GemmCtx c = make_ctx(); const int gwave = blockIdx.x * 8 + c.wid, nwaves = gridDim.x * 8; (void)gwave; (void)nwaves;
        phase_router(lds, c, WSP(bf16_t, WS_HB), ARG(ffn_norm), ARG(router_group), ARG(router_expert), WSP(bf16_t, WS_A1), WSP(int, WS_TOKE), WSP(float, WS_TOKW), WSP(float, WS_TOKR)); }
    SEAM(PH_ROUTER0)
    if (IN(PH_MOEA0)) { const GemmCtx c = make_ctx(); const int gwave = blockIdx.x * 8 + c.wid, nwaves = gridDim.x * 8; (void)gwave; (void)nwaves;
        phase_moe(lds, c, 0); }
    if (IN(PH_MOEA0) && IN(PH_COMBINE0)) grid_barrier((unsigned*)ARG(ws), bst);
    if (IN(PH_COMBINE0)) { const GemmCtx c = make_ctx(); const int gwave = blockIdx.x * 8 + c.wid, nwaves = gridDim.x * 8; (void)gwave; (void)nwaves;
        combine_rows2(WSP(bf16_t, WS_HB), WSP(bf16_t, WS_Y), ARG(kv_norm), WSP(bf16_t, WS_A1), nullptr, nullptr, nullptr, nullptr, gwave, nwaves, c.lane, WSP(float, WS_RINV)); }
    if (IN(PH_COMBINE0) && REPEAT_PH == PH_COMBINE0) grid_barrier((unsigned*)ARG(ws), bst);
    if (IN(PH_COMBINE0) && REPEAT_PH == PH_COMBINE0) { const GemmCtx c = make_ctx(); const int gwave = blockIdx.x * 8 + c.wid, nwaves = gridDim.x * 8; (void)gwave; (void)nwaves;
        combine_rows2(WSP(bf16_t, WS_HB), WSP(bf16_t, WS_Y), ARG(kv_norm), WSP(bf16_t, WS_A1), nullptr, nullptr, nullptr, nullptr, gwave, nwaves, c.lane, WSP(float, WS_RINV)); }
    SEAM(PH_COMBINE0)
    if (IN(PH_GEMM3)) { const GemmCtx c = make_ctx(); const int gwave = blockIdx.x * 8 + c.wid, nwaves = gridDim.x * 8; (void)gwave; (void)nwaves;
        phase_gemm3(lds, c, WSP(bf16_t, WS_A1), WSP(bf16_t, WS_A1), WSP(bf16_t, WS_WT) + (size_t)(6144 + 2048) * DM, ARG(k_norm), ARG(q_norm),
                                  WSP(bf16_t, WS_BCX), WSP(bf16_t, WS_BCX) + (size_t)NTOK * DM, WSP(bf16_t, WS_BCX) + (size_t)2 * NTOK * DM, WSP(float, WS_KMEAN)); }
    if (IN(PH_GEMM3) && REPEAT_PH == PH_GEMM3) grid_barrier((unsigned*)ARG(ws), bst);
    if (IN(PH_GEMM3) && REPEAT_PH == PH_GEMM3) { const GemmCtx c = make_ctx(); const int gwave = blockIdx.x * 8 + c.wid, nwaves = gridDim.x * 8; (void)gwave; (void)nwaves;
        phase_gemm3(lds, c, WSP(bf16_t, WS_A1), WSP(bf16_t, WS_A1), WSP(bf16_t, WS_WT) + (size_t)(6144 + 2048) * DM, ARG(k_norm), ARG(q_norm),
                                  WSP(bf16_t, WS_BCX), WSP(bf16_t, WS_BCX) + (size_t)NTOK * DM, WSP(bf16_t, WS_BCX) + (size_t)2 * NTOK * DM, WSP(float, WS_KMEAN)); }
    SEAM(PH_GEMM3)
    if (IN(PH_ATTN)) { const GemmCtx c = make_ctx(); const int gwave = blockIdx.x * 8 + c.wid, nwaves = gridDim.x * 8; (void)gwave; (void)nwaves;
        phase_attn(lds, c, WSP(bf16_t, WS_BCX) + (size_t)2 * NTOK * DM, WSP(bf16_t, WS_BCX), WSP(bf16_t, WS_BCX) + (size_t)NTOK * DM, WSP(float, WS_KMEAN), WSP(bf16_t, WS_Z)); }
    if (IN(PH_ATTN) && REPEAT_PH == PH_ATTN) grid_barrier((unsigned*)ARG(ws), bst);
    if (IN(PH_ATTN) && REPEAT_PH == PH_ATTN) { const GemmCtx c = make_ctx(); const int gwave = blockIdx.x * 8 + c.wid, nwaves = gridDim.x * 8; (void)gwave; (void)nwaves;
        phase_attn(lds, c, WSP(bf16_t, WS_BCX) + (size_t)2 * NTOK * DM, WSP(bf16_t, WS_BCX), WSP(bf16_t, WS_BCX) + (size_t)NTOK * DM, WSP(float, WS_KMEAN), WSP(bf16_t, WS_Z)); }
    SEAM(PH_ATTN)
    if (IN(PH_GEMM4)) { const GemmCtx c = make_ctx(); const int gwave = blockIdx.x * 8 + c.wid, nwaves = gridDim.x * 8; (void)gwave; (void)nwaves;
        phase_gemm_resid<2>(lds, c, WSP(bf16_t, WS_Z), WSP(bf16_t, WS_WT) + (size_t)(6144 + 2048 + 6144) * DM, WSP(bf16_t, WS_A1), WSP(bf16_t, WS_HB), WSP(float, WS_RINV)); }
    if (IN(PH_GEMM4) && REPEAT_PH == PH_GEMM4) grid_barrier((unsigned*)ARG(ws), bst);
    if (IN(PH_GEMM4) && REPEAT_PH == PH_GEMM4) { const GemmCtx c = make_ctx(); const int gwave = blockIdx.x * 8 + c.wid, nwaves = gridDim.x * 8; (void)gwave; (void)nwaves;
        phase_gemm_resid<2>(lds, c, WSP(bf16_t, WS_Z), WSP(bf16_t, WS_WT) + (size_t)(6144 + 2048 + 6144) * DM, WSP(bf16_t, WS_A1), WSP(bf16_t, WS_HB), WSP(float, WS_RINV)); }
    SEAM(PH_GEMM4)
    if (IN(PH_ROUTER1)) { const GemmCtx c = make_ctx(); const int gwave = blockIdx.x * 8 + c.wid, nwaves = gridDim.x * 8; (void)gwave; (void)nwaves;
        phase_router(lds, c, WSP(bf16_t, WS_HB), ARG(ffn_norm) + DM, ARG(router_group) + (size_t)DM * NG, ARG(router_expert) + (size_t)DM * NE, WSP(bf16_t, WS_A1), WSP(int, WS_TOKE) + 2 * NTOK, WSP(float, WS_TOKW) + 2 * NTOK, WSP(float, WS_TOKR) + NTOK); }
    if (IN(PH_ROUTER1) && REPEAT_PH == PH_ROUTER1) grid_barrier((unsigned*)ARG(ws), bst);
    if (IN(PH_ROUTER1) && REPEAT_PH == PH_ROUTER1) { const GemmCtx c = make_ctx(); const int gwave = blockIdx.x * 8 + c.wid, nwaves = gridDim.x * 8; (void)gwave; (void)nwaves;
        phase_router(lds, c, WSP(bf16_t, WS_HB), ARG(ffn_norm) + DM, ARG(router_group) + (size_t)DM * NG, ARG(router_expert) + (size_t)DM * NE, WSP(bf16_t, WS_A1), WSP(int, WS_TOKE) + 2 * NTOK, WSP(float, WS_TOKW) + 2 * NTOK, WSP(float, WS_TOKR) + NTOK); }
    SEAM(PH_ROUTER1)
    if (IN(PH_MOEA1)) { const GemmCtx c = make_ctx(); const int gwave = blockIdx.x * 8 + c.wid, nwaves = gridDim.x * 8; (void)gwave; (void)nwaves;
        phase_moe(lds, c, 1); }
    if (IN(PH_MOEA1) && IN(PH_COMBINE1)) grid_barrier((unsigned*)ARG(ws), bst);
    if (IN(PH_COMBINE1)) { const GemmCtx c = make_ctx(); const int gwave = blockIdx.x * 8 + c.wid, nwaves = gridDim.x * 8; (void)gwave; (void)nwaves;
        combine_rows2(WSP(bf16_t, WS_HB), WSP(bf16_t, WS_Y), nullptr, nullptr, nullptr, nullptr, nullptr, ARG(H), gwave, nwaves, c.lane); }
    if (IN(PH_COMBINE1) && REPEAT_PH == PH_COMBINE1) grid_barrier((unsigned*)ARG(ws), bst);
    if (IN(PH_COMBINE1) && REPEAT_PH == PH_COMBINE1) { const GemmCtx c = make_ctx(); const int gwave = blockIdx.x * 8 + c.wid, nwaves = gridDim.x * 8; (void)gwave; (void)nwaves;
        combine_rows2(WSP(bf16_t, WS_HB), WSP(bf16_t, WS_Y), nullptr, nullptr, nullptr, nullptr, nullptr, ARG(H), gwave, nwaves, c.lane); }
#undef IN
#undef SEAM
}

extern "C" void kernel_launch(void* const* d_in, const int* in_sizes, int n_in, void* d_out, int out_size, void* d_ws, size_t ws_size, hipStream_t stream) {
    const float* x = (const float*)d_in[0];
    const float* mix_norm = (const float*)d_in[1];
    const float* ffn_norm = (const float*)d_in[2];
    const float* conv_w_in = (const float*)d_in[3];
    const float* conv_w = (const float*)d_in[4];
    const float* conv_w_out = (const float*)d_in[5];
    const float* kv_norm = (const float*)d_in[6];
    const float* w_kv = (const float*)d_in[7];
    const float* k_norm = (const float*)d_in[8];
    const float* w_q = (const float*)d_in[9];
    const float* q_norm = (const float*)d_in[10];
    const float* w_o = (const float*)d_in[11];
    const float* router_group = (const float*)d_in[12];
    const float* router_expert = (const float*)d_in[13];
    const float* w_gate = (const float*)d_in[14];
    const float* w_up = (const float*)d_in[15];
    const float* w_down = (const float*)d_in[16];
    float* H = (float*)d_out;
    unsigned char* ws = (unsigned char*)d_ws;
    if (ws_size < WS_END) { fprintf(stderr, "workspace too small: %zu < %zu\n", ws_size, (size_t)WS_END); return; }
    int* cnt = (int*)(ws + WS_CNT);
    bf16_t* A1 = (bf16_t*)(ws + WS_A1); bf16_t* A2 = (bf16_t*)(ws + WS_A2);
    bf16_t* BCX = (bf16_t*)(ws + WS_BCX);
    bf16_t* Kb = (bf16_t*)(ws + WS_BCX); bf16_t* Vb = Kb + (size_t)NTOK * DM; bf16_t* Qb = Vb + (size_t)NTOK * DM;
    bf16_t* Z = (bf16_t*)(ws + WS_Z); bf16_t* ATT = Z;
    bf16_t* ACT = (bf16_t*)(ws + WS_ACT); bf16_t* Y = (bf16_t*)(ws + WS_Y);
    float* KM = (float*)(ws + WS_KMEAN);
    int* list = (int*)(ws + WS_LIST); float* tokw = (float*)(ws + WS_TOKW); int* toke = (int*)(ws + WS_TOKE);
    float* T = (float*)(ws + WS_T);
    const size_t nd = (size_t)NTOK * DM;
    static bool attr = false;
    if (!attr) { (void)hipFuncSetAttribute((const void*)mega, hipFuncAttributeMaxDynamicSharedMemorySize, LDS_BYTES); attr = true; }
    MegaArgs ma{};
    ma.x = x; ma.mix_norm = mix_norm; ma.ffn_norm = ffn_norm; ma.conv_w_in = conv_w_in; ma.conv_w = conv_w; ma.conv_w_out = conv_w_out;
    ma.kv_norm = kv_norm; ma.w_kv = w_kv; ma.k_norm = k_norm; ma.w_q = w_q; ma.q_norm = q_norm; ma.w_o = w_o;
    ma.router_group = router_group; ma.router_expert = router_expert; ma.w_gate = w_gate; ma.w_up = w_up; ma.w_down = w_down;
    ma.H = H; ma.ws = ws;
    static int grid = 0;
    if (!grid) {
        int dev = 0, cus = 0, per_cu = 0;
        (void)hipGetDevice(&dev);
        (void)hipDeviceGetAttribute(&cus, hipDeviceAttributeMultiprocessorCount, dev);
        (void)hipOccupancyMaxActiveBlocksPerMultiprocessor(&per_cu, (const void*)mega, 512, LDS_BYTES);
        if (per_cu < 1) per_cu = 1;
        grid = cus * 1;
        if (grid > 256) grid = 256;
    }
    (void)hipMemsetAsync(ws + WS_CTL, 0, 16384, stream);
    ma.ph_lo = 0; ma.ph_hi = PH_END;
    void* kargs[] = {&ma};
    hipError_t le = hipLaunchCooperativeKernel((const void*)mega, dim3(grid), dim3(512), kargs, LDS_BYTES, stream);
    if (le != hipSuccess) fprintf(stderr, "cooperative launch failed: %s (grid %d)\n", hipGetErrorString(le), grid);
}
```
